# Optimizing an MI355X kernel written in HIP

```python
import math
import jax
import jax.numpy as jnp
from jax import lax
import numpy as np


D_MODEL = 1024
BATCH = 2
SEQ = 8192
DEPTH = 1

GRID_W = 64
CTX_LEN = 256
EPS = 1e-6
N_MOD = 6

D_HY = 512
HY_ORDER = 2
HY_BANDS = 16
HY_EMB = 1 + 2 * HY_BANDS
HY_FFN = 64
HY_DECAY_TARGET = 1e-2
HY_FAST_PCT = 0.3
HY_SLOW_PCT = 1.5

NA_HEADS = 8
HEAD_DIM = 64
D_NA = NA_HEADS * HEAD_DIM
WIN_ROWS = 8
WIN_COLS = 16
ROPE_THETA = 10000.0
NEG_INF = -1e30

PEER_HEADS = 8
PEER_N_KEYS = 128
PEER_N_EXPERTS = PEER_N_KEYS * PEER_N_KEYS
PEER_TOPK = 16
PEER_D_KEY = 256
PEER_D_HALF = PEER_D_KEY // 2
PEER_BLOCK = 128

COL_HY = 0
COL_Q = COL_HY + 3 * D_HY
COL_K = COL_Q + D_NA
COL_V = COL_K + D_NA
COL_G_HY = COL_V + D_NA
COL_G_NA = COL_G_HY + D_MODEL
N_PROJ = COL_G_NA + D_MODEL

kernel_name = 'hybrid_hyena_natten_peer_block'


def rmsnorm(x, g):
    x32 = x.astype(jnp.float32)
    y = x32 * lax.rsqrt(jnp.mean(x32 * x32, axis=-1, keepdims=True) + EPS)
    return (y * g.astype(jnp.float32)).astype(x.dtype)


def modulate(x, g, shift, scale):
    return rmsnorm(x, g) * (1.0 + scale) + shift


def adaln(cond, p):
    m = jax.nn.silu(cond) @ p['w_ada'] + p['b_ada']
    return m.reshape(cond.shape[:-1] + (N_MOD, D_MODEL))


def hyena_filters(L, p):
    f32 = jnp.float32
    t = jnp.linspace(0.0, 1.0, L, dtype=f32)[:, None]
    w = (2.0 * math.pi / L) * jnp.arange(L, dtype=f32)[:, None]
    bands = jnp.linspace(1e-4, HY_BANDS - 1.0, HY_BANDS, dtype=f32)[None, :]
    feats = jnp.concatenate([t, jnp.cos(bands * w), -jnp.sin(bands * w)], axis=-1)
    freq = p['hy_sin_freq'].astype(f32)
    h = jnp.sin(freq * (feats @ p['hy_f1_w'].astype(f32) + p['hy_f1_b'].astype(f32)))
    h = jnp.sin(freq * (h @ p['hy_f2_w'].astype(f32) + p['hy_f2_b'].astype(f32)))
    h = jnp.sin(freq * (h @ p['hy_f3_w'].astype(f32) + p['hy_f3_b'].astype(f32)))
    h = (h @ p['hy_f4_w'].astype(f32)).reshape(L, HY_ORDER, 2, D_HY)
    deltas = jnp.abs(jnp.linspace(math.log(HY_DECAY_TARGET) / HY_SLOW_PCT,
                                  math.log(HY_DECAY_TARGET) / HY_FAST_PCT, D_HY, dtype=f32))
    h = h * jnp.exp(-t * deltas)[:, None, None, :]
    h = h / jnp.sum(jnp.abs(h), axis=(0, 2), keepdims=True)
    fwd, bwd = h[:, :, 0], h[:, :, 1]
    return jnp.concatenate([fwd, jnp.zeros_like(fwd[:1]), bwd[:0:-1]], axis=0)


def hyena(zh, p):
    B, L, _ = zh.shape
    cw = p['hy_conv_w']
    zp = jnp.pad(zh, ((0, 0), (1, 1), (0, 0)))
    zc = cw[0] * zp[:, :-2] + cw[1] * zp[:, 1:-1] + cw[2] * zp[:, 2:] + p['hy_conv_b']
    v, x1, x2 = jnp.split(zc.astype(jnp.float32), 3, axis=-1)
    kf = jnp.fft.rfft(hyena_filters(L, p), axis=0)
    skip = p['hy_skip'].astype(jnp.float32)
    y = v
    for o, gate in enumerate((x1, x2)):
        yf = jnp.fft.rfft(y, n=2 * L, axis=1)
        conv = jnp.fft.irfft(yf * kf[:, o][None], n=2 * L, axis=1)[:, :L]
        y = gate * (conv + skip[o] * y)
    return y.astype(zh.dtype)


def axial_rope(x):
    f32 = jnp.float32
    S = x.shape[1]
    pos = jnp.arange(S, dtype=jnp.int32)
    rows = (pos // GRID_W).astype(f32)
    cols = (pos % GRID_W).astype(f32)
    half = HEAD_DIM // 2
    nf = half // 2
    inv = ROPE_THETA ** (-jnp.arange(nf, dtype=f32) / nf)

    def rot(xp, ps):
        ang = ps[:, None] * inv[None, :]
        cos = jnp.cos(ang)[None, :, None, :]
        sin = jnp.sin(ang)[None, :, None, :]
        a, b = xp[..., :nf], xp[..., nf:]
        return jnp.concatenate([a * cos - b * sin, a * sin + b * cos], axis=-1)

    x32 = x.astype(f32)
    return jnp.concatenate([rot(x32[..., :half], rows), rot(x32[..., half:], cols)], axis=-1).astype(x.dtype)


def neighbourhood_attention(q, k, v, k_ctx, v_ctx, rpb):
    B, S, H, Dh = q.shape
    rows = S // GRID_W
    wr = min(WIN_ROWS, rows)
    r = np.arange(rows)
    row_start = np.clip(r - wr // 2, 0, rows - wr)
    row_idx = row_start[:, None] + np.arange(wr)[None, :]
    col = np.arange(GRID_W)
    col_start = np.clip(col - WIN_COLS // 2, 0, GRID_W - WIN_COLS)
    col_mask = (col[None, :] >= col_start[:, None]) & (col[None, :] < col_start[:, None] + WIN_COLS)
    dr_idx = row_idx - r[:, None] + (WIN_ROWS - 1)
    dc_idx = np.clip(col[None, :] - col[:, None], -(WIN_COLS - 1), WIN_COLS - 1) + (WIN_COLS - 1)
    bias = rpb[:, dr_idx[:, None, :, None], dc_idx[None, :, None, :]]

    qg = q.reshape(B, rows, GRID_W, H, Dh)
    kg = k.reshape(B, rows, GRID_W, H, Dh)[:, row_idx]
    vg = v.reshape(B, rows, GRID_W, H, Dh)[:, row_idx]
    scale = HEAD_DIM ** -0.5
    s_loc = jnp.einsum('brqhd,brikhd->bhrqik', qg, kg).astype(jnp.float32) * scale + bias.astype(jnp.float32)
    s_loc = jnp.where(col_mask[:, None, :], s_loc, NEG_INF).reshape(B, H, rows, GRID_W, wr * GRID_W)
    s_ctx = jnp.einsum('brqhd,bchd->bhrqc', qg, k_ctx).astype(jnp.float32) * scale
    p = jax.nn.softmax(jnp.concatenate([s_loc, s_ctx], axis=-1), axis=-1).astype(v.dtype)
    n_loc = wr * GRID_W
    p_loc = p[..., :n_loc].reshape(B, H, rows, GRID_W, wr, GRID_W)
    out = (jnp.einsum('bhrqik,brikhd->brqhd', p_loc, vg)
           + jnp.einsum('bhrqc,bchd->brqhd', p[..., n_loc:], v_ctx))
    return out.reshape(B, S, H, Dh)


def context_attention(q, k, v):
    s = jnp.einsum('bqhd,bkhd->bhqk', q, k).astype(jnp.float32) * (HEAD_DIM ** -0.5)
    p = jax.nn.softmax(s, axis=-1).astype(v.dtype)
    return jnp.einsum('bhqk,bkhd->bqhd', p, v)


def context_kv(h_ctx, p):
    B, C, _ = h_ctx.shape
    k = (h_ctx @ p['w_in'][:, COL_K:COL_V] + p['b_in'][COL_K:COL_V]).reshape(B, C, NA_HEADS, HEAD_DIM)
    v = (h_ctx @ p['w_in'][:, COL_V:COL_G_HY] + p['b_in'][COL_V:COL_G_HY]).reshape(B, C, NA_HEADS, HEAD_DIM)
    return rmsnorm(k, p['k_norm_g']), v


def token_mixer(h, p, attend):
    B, L, _ = h.shape
    z = h @ p['w_in'] + p['b_in']
    q = rmsnorm(z[..., COL_Q:COL_K].reshape(B, L, NA_HEADS, HEAD_DIM), p['q_norm_g'])
    k = rmsnorm(z[..., COL_K:COL_V].reshape(B, L, NA_HEADS, HEAD_DIM), p['k_norm_g'])
    v = z[..., COL_V:COL_G_HY].reshape(B, L, NA_HEADS, HEAD_DIM)
    y_hy = hyena(z[..., COL_HY:COL_Q], p) @ p['w_hy_out']
    y_na = attend(q, k, v).reshape(B, L, D_NA) @ p['w_na_out']
    gate = jax.nn.sigmoid(z[..., COL_G_HY:N_PROJ].astype(jnp.float32)).astype(h.dtype)
    merged = gate[..., :D_MODEL] * y_hy + gate[..., D_MODEL:] * y_na
    return merged @ p['w_out']


def peer(h, p):
    B, L, D = h.shape
    T = B * L
    hf = h.reshape(T, D)
    q = (hf @ p['peer_w_q']).reshape(T, PEER_HEADS, 2, PEER_D_HALF)
    s = jnp.einsum('thpd,hpnd->thpn', q, p['peer_keys']).astype(jnp.float32)
    top_s, top_i = lax.top_k(s, PEER_TOPK)
    cand_s = (top_s[:, :, 0, :, None] + top_s[:, :, 1, None, :]).reshape(T, PEER_HEADS, PEER_TOPK * PEER_TOPK)
    cand_i = (top_i[:, :, 0, :, None] * PEER_N_KEYS + top_i[:, :, 1, None, :]).reshape(T, PEER_HEADS, PEER_TOPK * PEER_TOPK)
    best_s, best_pos = lax.top_k(cand_s, PEER_TOPK)
    idx = jnp.take_along_axis(cand_i, best_pos, axis=-1)
    g = jax.nn.softmax(best_s, axis=-1).astype(h.dtype)
    nb = T // PEER_BLOCK
    u_tab, v_tab = p['peer_u'], p['peer_v']

    def block(args):
        xb, ib, gb = args
        act = jax.nn.gelu(jnp.einsum('td,thkd->thk', xb, u_tab[ib]), approximate=False)
        return jnp.einsum('thk,thkd->td', gb * act, v_tab[ib])

    out = lax.map(block, (hf.reshape(nb, PEER_BLOCK, D),
                          idx.reshape(nb, PEER_BLOCK, PEER_HEADS, PEER_TOPK),
                          g.reshape(nb, PEER_BLOCK, PEER_HEADS, PEER_TOPK)))
    return out.reshape(B, L, D)


def setup_inputs(seed: int = 0) -> dict:
    key = jax.random.key(seed)
    ks = jax.random.split(key, 32)
    f32 = jnp.float32

    def nrm(k, shape, scale):
        return jax.random.normal(k, shape, f32) * scale

    Ld = DEPTH
    return {
        'x': nrm(ks[0], (BATCH, SEQ, D_MODEL), 1.0),
        'c': nrm(ks[1], (BATCH, D_MODEL), 1.0),
        'ctx': nrm(ks[2], (BATCH, CTX_LEN, D_MODEL), 1.0),
        'c_ctx': nrm(ks[3], (D_MODEL,), 1.0),
        'norm1_g': 1.0 + nrm(ks[4], (Ld, D_MODEL), 0.02),
        'norm2_g': 1.0 + nrm(ks[5], (Ld, D_MODEL), 0.02),
        'w_ada': nrm(ks[6], (Ld, D_MODEL, N_MOD * D_MODEL), D_MODEL ** -0.5),
        'b_ada': nrm(ks[7], (Ld, N_MOD * D_MODEL), 0.02),
        'w_in': nrm(ks[8], (Ld, D_MODEL, N_PROJ), D_MODEL ** -0.5),
        'b_in': nrm(ks[9], (Ld, N_PROJ), 0.02),
        'hy_conv_w': nrm(ks[10], (Ld, 3, 3 * D_HY), 3 ** -0.5),
        'hy_conv_b': nrm(ks[11], (Ld, 3 * D_HY), 0.02),
        'hy_f1_w': nrm(ks[12], (Ld, HY_EMB, HY_FFN), HY_EMB ** -0.5),
        'hy_f1_b': nrm(ks[13], (Ld, HY_FFN), 0.02),
        'hy_f2_w': nrm(ks[14], (Ld, HY_FFN, HY_FFN), HY_FFN ** -0.5),
        'hy_f2_b': nrm(ks[15], (Ld, HY_FFN), 0.02),
        'hy_f3_w': nrm(ks[16], (Ld, HY_FFN, HY_FFN), HY_FFN ** -0.5),
        'hy_f3_b': nrm(ks[17], (Ld, HY_FFN), 0.02),
        'hy_f4_w': nrm(ks[18], (Ld, HY_FFN, HY_ORDER * 2 * D_HY), HY_FFN ** -0.5),
        'hy_sin_freq': 1.0 + nrm(ks[19], (Ld, HY_FFN), 0.02),
        'hy_skip': nrm(ks[20], (Ld, HY_ORDER, D_HY), 0.5),
        'q_norm_g': 1.0 + nrm(ks[21], (Ld, HEAD_DIM), 0.02),
        'k_norm_g': 1.0 + nrm(ks[22], (Ld, HEAD_DIM), 0.02),
        'na_rpb': nrm(ks[23], (Ld, NA_HEADS, 2 * WIN_ROWS - 1, 2 * WIN_COLS - 1), 0.02),
        'w_hy_out': nrm(ks[24], (Ld, D_HY, D_MODEL), D_HY ** -0.5),
        'w_na_out': nrm(ks[25], (Ld, D_NA, D_MODEL), D_NA ** -0.5),
        'w_out': nrm(ks[26], (Ld, D_MODEL, D_MODEL), D_MODEL ** -0.5),
        'peer_w_q': nrm(ks[27], (Ld, D_MODEL, PEER_HEADS * PEER_D_KEY), D_MODEL ** -0.5),
        'peer_keys': nrm(ks[28], (Ld, PEER_HEADS, 2, PEER_N_KEYS, PEER_D_HALF), PEER_D_HALF ** -0.5),
        'peer_u': nrm(ks[29], (Ld, PEER_N_EXPERTS, D_MODEL), D_MODEL ** -0.5),
        'peer_v': nrm(ks[30], (Ld, PEER_N_EXPERTS, D_MODEL), 0.5),
    }


def reference(x, c, ctx, c_ctx, norm1_g, norm2_g, w_ada, b_ada, w_in, b_in, hy_conv_w, hy_conv_b,
              hy_f1_w, hy_f1_b, hy_f2_w, hy_f2_b, hy_f3_w, hy_f3_b, hy_f4_w, hy_sin_freq, hy_skip,
              q_norm_g, k_norm_g, na_rpb, w_hy_out, w_na_out, w_out, peer_w_q, peer_keys, peer_u, peer_v):
    for layer in range(DEPTH):
        p = {
            'norm1_g': norm1_g[layer], 'norm2_g': norm2_g[layer],
            'w_ada': w_ada[layer], 'b_ada': b_ada[layer],
            'w_in': w_in[layer], 'b_in': b_in[layer],
            'hy_conv_w': hy_conv_w[layer], 'hy_conv_b': hy_conv_b[layer],
            'hy_f1_w': hy_f1_w[layer], 'hy_f1_b': hy_f1_b[layer],
            'hy_f2_w': hy_f2_w[layer], 'hy_f2_b': hy_f2_b[layer],
            'hy_f3_w': hy_f3_w[layer], 'hy_f3_b': hy_f3_b[layer],
            'hy_f4_w': hy_f4_w[layer], 'hy_sin_freq': hy_sin_freq[layer], 'hy_skip': hy_skip[layer],
            'q_norm_g': q_norm_g[layer], 'k_norm_g': k_norm_g[layer], 'na_rpb': na_rpb[layer],
            'w_hy_out': w_hy_out[layer], 'w_na_out': w_na_out[layer], 'w_out': w_out[layer],
            'peer_w_q': peer_w_q[layer], 'peer_keys': peer_keys[layer],
            'peer_u': peer_u[layer], 'peer_v': peer_v[layer],
        }
        m_lat = adaln(c, p)
        m_ctx = adaln(c_ctx, p)
        sh1, sc1, g1, sh2, sc2, g2 = [m_lat[:, i:i + 1] for i in range(N_MOD)]
        ch1, cs1, cg1, ch2, cs2, cg2 = [m_ctx[i:i + 1] for i in range(N_MOD)]

        h_ctx = modulate(ctx, p['norm1_g'], ch1, cs1)
        k_ctx, v_ctx = context_kv(h_ctx, p)

        def attend_latent(q, k, v, k_ctx=k_ctx, v_ctx=v_ctx, rpb=p['na_rpb']):
            return neighbourhood_attention(axial_rope(q), axial_rope(k), v, k_ctx, v_ctx, rpb)

        h = modulate(x, p['norm1_g'], sh1, sc1)
        x_next = x + g1 * token_mixer(h, p, attend_latent)
        x_next = x_next + g2 * peer(modulate(x_next, p['norm2_g'], sh2, sc2), p)

        if layer + 1 < DEPTH:
            ctx_next = ctx + cg1 * token_mixer(h_ctx, p, context_attention)
            ctx = ctx_next + cg2 * peer(modulate(ctx_next, p['norm2_g'], ch2, cs2), p)
        x = x_next
    return x
```

```cpp
#include <hip/hip_runtime.h>
#include <cstdio>
#include <cstdint>
#include <cmath>

typedef unsigned short bf16_t;
typedef short bf16x8 __attribute__((ext_vector_type(8)));
typedef float f32x4 __attribute__((ext_vector_type(4)));

constexpr int DM = 1024, BATCH = 2, SEQ = 8192, T = BATCH * SEQ;
constexpr int GRID_W = 64, CTX = 256;
constexpr int D_HY = 512, HY_FFN = 64, HY_EMB = 33;
constexpr int NH = 8, HD = 64, D_NA = 512;
constexpr int NPROJ = 5120;
constexpr int PH = 8, PNK = 128, PTOPK = 16, PDK = 256, PDH = 128;
constexpr float EPS = 1e-6f;

constexpr size_t MiB = 1u << 20;
constexpr size_t WS_WIN_T = 0;
constexpr size_t WS_WHY_T = 10 * MiB;
constexpr size_t WS_WNA_T = 11 * MiB;
constexpr size_t WS_WOUT_T = 12 * MiB;
constexpr size_t WS_WQ_T = 14 * MiB;
constexpr size_t WS_MOD = 18 * MiB;
constexpr size_t WS_HCTX = 19 * MiB;
constexpr size_t WS_KCTX = 20 * MiB;
constexpr size_t WS_VCTXT = 21 * MiB;
constexpr size_t WS_H3 = 22 * MiB;
constexpr size_t WS_FSUM = 24 * MiB;
constexpr size_t WS_XN = 26 * MiB;
constexpr size_t WS_ZT = 58 * MiB;
constexpr size_t WS_ZN = 122 * MiB;
constexpr size_t WS_HYO = 218 * MiB;
constexpr size_t WS_NAO = 234 * MiB;
constexpr size_t WS_END = 250 * MiB;

__device__ __forceinline__ bf16_t f2bf(float f) { unsigned u = __builtin_bit_cast(unsigned, f); return (bf16_t)((u + 0x7fffu + ((u >> 16) & 1u)) >> 16); }
__device__ __forceinline__ float bf2f(bf16_t h) { return __builtin_bit_cast(float, (unsigned)h << 16); }
__device__ __forceinline__ float wave_sum(float v) {
#pragma unroll
    for (int o = 32; o > 0; o >>= 1) v += __shfl_xor(v, o);
    return v;
}
__device__ __forceinline__ float wave_max(float v) {
#pragma unroll
    for (int o = 32; o > 0; o >>= 1) v = fmaxf(v, __shfl_xor(v, o));
    return v;
}
__device__ __forceinline__ void wave_argmax(float& v, int& idx) {
#pragma unroll
    for (int o = 32; o > 0; o >>= 1) { const float ov = __shfl_xor(v, o); const int oi = __shfl_xor(idx, o); if (ov > v || (ov == v && oi < idx)) { v = ov; idx = oi; } }
}

__device__ __forceinline__ int win_logical(int p) { return p < 1536 ? p : (p < 2048 ? p + 1024 : (p < 3072 ? p - 512 : p)); }
__global__ void __launch_bounds__(256) k_transpose(const float* W, int K, int N, bf16_t* WT, int mode) {
    __shared__ float tile[32][33];
    const int p0 = blockIdx.x * 32, k0 = blockIdx.y * 32, tx = threadIdx.x & 31, ty = threadIdx.x >> 5;
    const int l0 = mode ? win_logical(p0) : p0;
    for (int i = ty; i < 32; i += 8) tile[i][tx] = W[(size_t)(k0 + i) * N + l0 + tx];
    __syncthreads();
    for (int i = ty; i < 32; i += 8) WT[(size_t)(p0 + i) * K + k0 + tx] = f2bf(tile[tx][i]);
}

__global__ void __launch_bounds__(256) k_adaln(const float* c, const float* c_ctx, const float* w_ada, const float* b_ada, float* mod) {
    __shared__ float sc[3][1024];
    __shared__ float part[4][3][64];
    for (int i = threadIdx.x; i < 3 * 1024; i += 256) { const int v = i >> 10, k = i & 1023; const float x = v < 2 ? c[v * 1024 + k] : c_ctx[k]; sc[v][k] = x / (1.f + expf(-x)); }
    __syncthreads();
    const int jl = threadIdx.x & 63, kq = threadIdx.x >> 6, j = blockIdx.x * 64 + jl;
    float a0 = 0.f, a1 = 0.f, a2 = 0.f;
    for (int k = kq * 256; k < kq * 256 + 256; ++k) { const float w = w_ada[(size_t)k * 6144 + j]; a0 += sc[0][k] * w; a1 += sc[1][k] * w; a2 += sc[2][k] * w; }
    part[kq][0][jl] = a0; part[kq][1][jl] = a1; part[kq][2][jl] = a2;
    __syncthreads();
    if (threadIdx.x < 192) { const int v = threadIdx.x >> 6, jj = threadIdx.x & 63; const int jo = blockIdx.x * 64 + jj;
        mod[v * 6144 + jo] = b_ada[jo] + part[0][v][jj] + part[1][v][jj] + part[2][v][jj] + part[3][v][jj]; }
}

__global__ void __launch_bounds__(256) k_modulate(const float* x, int nrows, const float* g, const float* mod, int shift_chunk, int rows_per_vec, int vec0, bf16_t* out) {
    const int row = blockIdx.x * 4 + (threadIdx.x >> 6), lane = threadIdx.x & 63;
    if (row >= nrows) return;
    const int v = vec0 + (rows_per_vec > 0 ? row / rows_per_vec : 0);
    const float* sh = mod + v * 6144 + shift_chunk * 1024; const float* scl = sh + 1024;
    const f32x4* xr = (const f32x4*)(x + (size_t)row * DM) + lane;
    f32x4 xv[4]; float s = 0.f;
#pragma unroll
    for (int j = 0; j < 4; ++j) { xv[j] = xr[64 * j]; s += xv[j].x * xv[j].x + xv[j].y * xv[j].y + xv[j].z * xv[j].z + xv[j].w * xv[j].w; }
    const float rstd = 1.f / sqrtf(wave_sum(s) * (1.f / DM) + EPS);
#pragma unroll
    for (int j = 0; j < 4; ++j) { const int c0 = 4 * lane + 256 * j;
        const f32x4 gv = *(const f32x4*)(g + c0), sv = *(const f32x4*)(sh + c0), cv = *(const f32x4*)(scl + c0);
        const float o0 = xv[j].x * rstd * gv.x * (1.f + cv.x) + sv.x, o1 = xv[j].y * rstd * gv.y * (1.f + cv.y) + sv.y;
        const float o2 = xv[j].z * rstd * gv.z * (1.f + cv.z) + sv.z, o3 = xv[j].w * rstd * gv.w * (1.f + cv.w) + sv.w;
        ushort4 o; o.x = f2bf(o0); o.y = f2bf(o1); o.z = f2bf(o2); o.w = f2bf(o3);
        *(ushort4*)(out + (size_t)row * DM + c0) = o; }
}

template <class Epi, bool DUAL>
__global__ void __launch_bounds__(256) k_gemm(const bf16_t* A, const bf16_t* Bt, int K, const bf16_t* A2, const bf16_t* Bt2, int K2, Epi epi) {
    const int wid = threadIdx.x >> 6, lane = threadIdx.x & 63, fr = lane & 15, fq = lane >> 4;
    const int row0 = blockIdx.y * 128 + (wid >> 1) * 64, col0 = blockIdx.x * 128 + (wid & 1) * 64;
    f32x4 acc[4][4], acc2[4][4];
#pragma unroll
    for (int m = 0; m < 4; ++m)
#pragma unroll
        for (int n = 0; n < 4; ++n) { acc[m][n] = (f32x4){0.f, 0.f, 0.f, 0.f}; acc2[m][n] = (f32x4){0.f, 0.f, 0.f, 0.f}; }
    for (int k0 = 0; k0 < K; k0 += 32) {
        bf16x8 a[4], b[4];
#pragma unroll
        for (int m = 0; m < 4; ++m) a[m] = *(const bf16x8*)(A + (size_t)(row0 + m * 16 + fr) * K + k0 + fq * 8);
#pragma unroll
        for (int n = 0; n < 4; ++n) b[n] = *(const bf16x8*)(Bt + (size_t)(col0 + n * 16 + fr) * K + k0 + fq * 8);
#pragma unroll
        for (int m = 0; m < 4; ++m)
#pragma unroll
            for (int n = 0; n < 4; ++n) acc[m][n] = __builtin_amdgcn_mfma_f32_16x16x32_bf16(a[m], b[n], acc[m][n], 0, 0, 0);
    }
    if (DUAL) {
        for (int k0 = 0; k0 < K2; k0 += 32) {
            bf16x8 a[4], b[4];
#pragma unroll
            for (int m = 0; m < 4; ++m) a[m] = *(const bf16x8*)(A2 + (size_t)(row0 + m * 16 + fr) * K2 + k0 + fq * 8);
#pragma unroll
            for (int n = 0; n < 4; ++n) b[n] = *(const bf16x8*)(Bt2 + (size_t)(col0 + n * 16 + fr) * K2 + k0 + fq * 8);
#pragma unroll
            for (int m = 0; m < 4; ++m)
#pragma unroll
                for (int n = 0; n < 4; ++n) acc2[m][n] = __builtin_amdgcn_mfma_f32_16x16x32_bf16(a[m], b[n], acc2[m][n], 0, 0, 0);
        }
    }
#pragma unroll
    for (int m = 0; m < 4; ++m)
#pragma unroll
        for (int n = 0; n < 4; ++n)
#pragma unroll
            for (int j = 0; j < 4; ++j) epi(row0 + m * 16 + fq * 4 + j, col0 + n * 16 + fr, acc[m][n][j], acc2[m][n][j]);
}

struct EpiZT {
    bf16_t* ZT; const float* b_in;
    __device__ __forceinline__ void operator()(int r, int c, float v, float) const { ZT[(size_t)r * T + c] = f2bf(v + b_in[r < 1536 ? r : r + 1024]); }
};
struct EpiZN {
    bf16_t* ZN; const float* b_in;
    __device__ __forceinline__ void operator()(int r, int c, float v, float) const {
        const int lc = c < 1024 ? c + 1536 : c + 2048; float o = v + b_in[lc];
        if (c >= 1024) o = 1.f / (1.f + expf(-o));
        ZN[(size_t)r * 3072 + c] = f2bf(o); }
};
struct EpiKctx {
    bf16_t* KC; const float* b_in;
    __device__ __forceinline__ void operator()(int r, int c, float v, float) const { KC[(size_t)r * 512 + c] = f2bf(v + b_in[2048 + c]); }
};
struct EpiVctxT {
    bf16_t* VT; const float* b_in;
    __device__ __forceinline__ void operator()(int r, int c, float v, float) const { VT[(size_t)r * 512 + c] = f2bf(v + b_in[2560 + r]); }
};
struct EpiMerged {
    bf16_t* MG; const bf16_t* ZN;
    __device__ __forceinline__ void operator()(int r, int c, float v, float v2) const {
        const float gh = bf2f(ZN[(size_t)r * 3072 + 1024 + c]), gn = bf2f(ZN[(size_t)r * 3072 + 2048 + c]);
        MG[(size_t)r * DM + c] = f2bf(gh * v + gn * v2); }
};
struct EpiOut {
    float* X1; const float* x; const float* mod;
    __device__ __forceinline__ void operator()(int r, int c, float v, float) const { const int b = r / SEQ; X1[(size_t)r * DM + c] = x[(size_t)r * DM + c] + mod[b * 6144 + 2 * 1024 + c] * v; }
};
struct EpiQP {
    bf16_t* QP;
    __device__ __forceinline__ void operator()(int r, int c, float v, float) const { QP[(size_t)r * 2048 + c] = f2bf(v); }
};

__global__ void __launch_bounds__(256) k_headnorm(bf16_t* buf, int ld, int col0, int nrows, const float* g, int rope) {
    const int gi = blockIdx.x * 256 + threadIdx.x; if (gi >= nrows * NH) return;
    const int row = gi / NH, h = gi % NH;
    bf16_t* p = buf + (size_t)row * ld + col0 + h * HD;
    float v[64]; float s = 0.f;
#pragma unroll
    for (int i = 0; i < 64; ++i) { v[i] = bf2f(p[i]); s += v[i] * v[i]; }
    const float rstd = 1.f / sqrtf(s * (1.f / 64.f) + EPS);
#pragma unroll
    for (int i = 0; i < 64; ++i) v[i] = v[i] * rstd * g[i];
    if (rope) {
        const int pos = row % SEQ; const float pr = (float)(pos / GRID_W), pc = (float)(pos % GRID_W);
#pragma unroll
        for (int i = 0; i < 16; ++i) {
            const float inv = expf(-(float)i * 0.5756462732485114f);
            float sn, cs; sincosf(pr * inv, &sn, &cs);
            const float a = v[i], b = v[16 + i]; v[i] = a * cs - b * sn; v[16 + i] = a * sn + b * cs;
            sincosf(pc * inv, &sn, &cs);
            const float a2 = v[32 + i], b2 = v[48 + i]; v[32 + i] = a2 * cs - b2 * sn; v[48 + i] = a2 * sn + b2 * cs;
        }
    }
#pragma unroll
    for (int i = 0; i < 64; ++i) p[i] = f2bf(v[i]);
}

__global__ void __launch_bounds__(256) k_filter_mlp(const float* f1w, const float* f1b, const float* f2w, const float* f2b, const float* f3w, const float* f3b, const float* freq, float* h3) {
    __shared__ float hA[64][65], hB[64][65];
    const int tl = threadIdx.x & 63, part = __builtin_amdgcn_readfirstlane(threadIdx.x >> 6), t = blockIdx.x * 64 + tl;
    {
        const float tt = (float)t / (float)(SEQ - 1), w = (6.283185307179586f / (float)SEQ) * (float)t;
        if (part == 0) hA[0][tl] = tt;
        for (int k = part * 4; k < part * 4 + 4; ++k) { const float band = 1e-4f + (float)k * ((15.f - 1e-4f) / 15.f); float sn, cs; sincosf(band * w, &sn, &cs); hA[1 + k][tl] = cs; hA[17 + k][tl] = -sn; }
    }
    __syncthreads();
    float acc[16];
#pragma unroll
    for (int o = 0; o < 16; ++o) acc[o] = f1b[part * 16 + o];
    for (int i = 0; i < HY_EMB; ++i) { const float x = hA[i][tl];
#pragma unroll
        for (int o = 0; o < 16; ++o) acc[o] += x * f1w[i * 64 + part * 16 + o]; }
#pragma unroll
    for (int o = 0; o < 16; ++o) hB[part * 16 + o][tl] = sinf(freq[part * 16 + o] * acc[o]);
    __syncthreads();
#pragma unroll
    for (int o = 0; o < 16; ++o) acc[o] = f2b[part * 16 + o];
    for (int i = 0; i < 64; ++i) { const float x = hB[i][tl];
#pragma unroll
        for (int o = 0; o < 16; ++o) acc[o] += x * f2w[i * 64 + part * 16 + o]; }
    __syncthreads();
#pragma unroll
    for (int o = 0; o < 16; ++o) hA[part * 16 + o][tl] = sinf(freq[part * 16 + o] * acc[o]);
    __syncthreads();
#pragma unroll
    for (int o = 0; o < 16; ++o) acc[o] = f3b[part * 16 + o];
    for (int i = 0; i < 64; ++i) { const float x = hA[i][tl];
#pragma unroll
        for (int o = 0; o < 16; ++o) acc[o] += x * f3w[i * 64 + part * 16 + o]; }
#pragma unroll
    for (int o = 0; o < 16; ++o) h3[(size_t)t * 64 + part * 16 + o] = sinf(freq[part * 16 + o] * acc[o]);
}

__global__ void __launch_bounds__(256) k_filter_fin(const float* h3, const float* f4w, float* FILT) {
    __shared__ float w4[64][4];
    __shared__ float red[2][4];
    const int d = blockIdx.x, tid = threadIdx.x, lane = tid & 63, wid = tid >> 6;
    { const int i = tid >> 2, q = tid & 3; w4[i][q] = f4w[(size_t)i * 2048 + q * 512 + d]; }
    __syncthreads();
    const float a = -4.605170185988091f / 1.5f, bq = -4.605170185988091f / 0.3f;
    const float delta = fabsf(a + (float)d * ((bq - a) / 511.f));
    float s0 = 0.f, s1 = 0.f;
#pragma unroll 1
    for (int t = tid; t < SEQ; t += 256) {
        const f32x4* hr = (const f32x4*)(h3 + (size_t)t * 64);
        float v0 = 0.f, v1 = 0.f, v2 = 0.f, v3 = 0.f;
#pragma unroll
        for (int i4 = 0; i4 < 16; ++i4) { const f32x4 hv = hr[i4];
            v0 += hv.x * w4[4 * i4][0] + hv.y * w4[4 * i4 + 1][0] + hv.z * w4[4 * i4 + 2][0] + hv.w * w4[4 * i4 + 3][0];
            v1 += hv.x * w4[4 * i4][1] + hv.y * w4[4 * i4 + 1][1] + hv.z * w4[4 * i4 + 2][1] + hv.w * w4[4 * i4 + 3][1];
            v2 += hv.x * w4[4 * i4][2] + hv.y * w4[4 * i4 + 1][2] + hv.z * w4[4 * i4 + 2][2] + hv.w * w4[4 * i4 + 3][2];
            v3 += hv.x * w4[4 * i4][3] + hv.y * w4[4 * i4 + 1][3] + hv.z * w4[4 * i4 + 2][3] + hv.w * w4[4 * i4 + 3][3]; }
        const float tt = (float)t / (float)(SEQ - 1), dec = expf(-tt * delta);
        v0 *= dec; v1 *= dec; v2 *= dec; v3 *= dec;
        s0 += fabsf(v0) + fabsf(v1); s1 += fabsf(v2) + fabsf(v3);
        FILT[((size_t)(0 * 512 + d) * 2 + 0) * SEQ + t] = v0; FILT[((size_t)(0 * 512 + d) * 2 + 1) * SEQ + t] = v1;
        FILT[((size_t)(1 * 512 + d) * 2 + 0) * SEQ + t] = v2; FILT[((size_t)(1 * 512 + d) * 2 + 1) * SEQ + t] = v3;
    }
    s0 = wave_sum(s0); s1 = wave_sum(s1);
    if (lane == 0) { red[0][wid] = s0; red[1][wid] = s1; }
    __syncthreads();
    const float r0 = 1.f / (red[0][0] + red[0][1] + red[0][2] + red[0][3]), r1 = 1.f / (red[1][0] + red[1][1] + red[1][2] + red[1][3]);
    for (int t = tid; t < SEQ; t += 256) {
        FILT[((size_t)(0 * 512 + d) * 2 + 0) * SEQ + t] *= r0; FILT[((size_t)(0 * 512 + d) * 2 + 1) * SEQ + t] *= r0;
        FILT[((size_t)(1 * 512 + d) * 2 + 0) * SEQ + t] *= r1; FILT[((size_t)(1 * 512 + d) * 2 + 1) * SEQ + t] *= r1;
    }
}

__device__ __forceinline__ float shortconv(const bf16_t* row, int t, float w0, float w1, float w2, float cb) {
    const float zm = t > 0 ? bf2f(row[t - 1]) : 0.f, z0 = bf2f(row[t]), zp = t < SEQ - 1 ? bf2f(row[t + 1]) : 0.f;
    return w0 * zm + w1 * z0 + w2 * zp + cb;
}
__global__ void __launch_bounds__(512) k_hyena(const bf16_t* ZT, const float* FILT, const float* cw, const float* cb, const float* skip, bf16_t* HYO) {
    extern __shared__ __attribute__((aligned(16))) float sm[];
    float* y = sm;
    float* kf = sm + SEQ;
    const int d = blockIdx.x & 511, b = blockIdx.x >> 9, tid = threadIdx.x;
    const bf16_t* vrow = ZT + (size_t)d * T + (size_t)b * SEQ;
    const bf16_t* x1row = ZT + (size_t)(512 + d) * T + (size_t)b * SEQ;
    const bf16_t* x2row = ZT + (size_t)(1024 + d) * T + (size_t)b * SEQ;
    for (int t = tid; t < SEQ; t += 512) y[t] = shortconv(vrow, t, cw[d], cw[1536 + d], cw[3072 + d], cb[d]);
    for (int o = 0; o < 2; ++o) {
        const float* fw = FILT + ((size_t)(o * 512 + d) * 2 + 0) * SEQ; const float* bw = fw + SEQ;
        for (int j = tid; j < SEQ; j += 512) { kf[8192 + j] = fw[j]; if (j > 0) kf[8192 - j] = bw[j]; }
        if (tid == 0) kf[0] = 0.f;
        __syncthreads();
        float acc[16];
#pragma unroll
        for (int i = 0; i < 16; ++i) acc[i] = 0.f;
        const float* kb = kf + tid + 8192;
        for (int s = 0; s < SEQ; ++s) {
            const float ys = y[s];
#pragma unroll
            for (int i = 0; i < 16; ++i) acc[i] += ys * kb[512 * i - s];
        }
        const bf16_t* grow = o == 0 ? x1row : x2row; const int gc = (o == 0 ? 512 : 1024) + d;
        const float w0 = cw[gc], w1 = cw[1536 + gc], w2 = cw[3072 + gc], gb = cb[gc], sk = skip[o * 512 + d];
        float yn[16];
#pragma unroll
        for (int i = 0; i < 16; ++i) { const int t = tid + 512 * i; yn[i] = shortconv(grow, t, w0, w1, w2, gb) * (acc[i] + sk * y[t]); }
        __syncthreads();
        if (o == 0) {
#pragma unroll
            for (int i = 0; i < 16; ++i) y[tid + 512 * i] = yn[i];
        } else {
#pragma unroll
            for (int i = 0; i < 16; ++i) HYO[((size_t)b * SEQ + tid + 512 * i) * D_HY + d] = f2bf(yn[i]);
        }
        __syncthreads();
    }
}

__global__ void __launch_bounds__(256) k_natten(const bf16_t* ZN, const bf16_t* ZT, const bf16_t* KC, const bf16_t* VCT, const float* rpb, bf16_t* NAO) {
    __shared__ float scs[4][384];
    const int wid = threadIdx.x >> 6, lane = threadIdx.x & 63;
    const int gw = blockIdx.x * 4 + wid;
    const int t = gw >> 3, h = gw & 7, b = t / SEQ, pos = t % SEQ, r = pos / GRID_W, c = pos % GRID_W;
    int rs = r - 4; rs = rs < 0 ? 0 : (rs > 120 ? 120 : rs);
    int cs = c - 8; cs = cs < 0 ? 0 : (cs > 48 ? 48 : cs);
    const float q = bf2f(ZN[(size_t)t * 3072 + h * HD + lane]);
    float* sc = scs[wid];
    for (int i = 0; i < 8; ++i)
        for (int kc = cs; kc < cs + 16; ++kc) {
            const int tk = b * SEQ + (rs + i) * GRID_W + kc;
            const float kv = bf2f(ZN[(size_t)tk * 3072 + 512 + h * HD + lane]);
            float s = wave_sum(q * kv) * 0.125f;
            int dc = kc - c; dc = dc < -15 ? -15 : (dc > 15 ? 15 : dc);
            s += rpb[(h * 15 + (rs + i - r + 7)) * 31 + dc + 15];
            if (lane == 0) sc[i * 16 + (kc - cs)] = s;
        }
    for (int j = 0; j < CTX; ++j) {
        const float kv = bf2f(KC[(size_t)(b * CTX + j) * 512 + h * HD + lane]);
        const float s = wave_sum(q * kv) * 0.125f;
        if (lane == 0) sc[128 + j] = s;
    }
    __builtin_amdgcn_s_waitcnt(0);
    float mx = -INFINITY;
#pragma unroll
    for (int k = 0; k < 6; ++k) mx = fmaxf(mx, sc[lane + 64 * k]);
    mx = wave_max(mx);
    float pv[6], sum = 0.f;
#pragma unroll
    for (int k = 0; k < 6; ++k) { pv[k] = expf(sc[lane + 64 * k] - mx); sum += pv[k]; }
    sum = wave_sum(sum); const float rinv = 1.f / sum;
#pragma unroll
    for (int k = 0; k < 6; ++k) sc[lane + 64 * k] = pv[k] * rinv;
    __builtin_amdgcn_s_waitcnt(0);
    float o = 0.f;
    const bf16_t* vrow = ZT + (size_t)(1536 + h * HD + lane) * T;
    for (int i = 0; i < 8; ++i)
        for (int kk = 0; kk < 16; ++kk) { const int tk = b * SEQ + (rs + i) * GRID_W + cs + kk; o += sc[i * 16 + kk] * bf2f(vrow[tk]); }
    const bf16_t* vcrow = VCT + (size_t)(h * HD + lane) * 512 + b * CTX;
    for (int j = 0; j < CTX; ++j) o += sc[128 + j] * bf2f(vcrow[j]);
    NAO[(size_t)t * D_NA + h * HD + lane] = f2bf(o);
}

__global__ void __launch_bounds__(512) k_peer(const bf16_t* QP, const bf16_t* H2, const float* keys, const float* pu, const float* pv, const float* mod, float* out) {
    __shared__ float qs[8][256];
    __shared__ float part[8][1024];
    const int t = blockIdx.x, h = threadIdx.x >> 6, lane = threadIdx.x & 63, b = t / SEQ;
    for (int i = lane; i < 256; i += 64) qs[h][i] = bf2f(QP[(size_t)t * 2048 + h * 256 + i]);
    __builtin_amdgcn_s_waitcnt(0);
    float s00 = 0.f, s01 = 0.f, s10 = 0.f, s11 = 0.f;
    {
        const float* k00 = keys + ((size_t)(h * 2 + 0) * PNK + lane) * PDH; const float* k01 = k00 + 64 * PDH;
        const float* k10 = keys + ((size_t)(h * 2 + 1) * PNK + lane) * PDH; const float* k11 = k10 + 64 * PDH;
#pragma unroll 2
        for (int d4 = 0; d4 < 32; ++d4) {
            const f32x4 a = *(const f32x4*)(k00 + 4 * d4), bq = *(const f32x4*)(k01 + 4 * d4), cq = *(const f32x4*)(k10 + 4 * d4), dq = *(const f32x4*)(k11 + 4 * d4);
            const float q0 = qs[h][4 * d4], q1 = qs[h][4 * d4 + 1], q2 = qs[h][4 * d4 + 2], q3 = qs[h][4 * d4 + 3];
            const float r0 = qs[h][128 + 4 * d4], r1 = qs[h][128 + 4 * d4 + 1], r2 = qs[h][128 + 4 * d4 + 2], r3 = qs[h][128 + 4 * d4 + 3];
            s00 += a.x * q0 + a.y * q1 + a.z * q2 + a.w * q3; s01 += bq.x * q0 + bq.y * q1 + bq.z * q2 + bq.w * q3;
            s10 += cq.x * r0 + cq.y * r1 + cq.z * r2 + cq.w * r3; s11 += dq.x * r0 + dq.y * r1 + dq.z * r2 + dq.w * r3;
        }
    }
    float a0s = 0.f, a1s = 0.f; int a0i = 0, a1i = 0;
    for (int k = 0; k < PTOPK; ++k) {
        float v = s00 >= s01 ? s00 : s01; int idx = s00 >= s01 ? lane : lane + 64;
        wave_argmax(v, idx);
        if (lane == (idx & 63)) { if (idx < 64) s00 = -INFINITY; else s01 = -INFINITY; }
        if (lane == k) { a0s = v; a0i = idx; }
    }
    for (int k = 0; k < PTOPK; ++k) {
        float v = s10 >= s11 ? s10 : s11; int idx = s10 >= s11 ? lane : lane + 64;
        wave_argmax(v, idx);
        if (lane == (idx & 63)) { if (idx < 64) s10 = -INFINITY; else s11 = -INFINITY; }
        if (lane == k) { a1s = v; a1i = idx; }
    }
    float c0, c1, c2, c3;
    { const float ai = __shfl(a0s, lane >> 2); const int jb = (lane & 3) * 4;
      c0 = ai + __shfl(a1s, jb); c1 = ai + __shfl(a1s, jb + 1); c2 = ai + __shfl(a1s, jb + 2); c3 = ai + __shfl(a1s, jb + 3); }
    float bs = -INFINITY; int bc = 0;
    for (int k = 0; k < PTOPK; ++k) {
        float v = c0; int idx = lane * 4;
        if (c1 > v) { v = c1; idx = lane * 4 + 1; }
        if (c2 > v) { v = c2; idx = lane * 4 + 2; }
        if (c3 > v) { v = c3; idx = lane * 4 + 3; }
        wave_argmax(v, idx);
        if (lane == (idx >> 2)) { const int e = idx & 3; if (e == 0) c0 = -INFINITY; else if (e == 1) c1 = -INFINITY; else if (e == 2) c2 = -INFINITY; else c3 = -INFINITY; }
        if (lane == k) { bs = v; bc = idx; }
    }
    const int ei = __shfl(a0i, bc >> 4) * PNK + __shfl(a1i, bc & 15);
    const float mx = wave_max(bs);
    const float ex = lane < PTOPK ? expf(bs - mx) : 0.f;
    const float g = ex / wave_sum(ex);
    f32x4 hx[4], oacc[4];
#pragma unroll
    for (int j = 0; j < 4; ++j) { const ushort4 hv = *(const ushort4*)(H2 + (size_t)t * DM + 4 * lane + 256 * j); hx[j] = (f32x4){bf2f(hv.x), bf2f(hv.y), bf2f(hv.z), bf2f(hv.w)}; oacc[j] = (f32x4){0.f, 0.f, 0.f, 0.f}; }
#pragma unroll 1
    for (int k = 0; k < PTOPK; ++k) {
        const int e = __builtin_amdgcn_readfirstlane(__shfl(ei, k)); const float gk = __shfl(g, k);
        const f32x4* ur = (const f32x4*)(pu + (size_t)e * DM) + lane; const f32x4* vr = (const f32x4*)(pv + (size_t)e * DM) + lane;
        float dsum = 0.f;
#pragma unroll
        for (int j = 0; j < 4; ++j) { const f32x4 uv = ur[64 * j]; dsum += uv.x * hx[j].x + uv.y * hx[j].y + uv.z * hx[j].z + uv.w * hx[j].w; }
        dsum = wave_sum(dsum);
        const float act = 0.5f * dsum * (1.f + erff(dsum * 0.7071067811865476f));
        const float cf = gk * act;
#pragma unroll
        for (int j = 0; j < 4; ++j) { const f32x4 vv = vr[64 * j]; oacc[j] += vv * cf; }
    }
#pragma unroll
    for (int j = 0; j < 4; ++j) *(f32x4*)(&part[h][4 * lane + 256 * j]) = oacc[j];
    __syncthreads();
    for (int cc = threadIdx.x; cc < DM; cc += 512) {
        float s = 0.f;
#pragma unroll
        for (int w = 0; w < 8; ++w) s += part[w][cc];
        out[(size_t)t * DM + cc] += mod[b * 6144 + 5 * 1024 + cc] * s;
    }
}

extern "C" void kernel_launch(void* const* d_in, const int* in_sizes, int n_in, void* d_out, int out_size, void* d_ws, size_t ws_size, hipStream_t stream) {
    const float* x = (const float*)d_in[0]; const float* c = (const float*)d_in[1]; const float* ctx = (const float*)d_in[2]; const float* c_ctx = (const float*)d_in[3];
    const float* norm1_g = (const float*)d_in[4]; const float* norm2_g = (const float*)d_in[5]; const float* w_ada = (const float*)d_in[6]; const float* b_ada = (const float*)d_in[7];
    const float* w_in = (const float*)d_in[8]; const float* b_in = (const float*)d_in[9]; const float* hy_conv_w = (const float*)d_in[10]; const float* hy_conv_b = (const float*)d_in[11];
    const float* f1w = (const float*)d_in[12]; const float* f1b = (const float*)d_in[13]; const float* f2w = (const float*)d_in[14]; const float* f2b = (const float*)d_in[15];
    const float* f3w = (const float*)d_in[16]; const float* f3b = (const float*)d_in[17]; const float* f4w = (const float*)d_in[18]; const float* freq = (const float*)d_in[19];
    const float* hy_skip = (const float*)d_in[20]; const float* q_norm_g = (const float*)d_in[21]; const float* k_norm_g = (const float*)d_in[22]; const float* na_rpb = (const float*)d_in[23];
    const float* w_hy_out = (const float*)d_in[24]; const float* w_na_out = (const float*)d_in[25]; const float* w_out = (const float*)d_in[26]; const float* peer_w_q = (const float*)d_in[27];
    const float* peer_keys = (const float*)d_in[28]; const float* peer_u = (const float*)d_in[29]; const float* peer_v = (const float*)d_in[30];
    float* out = (float*)d_out; unsigned char* ws = (unsigned char*)d_ws;
    if (ws_size < WS_END) { fprintf(stderr, "kernel_launch: workspace too small (%zu < %zu)\n", ws_size, (size_t)WS_END); return; }
    bf16_t* WIN_T = (bf16_t*)(ws + WS_WIN_T); bf16_t* WHY_T = (bf16_t*)(ws + WS_WHY_T); bf16_t* WNA_T = (bf16_t*)(ws + WS_WNA_T); bf16_t* WOUT_T = (bf16_t*)(ws + WS_WOUT_T); bf16_t* WQ_T = (bf16_t*)(ws + WS_WQ_T);
    float* MOD = (float*)(ws + WS_MOD); bf16_t* HCTX = (bf16_t*)(ws + WS_HCTX); bf16_t* KCTX = (bf16_t*)(ws + WS_KCTX); bf16_t* VCTXT = (bf16_t*)(ws + WS_VCTXT);
    float* H3 = (float*)(ws + WS_H3); bf16_t* XN = (bf16_t*)(ws + WS_XN); bf16_t* ZT = (bf16_t*)(ws + WS_ZT); bf16_t* ZN = (bf16_t*)(ws + WS_ZN);
    bf16_t* HYO = (bf16_t*)(ws + WS_HYO); bf16_t* NAO = (bf16_t*)(ws + WS_NAO);
    float* FILT = out;
    bf16_t* MG = XN; bf16_t* H2 = ZT; bf16_t* QP = ZN;

    static bool attr = false;
    if (!attr) { (void)hipFuncSetAttribute((const void*)k_hyena, hipFuncAttributeMaxDynamicSharedMemorySize, 98304); attr = true; }

    k_transpose<<<dim3(5120 / 32, 1024 / 32), 256, 0, stream>>>(w_in, 1024, NPROJ, WIN_T, 1);
    k_transpose<<<dim3(1024 / 32, 512 / 32), 256, 0, stream>>>(w_hy_out, 512, 1024, WHY_T, 0);
    k_transpose<<<dim3(1024 / 32, 512 / 32), 256, 0, stream>>>(w_na_out, 512, 1024, WNA_T, 0);
    k_transpose<<<dim3(1024 / 32, 1024 / 32), 256, 0, stream>>>(w_out, 1024, 1024, WOUT_T, 0);
    k_transpose<<<dim3(2048 / 32, 1024 / 32), 256, 0, stream>>>(peer_w_q, 1024, 2048, WQ_T, 0);
    k_adaln<<<96, 256, 0, stream>>>(c, c_ctx, w_ada, b_ada, MOD);
    k_filter_mlp<<<SEQ / 64, 256, 0, stream>>>(f1w, f1b, f2w, f2b, f3w, f3b, freq, H3);
    k_filter_fin<<<512, 256, 0, stream>>>(H3, f4w, FILT);
    k_modulate<<<T / 4, 256, 0, stream>>>(x, T, norm1_g, MOD, 0, SEQ, 0, XN);
    k_modulate<<<512 / 4, 256, 0, stream>>>(ctx, 512, norm1_g, MOD, 0, 0, 2, HCTX);
    { EpiZT e{ZT, b_in}; k_gemm<EpiZT, false><<<dim3(T / 128, 2048 / 128), 256, 0, stream>>>(WIN_T, XN, 1024, nullptr, nullptr, 0, e); }
    { EpiZN e{ZN, b_in}; k_gemm<EpiZN, false><<<dim3(3072 / 128, T / 128), 256, 0, stream>>>(XN, WIN_T + (size_t)2048 * 1024, 1024, nullptr, nullptr, 0, e); }
    { EpiKctx e{KCTX, b_in}; k_gemm<EpiKctx, false><<<dim3(512 / 128, 512 / 128), 256, 0, stream>>>(HCTX, WIN_T + (size_t)2560 * 1024, 1024, nullptr, nullptr, 0, e); }
    { EpiVctxT e{VCTXT, b_in}; k_gemm<EpiVctxT, false><<<dim3(512 / 128, 512 / 128), 256, 0, stream>>>(WIN_T + (size_t)1536 * 1024, HCTX, 1024, nullptr, nullptr, 0, e); }
    k_headnorm<<<(T * NH + 255) / 256, 256, 0, stream>>>(ZN, 3072, 0, T, q_norm_g, 1);
    k_headnorm<<<(T * NH + 255) / 256, 256, 0, stream>>>(ZN, 3072, 512, T, k_norm_g, 1);
    k_headnorm<<<(512 * NH + 255) / 256, 256, 0, stream>>>(KCTX, 512, 0, 512, k_norm_g, 0);
    k_hyena<<<1024, 512, 98304, stream>>>(ZT, FILT, hy_conv_w, hy_conv_b, hy_skip, HYO);
    k_natten<<<T * NH / 4, 256, 0, stream>>>(ZN, ZT, KCTX, VCTXT, na_rpb, NAO);
    { EpiMerged e{MG, ZN}; k_gemm<EpiMerged, true><<<dim3(1024 / 128, T / 128), 256, 0, stream>>>(HYO, WHY_T, 512, NAO, WNA_T, 512, e); }
    { EpiOut e{out, x, MOD}; k_gemm<EpiOut, false><<<dim3(1024 / 128, T / 128), 256, 0, stream>>>(MG, WOUT_T, 1024, nullptr, nullptr, 0, e); }
    k_modulate<<<T / 4, 256, 0, stream>>>(out, T, norm2_g, MOD, 3, SEQ, 0, H2);
    { EpiQP e{QP}; k_gemm<EpiQP, false><<<dim3(2048 / 128, T / 128), 256, 0, stream>>>(H2, WQ_T, 1024, nullptr, nullptr, 0, e); }
    k_peer<<<T, 512, 0, stream>>>(QP, H2, peer_keys, peer_u, peer_v, MOD, out);
}
```

```cpp
#include <hip/hip_runtime.h>
#include <hip/hip_cooperative_groups.h>
namespace cg = cooperative_groups;
#include <cstdio>
#include <cstdint>
#include <cmath>

typedef unsigned short bf16_t;
typedef short bf16x8 __attribute__((ext_vector_type(8)));
typedef float f32x4 __attribute__((ext_vector_type(4)));

constexpr int DM = 1024, BATCH = 2, SEQ = 8192, T = BATCH * SEQ;
constexpr int GRID_W = 64, CTX = 256;
constexpr int D_HY = 512, HY_FFN = 64, HY_EMB = 33;
constexpr int NH = 8, HD = 64, D_NA = 512;
constexpr int NPROJ = 5120;
constexpr int PH = 8, PNK = 128, PTOPK = 16, PDK = 256, PDH = 128;
constexpr float EPS = 1e-6f;

constexpr size_t MiB = 1u << 20;
constexpr size_t WS_WIN_T = 0;
constexpr size_t WS_WHY_T = 10 * MiB;
constexpr size_t WS_WNA_T = 11 * MiB;
constexpr size_t WS_WOUT_T = 12 * MiB;
constexpr size_t WS_WQ_T = 14 * MiB;
constexpr size_t WS_MOD = 18 * MiB;
constexpr size_t WS_HCTX = 19 * MiB;
constexpr size_t WS_KCTX = 20 * MiB;
constexpr size_t WS_VCTXT = 21 * MiB;
constexpr size_t WS_H3 = 22 * MiB;
constexpr size_t WS_CTL = 24 * MiB;
constexpr size_t WS_XN = 26 * MiB;
constexpr size_t WS_ZT = 58 * MiB;
constexpr size_t WS_ZN = 122 * MiB;
constexpr size_t WS_HYO = 218 * MiB;
constexpr size_t WS_NAO = 234 * MiB;
constexpr size_t WS_END = 250 * MiB;

__device__ __forceinline__ bf16_t f2bf(float f) { unsigned u = __builtin_bit_cast(unsigned, f); return (bf16_t)((u + 0x7fffu + ((u >> 16) & 1u)) >> 16); }
__device__ __forceinline__ float bf2f(bf16_t h) { return __builtin_bit_cast(float, (unsigned)h << 16); }
__device__ __forceinline__ float wave_sum(float v) {
#pragma unroll
    for (int o = 32; o > 0; o >>= 1) v += __shfl_xor(v, o);
    return v;
}
__device__ __forceinline__ float wave_max(float v) {
#pragma unroll
    for (int o = 32; o > 0; o >>= 1) v = fmaxf(v, __shfl_xor(v, o));
    return v;
}
__device__ __forceinline__ void wave_argmax(float& v, int& idx) {
#pragma unroll
    for (int o = 32; o > 0; o >>= 1) { const float ov = __shfl_xor(v, o); const int oi = __shfl_xor(idx, o); if (ov > v || (ov == v && oi < idx)) { v = ov; idx = oi; } }
}

#define FH __device__ __forceinline__
#define FFT_LDS __attribute__((address_space(3)))
#define FFT_OPAQUE(x) asm volatile("" : "+v"(x))
#define FFT_SCHED() __builtin_amdgcn_sched_barrier(0)
#ifndef FH
#define FH __host__ __device__ __forceinline__
#endif
#ifndef FFT_LDS
#define FFT_LDS
#endif
#ifndef FFT_OPAQUE
#define FFT_OPAQUE(x)
#endif
#ifndef FFT_SCHED
#define FFT_SCHED()
#endif
typedef float fc2 __attribute__((ext_vector_type(2)));
constexpr int FN = 16384, FRS = 560, FLDS_ELEMS = 32 * FRS;
FH int fphys(int a, int b, int c) { return a * FRS + b * 17 + c; }
FH constexpr int fbrev(int k, int bits) { int r = 0; for (int i = 0; i < bits; ++i) r |= ((k >> i) & 1) << (bits - 1 - i); return r; }
FH constexpr float fcos32(int j) {
    return j == 0 ? 1.f : j == 1 ? 0.98078528040323043f : j == 2 ? 0.92387953251128674f : j == 3 ? 0.83146961230254524f : j == 4 ? 0.70710678118654757f
         : j == 5 ? 0.55557023301960229f : j == 6 ? 0.38268343236508984f : j == 7 ? 0.19509032201612833f : 0.f;
}
template <bool INV> FH void fmulw32(float& tr, float& ti, int idx) {
    if (idx == 0) return;
    if (idx == 8) { const float a = tr; if (INV) { tr = -ti; ti = a; } else { tr = ti; ti = -a; } return; }
    const float c = idx <= 8 ? fcos32(idx) : -fcos32(16 - idx), s0 = idx <= 8 ? fcos32(8 - idx) : fcos32(idx - 8);
    const float s = INV ? s0 : -s0;
    const float a = tr * c - ti * s, b = tr * s + ti * c; tr = a; ti = b;
}
template <int R, bool INV> FH void fdif(float (&re)[R], float (&im)[R]) {
#pragma unroll
    for (int span = R; span >= 2; span >>= 1) {
        const int half = span / 2;
#pragma unroll
        for (int b = 0; b < R; b += span)
#pragma unroll
            for (int j = 0; j < half; ++j) {
                const int i0 = b + j, i1 = i0 + half;
                float tr = re[i0] - re[i1], ti = im[i0] - im[i1];
                re[i0] += re[i1]; im[i0] += im[i1];
                fmulw32<INV>(tr, ti, j * (32 / span));
                re[i1] = tr; im[i1] = ti;
            }
    }
}
template <int R, bool INV> FH void fdit(float (&re)[R], float (&im)[R]) {
#pragma unroll
    for (int span = 2; span <= R; span <<= 1) {
        const int half = span / 2;
#pragma unroll
        for (int b = 0; b < R; b += span)
#pragma unroll
            for (int j = 0; j < half; ++j) {
                const int i0 = b + j, i1 = i0 + half;
                float tr = re[i1], ti = im[i1];
                fmulw32<INV>(tr, ti, j * (32 / span));
                re[i1] = re[i0] - tr; im[i1] = im[i0] - ti;
                re[i0] += tr; im[i0] += ti;
            }
    }
}
FH void fsincos_rev(float rev, float& s, float& c) {
#if defined(__HIP_DEVICE_COMPILE__)
    s = __builtin_amdgcn_sinf(rev); c = __builtin_amdgcn_cosf(rev);
#else
    s = sinf(6.283185307179586f * rev); c = cosf(6.283185307179586f * rev);
#endif
}
template <bool INV> FH void ftwid(float& r, float& i, int m, int den) {
    float s, c; fsincos_rev((float)(m & (den - 1)) / (float)den, s, c);
    if (!INV) s = -s;
    const float a = r * c - i * s, b = r * s + i * c; r = a; i = b;
}

FH void fpassF1(int tid, FFT_LDS fc2* L, float (&re)[32], float (&im)[32]) {
    FFT_OPAQUE(tid);
    const int n2 = tid >> 4, n3 = tid & 15;
    fdif<32, false>(re, im);
#pragma unroll
    for (int k1 = 0; k1 < 32; ++k1) { const int r = fbrev(k1, 5); float a = re[r], b = im[r]; if (k1) ftwid<false>(a, b, n2 * k1, 1024); L[fphys(k1, n2, n3)] = (fc2){a, b}; if ((k1 & 3) == 3) FFT_SCHED(); }
}
FH void fpassI1(int tid, const FFT_LDS fc2* L, float (&re)[32], float (&im)[32]) {
    FFT_OPAQUE(tid);
    const int n2 = tid >> 4, n3 = tid & 15;
#pragma unroll
    for (int k1 = 0; k1 < 32; ++k1) { const fc2 v = L[fphys(k1, n2, n3)]; const int r = fbrev(k1, 5); re[r] = v.x; im[r] = v.y; }
    fdit<32, true>(re, im);
}

FH void fpassF1z(int tid, FFT_LDS fc2* L, const float (&xr)[16], const float (&xi)[16]) {
    FFT_OPAQUE(tid);
    const int n2 = tid >> 4, n3 = tid & 15;
    {
        float re[16], im[16];
#pragma unroll
        for (int j = 0; j < 16; ++j) { re[j] = xr[j]; im[j] = xi[j]; }
        fdif<16, false>(re, im);
#pragma unroll
        for (int m = 0; m < 16; ++m) { const int r = fbrev(m, 4); float a = re[r], b = im[r]; if (m) ftwid<false>(a, b, n2 * 2 * m, 1024); L[fphys(2 * m, n2, n3)] = (fc2){a, b}; }
    }
    FFT_SCHED();
    {
        float re[16], im[16];
#pragma unroll
        for (int j = 0; j < 16; ++j) { re[j] = xr[j]; im[j] = xi[j]; fmulw32<false>(re[j], im[j], j); }
        fdif<16, false>(re, im);
#pragma unroll
        for (int m = 0; m < 16; ++m) { const int r = fbrev(m, 4); float a = re[r], b = im[r]; ftwid<false>(a, b, n2 * (2 * m + 1), 1024); L[fphys(2 * m + 1, n2, n3)] = (fc2){a, b}; }
    }
}
FH void fpassI1h(int tid, const FFT_LDS fc2* L, float (&outr)[16], float (&outi)[16]) {
    FFT_OPAQUE(tid);
    const int n2 = tid >> 4, n3 = tid & 15;
    {
        float re[16], im[16];
#pragma unroll
        for (int m = 0; m < 16; ++m) { const fc2 v = L[fphys(2 * m, n2, n3)]; const int r = fbrev(m, 4); re[r] = v.x; im[r] = v.y; }
        fdit<16, true>(re, im);
#pragma unroll
        for (int j = 0; j < 16; ++j) { outr[j] = re[j]; outi[j] = im[j]; }
    }
    FFT_SCHED();
    {
        float re[16], im[16];
#pragma unroll
        for (int m = 0; m < 16; ++m) { const fc2 v = L[fphys(2 * m + 1, n2, n3)]; const int r = fbrev(m, 4); re[r] = v.x; im[r] = v.y; }
        fdit<16, true>(re, im);
#pragma unroll
        for (int j = 0; j < 16; ++j) { fmulw32<true>(re[j], im[j], j); outr[j] += re[j]; outi[j] += im[j]; }
    }
}
FH void fpassF2(int tid, FFT_LDS fc2* L) {
    FFT_OPAQUE(tid);
    const int k1 = tid >> 4, n3 = tid & 15; float re[32], im[32];
#pragma unroll
    for (int n2 = 0; n2 < 32; ++n2) { const fc2 v = L[fphys(k1, n2, n3)]; re[n2] = v.x; im[n2] = v.y; }
    fdif<32, false>(re, im);
#pragma unroll
    for (int k2 = 0; k2 < 32; ++k2) { const int r = fbrev(k2, 5); float a = re[r], b = im[r]; ftwid<false>(a, b, n3 * (k1 + 32 * k2), FN); L[fphys(k1, k2, n3)] = (fc2){a, b}; if ((k2 & 3) == 3) FFT_SCHED(); }
}
FH void fpassI2(int tid, FFT_LDS fc2* L) {
    FFT_OPAQUE(tid);
    const int k1 = tid >> 4, n3 = tid & 15; float re[32], im[32];
#pragma unroll
    for (int k2 = 0; k2 < 32; ++k2) { const fc2 v = L[fphys(k1, k2, n3)]; const int r = fbrev(k2, 5); re[r] = v.x; im[r] = v.y; }
    fdit<32, true>(re, im);
#pragma unroll
    for (int n2 = 0; n2 < 32; ++n2) { float a = re[n2], b = im[n2]; if (n2) ftwid<true>(a, b, n2 * k1, 1024); L[fphys(k1, n2, n3)] = (fc2){a, b}; if ((n2 & 3) == 3) FFT_SCHED(); }
}
FH void fpassF3(int tid, FFT_LDS fc2* L) {
    FFT_OPAQUE(tid);
#pragma unroll 1
    for (int it = 0; it < 2; ++it) {
        const int k2 = tid & 31, k1 = (tid >> 5) + 16 * it; float re[16], im[16];
#pragma unroll
        for (int n3 = 0; n3 < 16; ++n3) { const fc2 v = L[fphys(k1, k2, n3)]; re[n3] = v.x; im[n3] = v.y; }
        fdif<16, false>(re, im);
#pragma unroll
        for (int k3 = 0; k3 < 16; ++k3) { const int r = fbrev(k3, 4); L[fphys(k1, k2, k3)] = (fc2){re[r], im[r]}; }
    }
}
template <class KT>
FH void fpassF3KI3(int tid, FFT_LDS fc2* L, const KT* KF) {
    FFT_OPAQUE(tid);
#pragma unroll 1
    for (int it = 0; it < 2; ++it) {
        const int k2 = tid & 31, k1 = (tid >> 5) + 16 * it; float re[16], im[16];
#pragma unroll
        for (int n3 = 0; n3 < 16; ++n3) { const fc2 v = L[fphys(k1, k2, n3)]; re[n3] = v.x; im[n3] = v.y; }
        fdif<16, false>(re, im);
        const KT* kp = KF + k1 * 512 + k2 * 16;
#pragma unroll
        for (int r = 0; r < 16; ++r) { const KT kv = kp[fbrev(r, 4)]; const float kr = (float)kv.x, ki = (float)kv.y; const float a = re[r] * kr - im[r] * ki, b = re[r] * ki + im[r] * kr; re[r] = a; im[r] = b; }
        fdit<16, true>(re, im);
#pragma unroll
        for (int n3 = 0; n3 < 16; ++n3) { float a = re[n3], b = im[n3]; if (n3) ftwid<true>(a, b, n3 * (k1 + 32 * k2), FN); L[fphys(k1, k2, n3)] = (fc2){a, b}; }
    }
}
template <class KT, class KE>
FH void funpack(int tid, const FFT_LDS fc2* L, KT* KF0, KT* KF1, float scale0, float scale1, float add0, float add1) {
    FFT_OPAQUE(tid);
#pragma unroll 1
    for (int i = 0; i < 32; ++i) {
        const int l = tid + 512 * i, k1 = i, k2 = tid >> 4, k3 = tid & 15;
        const int f = k1 + 32 * k2 + 1024 * k3, g = (FN - f) & (FN - 1);
        const fc2 p = L[fphys(k1, k2, k3)], q = L[fphys(g & 31, (g >> 5) & 31, g >> 10)];
        const float ar = 0.5f * (p.x + q.x), ai = 0.5f * (p.y - q.y);
        const float br = 0.5f * (p.y + q.y), bi = -0.5f * (p.x - q.x);
        KT o0, o1; o0.x = (KE)(ar * scale0 + add0); o0.y = (KE)(ai * scale0); o1.x = (KE)(br * scale1 + add1); o1.y = (KE)(bi * scale1);
        KF0[l] = o0; KF1[l] = o1;
    }
}
namespace pg8 {
#define PG8_LAS __attribute__((address_space(3)))
typedef unsigned short bf16_t;
typedef short bf16x8 __attribute__((ext_vector_type(8)));
typedef float f32x4 __attribute__((ext_vector_type(4)));
typedef unsigned u32x4 __attribute__((ext_vector_type(4)));
constexpr int BM = 256, BK = 64, HALF = 128, HTB = HALF * BK * 2  , STAGE_BYTES = 8 * HTB, NXCD = 8, WGM = 8;

__host__ __device__ __forceinline__ int lds_byte(int r, int c) { const int st = (r >> 4) * 2 + (c >> 5), rr = r & 15, cc = c & 31, ob = rr * 64 + cc * 2; return st * 1024 + (ob ^ (((ob >> 9) & 1) << 5)); }
__host__ __device__ __forceinline__ void stage_rc(int b, int& R, int& C) { const int st = b / 1024, sb = b % 1024, swz = sb ^ (((sb >> 9) & 1) << 5); R = (st >> 1) * 16 + swz / 64; C = (st & 1) * 32 + (swz % 64) / 2; }
__host__ __device__ __forceinline__ int perm32(int rho) { const int n = rho >> 4, i = rho & 15; return 8 * (i >> 2) + 4 * n + (i & 3); }

struct Unit { int pm, pn; };
struct Gemm { const bf16_t* A; const bf16_t* Bt; int M, N, K; };

struct StaticOrder {
    int nM, nN, nwg, G, c;
    __host__ __device__ void init(int M, int N, int G_, int c_) { nM = M / BM; nN = N / BM; nwg = nM * nN; G = G_; c = c_; }
    __host__ __device__ bool next(int i, Unit& u) const {
        const long L = (long)i * G + c; if (L >= nwg) return false;
        int wgid = (int)L; { const int q = nwg / NXCD, r = nwg % NXCD, xcd = wgid % NXCD, off = wgid / NXCD; wgid = (xcd < r ? xcd * (q + 1) : r * (q + 1) + (xcd - r) * q) + off; }
        const int nig = WGM * nN, gid = wgid / nig, fm = gid * WGM, gsz = (nM - fm) < WGM ? (nM - fm) : WGM;
        u.pm = fm + ((wgid % nig) % gsz); u.pn = (wgid % nig) / gsz; return true;
    }
    __device__ __forceinline__ void a_ready(const Unit&) const {}
    __device__ __forceinline__ void done(const Unit&) const {}
};
__device__ __forceinline__ unsigned cvt_pk_bf16(float lo, float hi) { unsigned r; asm volatile("v_cvt_pk_bf16_f32 %0, %1, %2" : "=v"(r) : "v"(lo), "v"(hi)); return r; }

template <class Epi, class Sched, bool ALIGN_EPI = false, bool SP2 = false>
__device__ __forceinline__ void gemm_phase(PG8_LAS unsigned char* lds, const Gemm g, const Sched& S, const Epi& E) {
    int tid_ = threadIdx.x; asm volatile("" : "+v"(tid_));
    const int tid = tid_, wid = __builtin_amdgcn_readfirstlane(tid >> 6), lane = tid & 63, wr = wid >> 2, wc = wid & 3, fr = lane & 15, fq = lane >> 4;
    const int K = g.K; int nt = K / BK; if constexpr (Epi::FP8) asm volatile("" : "+s"(nt));
    unsigned voffA[2], voffB[2];
#pragma unroll
    for (int i = 0; i < 2; ++i) { int R, C; stage_rc(tid * 16 + i * 8192, R, C); const int Rb = Epi::PERM ? ((R & ~31) + perm32(R & 31)) : R;
        voffA[i] = (unsigned)(R * K + C) * 2u; voffB[i] = (unsigned)(Rb * K + C) * 2u; }
    const size_t kstep = (size_t)(BK * 2);
    const size_t hstep = (size_t)HALF * K * 2;
    const size_t tstep = 2 * hstep;
    const unsigned ldsw = (unsigned)wid * 1024u;
    const int aoff = lds_byte(wr * 64 + fr, fq * 8), boff = lds_byte(wc * 32 + fr, fq * 8);
#define PG8_SA(b, h) (((b) * 2 + (h)) * HTB)
#define PG8_SB(b, h) ((4 + (b) * 2 + (h)) * HTB)
    const __amdgpu_buffer_rsrc_t rs_voffA = __builtin_amdgcn_make_buffer_rsrc((void*)g.A, 0, 0x7FFFFFFF, 0x00020000), rs_voffB = __builtin_amdgcn_make_buffer_rsrc((void*)g.Bt, 0, 0x7FFFFFFF, 0x00020000);
    const char* const base_voffA = (const char*)g.A; const char* const base_voffB = (const char*)g.Bt;
#define PG8_STAGE(bufoff, gbase, voff) do { if constexpr (Epi::FP8) { const int so_ = (int)((const char*)(gbase) - base_##voff); _Pragma("unroll") for (int _i = 0; _i < 2; ++_i) \
            __builtin_amdgcn_raw_ptr_buffer_load_lds(rs_##voff, (PG8_LAS void*)(lds + (bufoff) + ldsw + _i * 8192), 16, (int)(voff)[_i], so_, 0, 0); } \
        else { _Pragma("unroll") for (int _i = 0; _i < 2; ++_i) \
            __builtin_amdgcn_global_load_lds((const unsigned*)((const char*)(gbase) + (voff)[_i]), (PG8_LAS unsigned*)(lds + (bufoff) + ldsw + _i * 8192), 16, 0, 0); } } while (0)
#define PG8_LDA(dst, b, h) do { _Pragma("unroll") for (int m = 0; m < 4; ++m) _Pragma("unroll") for (int k = 0; k < 2; ++k) dst[m][k] = *(const PG8_LAS bf16x8*)(lds + PG8_SA(b, h) + aoff + m * 2048 + k * 1024); } while (0)
#define PG8_LDB(dst, b, h) do { _Pragma("unroll") for (int n = 0; n < 2; ++n) _Pragma("unroll") for (int k = 0; k < 2; ++k) dst[n][k] = *(const PG8_LAS bf16x8*)(lds + PG8_SB(b, h) + boff + n * 2048 + k * 1024); } while (0)
#define PG8_MMA(ai, bj, At, Bt) do { __builtin_amdgcn_s_setprio(1); \
        if constexpr (Epi::FP8) { typedef int pg8_v8i_t __attribute__((ext_vector_type(8))); typedef int pg8_v4i_t __attribute__((ext_vector_type(4))); \
            _Pragma("unroll") for (int m = 0; m < 4; ++m) _Pragma("unroll") for (int n = 0; n < 2; ++n) { \
                const pg8_v8i_t bq_ = __builtin_bit_cast(pg8_v8i_t, __builtin_shufflevector(Bt[n][0], Bt[n][1], 0, 1, 2, 3, 4, 5, 6, 7, 8, 9, 10, 11, 12, 13, 14, 15)), \
                                aq_ = __builtin_bit_cast(pg8_v8i_t, __builtin_shufflevector(At[m][0], At[m][1], 0, 1, 2, 3, 4, 5, 6, 7, 8, 9, 10, 11, 12, 13, 14, 15)); \
                acc[ai][bj][m][n] = __builtin_amdgcn_mfma_scale_f32_16x16x128_f8f6f4(bq_, aq_, acc[ai][bj][m][n], 0, 0, 0, 0, 0, 0); } } \
        else { _Pragma("unroll") for (int m = 0; m < 4; ++m) _Pragma("unroll") for (int n = 0; n < 2; ++n) _Pragma("unroll") for (int k = 0; k < 2; ++k) \
            acc[ai][bj][m][n] = __builtin_amdgcn_mfma_f32_16x16x32_bf16(Bt[n][k], At[m][k], acc[ai][bj][m][n], 0, 0, 0); } \
        __builtin_amdgcn_s_setprio(0); } while (0)
#define PG8_WAIT_V(n) asm volatile("s_waitcnt vmcnt(" #n ")" ::: "memory")
#define PG8_WAIT_L(n) asm volatile("s_waitcnt lgkmcnt(" #n ")" ::: "memory")
#define PG8_BAR __builtin_amdgcn_s_barrier()
#define PG8_SCHED __builtin_amdgcn_sched_barrier(0)
    Unit cur, nxt; int ui = 0;
    if (!S.next(0, cur)) return;
    f32x4 acc[2][2][4][2];
#pragma unroll
    for (int a = 0; a < 2; ++a)
#pragma unroll
        for (int b = 0; b < 2; ++b)
#pragma unroll
            for (int m = 0; m < 4; ++m)
#pragma unroll
                for (int n = 0; n < 2; ++n) acc[a][b][m][n] = (f32x4){0.f, 0.f, 0.f, 0.f};
    bf16x8 At[4][2], B0[2][2], B1[2][2];
    const char* cA = (const char*)g.A + (size_t)cur.pm * tstep; const char* cB = (const char*)g.Bt + (size_t)cur.pn * tstep;
    S.a_ready(cur);
    if constexpr (SP2) {
        PG8_STAGE(PG8_SB(0, 0), cB, voffB); PG8_STAGE(PG8_SB(0, 1), cB + hstep, voffB); PG8_STAGE(PG8_SA(0, 0), cA, voffA); PG8_STAGE(PG8_SA(0, 1), cA + hstep, voffA);
        if (wr == 1) PG8_BAR;
        PG8_WAIT_V(2); PG8_BAR;
        PG8_STAGE(PG8_SB(1, 0), cB + kstep, voffB); PG8_STAGE(PG8_SA(1, 0), cA + kstep, voffA); PG8_STAGE(PG8_SB(1, 1), cB + hstep + kstep, voffB);
        PG8_WAIT_V(6); PG8_BAR;
    } else {
        PG8_STAGE(PG8_SB(0, 0), cB, voffB); PG8_STAGE(PG8_SA(0, 0), cA, voffA); PG8_STAGE(PG8_SB(0, 1), cB + hstep, voffB); PG8_STAGE(PG8_SA(0, 1), cA + hstep, voffA);
        if (wr == 1) PG8_BAR;
        PG8_WAIT_V(4); PG8_BAR;
        PG8_STAGE(PG8_SB(1, 0), cB + kstep, voffB); PG8_STAGE(PG8_SA(1, 0), cA + kstep, voffA); PG8_STAGE(PG8_SB(1, 1), cB + hstep + kstep, voffB);
        PG8_WAIT_V(6); PG8_BAR;
    }
    for (;;) {
        const bool has_next = S.next(ui + 1, nxt);
        const char* nA = has_next ? (const char*)g.A + (size_t)nxt.pm * tstep : cA; const char* nB = has_next ? (const char*)g.Bt + (size_t)nxt.pn * tstep : cB;
        for (int t = 0; t < nt; t += 2) {
            const bool last = (t == nt - 2);
            const char* a1 = cA + (size_t)(t + 1) * kstep;
            const char* a2 = last ? nA : cA + (size_t)(t + 2) * kstep; const char* b2 = last ? nB : cB + (size_t)(t + 2) * kstep;
            const char* a3 = a2 + kstep; const char* b3 = b2 + kstep;
            if (last && has_next) S.a_ready(nxt);
            if constexpr (Epi::MID) { if (t == (nt >> 1)) E.mid(acc, cur, wr, wc, fr, fq); }
            if constexpr (SP2) {
            PG8_LDB(B0, 0, 0); PG8_LDB(B1, 0, 1); PG8_SCHED; PG8_LDA(At, 0, 0); PG8_STAGE(PG8_SA(1, 1), a1 + hstep, voffA);
            PG8_WAIT_V(8); PG8_WAIT_L(0); PG8_BAR; PG8_MMA(0, 0, At, B0); PG8_MMA(0, 1, At, B1); PG8_BAR; PG8_SCHED;
            PG8_LDA(At, 0, 1); PG8_STAGE(PG8_SB(0, 0), b2, voffB); PG8_STAGE(PG8_SB(0, 1), b2 + hstep, voffB); PG8_STAGE(PG8_SA(0, 0), a2, voffA);
            PG8_WAIT_V(8); PG8_WAIT_L(0); PG8_BAR; PG8_MMA(1, 0, At, B0); PG8_MMA(1, 1, At, B1); PG8_BAR; PG8_SCHED;
            PG8_LDB(B0, 1, 0); PG8_LDB(B1, 1, 1); PG8_SCHED; PG8_LDA(At, 1, 0); PG8_STAGE(PG8_SA(0, 1), a2 + hstep, voffA);
            PG8_WAIT_V(8); PG8_WAIT_L(0); PG8_BAR; PG8_MMA(0, 0, At, B0); PG8_MMA(0, 1, At, B1); PG8_BAR; PG8_SCHED;
            PG8_LDA(At, 1, 1); PG8_STAGE(PG8_SB(1, 0), b3, voffB); PG8_STAGE(PG8_SB(1, 1), b3 + hstep, voffB); PG8_STAGE(PG8_SA(1, 0), a3, voffA);
            PG8_WAIT_V(8); PG8_WAIT_L(0); PG8_BAR; PG8_MMA(1, 0, At, B0); PG8_MMA(1, 1, At, B1); PG8_BAR; PG8_SCHED;
            } else {
            PG8_LDB(B0, 0, 0); PG8_SCHED; PG8_LDA(At, 0, 0); PG8_STAGE(PG8_SA(1, 1), a1 + hstep, voffA);
            PG8_WAIT_L(8); PG8_BAR; PG8_WAIT_L(0); PG8_MMA(0, 0, At, B0); PG8_BAR; PG8_SCHED;
            PG8_LDB(B1, 0, 1); PG8_STAGE(PG8_SB(0, 0), b2, voffB);
            PG8_BAR; PG8_WAIT_L(0); PG8_MMA(0, 1, At, B1); PG8_BAR;
            PG8_LDA(At, 0, 1); PG8_STAGE(PG8_SA(0, 0), a2, voffA);
            PG8_BAR; PG8_WAIT_L(0); PG8_MMA(1, 0, At, B0); PG8_BAR; PG8_SCHED;
            PG8_STAGE(PG8_SB(0, 1), b2 + hstep, voffB);
            PG8_WAIT_V(6); PG8_BAR; PG8_MMA(1, 1, At, B1); PG8_BAR;
            PG8_LDB(B0, 1, 0); PG8_SCHED; PG8_LDA(At, 1, 0); PG8_STAGE(PG8_SA(0, 1), a2 + hstep, voffA);
            PG8_WAIT_L(8); PG8_BAR; PG8_WAIT_L(0); PG8_MMA(0, 0, At, B0); PG8_BAR; PG8_SCHED;
            PG8_LDB(B1, 1, 1); PG8_STAGE(PG8_SB(1, 0), b3, voffB);
            PG8_BAR; PG8_WAIT_L(0); PG8_MMA(0, 1, At, B1); PG8_BAR;
            PG8_LDA(At, 1, 1); PG8_STAGE(PG8_SA(1, 0), a3, voffA);
            PG8_BAR; PG8_WAIT_L(0); PG8_MMA(1, 0, At, B0); PG8_BAR; PG8_SCHED;
            PG8_STAGE(PG8_SB(1, 1), b3 + hstep, voffB);
            PG8_WAIT_V(6); PG8_BAR; PG8_MMA(1, 1, At, B1); PG8_BAR;
            }
        }
        if constexpr (ALIGN_EPI) { if (wr == 0) PG8_BAR; }
        if constexpr (!Epi::AFTER_DRAIN) { if constexpr (Epi::FP8) { int t2_ = threadIdx.x; asm volatile("" : "+v"(t2_));
                E(acc, cur, wr, wc, t2_ & 15, (t2_ & 63) >> 4); } else E(acc, cur, wr, wc, fr, fq);
            S.done(cur); }
        if (!has_next) break;
#pragma unroll
        for (int a = 0; a < 2; ++a)
#pragma unroll
            for (int b = 0; b < 2; ++b)
#pragma unroll
                for (int m = 0; m < 4; ++m)
#pragma unroll
                    for (int n = 0; n < 2; ++n) acc[a][b][m][n] = (f32x4){0.f, 0.f, 0.f, 0.f};
        cur = nxt; cA = nA; cB = nB; ++ui;
        if constexpr (ALIGN_EPI) { if (wr == 1) PG8_BAR; }
    }
    PG8_WAIT_V(0);
    if constexpr (!ALIGN_EPI) { if (wr == 0) PG8_BAR; }
    PG8_BAR;
    if constexpr (Epi::AFTER_DRAIN) { E.fused(acc, cur, wr, wc, fr, fq, lds, wid, lane); S.done(cur); }
#undef PG8_SA
#undef PG8_SB
#undef PG8_STAGE
#undef PG8_LDA
#undef PG8_LDB
#undef PG8_MMA
#undef PG8_WAIT_V
#undef PG8_WAIT_L
#undef PG8_BAR
#undef PG8_SCHED
}
}

#define LAS __attribute__((address_space(3)))
constexpr int NTHR = 512, NWAVE = 8;
constexpr int VPITCH = T + 64;
constexpr int LDS_BYTES = 163840;

struct P {
    const float *x, *c, *ctx, *c_ctx, *norm1_g, *norm2_g, *w_ada, *b_ada, *w_in, *b_in, *hy_conv_w, *hy_conv_b;
    const float *f1w, *f1b, *f2w, *f2b, *f3w, *f3b, *f4w, *freq, *hy_skip, *q_norm_g, *k_norm_g, *na_rpb;
    const float *w_hy_out, *w_na_out, *w_out, *peer_w_q, *peer_keys, *peer_u, *peer_v;
    float* out; unsigned char* ws;
};

typedef float f32x2v_t __attribute__((ext_vector_type(2))); typedef __bf16 bf16x2v_t __attribute__((ext_vector_type(2)));
__device__ __forceinline__ int opq_gx() { int g = (int)gridDim.x; asm volatile("" : "+s"(g)); return g; }
__device__ __forceinline__ unsigned pk_bf16(float lo, float hi) { const f32x2v_t v = {lo, hi}; const bf16x2v_t r = __builtin_convertvector(v, bf16x2v_t); return __builtin_bit_cast(unsigned, r); }
__device__ __forceinline__ int win_logical(int p) { if (p < 1536) return p; if (p < 2048) return p + 1024; if (p >= 3072) return p; const int tb = p & ~255, P = p & 255; return tb - 512 + 64 * ((P >> 5) & 3) + 32 * (P >> 7) + (P & 31); }
__device__ __forceinline__ void ph_transpose(const float* W, int K, int N, bf16_t* WT, int mode, float* lds, int ld = 0, int ldo = 0, unsigned char* W8 = nullptr) {
    if (ld == 0) ld = N;
    if (ldo == 0) ldo = K;
    int tix_ = threadIdx.x; asm volatile("" : "+v"(tix_));
    const int wave = tix_ >> 6, lane = tix_ & 63;
    LAS float* scr = (LAS float*)lds + wave * (64 * 33);
    const int nblk = N / 32, nitems = nblk * (K / 64);
    for (int item = blockIdx.x * NWAVE + wave; item < nitems; item += opq_gx() * NWAVE) {
        const int kb = item / nblk, nb = item % nblk, k0 = 64 * kb, p0 = 32 * nb;
        const int l0 = mode ? win_logical(p0) : p0;
        f32x4 tv[8];
#pragma unroll
        for (int i = 0; i < 8; ++i) tv[i] = *(const f32x4*)(W + (size_t)(k0 + 8 * i + (lane >> 3)) * ld + l0 + 4 * (lane & 7));
        __builtin_amdgcn_sched_barrier(0);
#pragma unroll
        for (int i = 0; i < 8; ++i) { LAS float* d = scr + (8 * i + (lane >> 3)) * 33 + 4 * (lane & 7); d[0] = tv[i][0]; d[1] = tv[i][1]; d[2] = tv[i][2]; d[3] = tv[i][3]; }
        asm volatile("s_waitcnt lgkmcnt(0)" ::: "memory");
        const int c = lane & 7;
#pragma unroll
        for (int jj = 0; jj < 4; ++jj) { const int n = (lane >> 3) + 8 * jj; const LAS float* s = scr + (8 * c) * 33 + n;
            uint4 o; o.x = pk_bf16(s[0 * 33], s[1 * 33]); o.y = pk_bf16(s[2 * 33], s[3 * 33]); o.z = pk_bf16(s[4 * 33], s[5 * 33]); o.w = pk_bf16(s[6 * 33], s[7 * 33]);
            *(uint4*)(WT + (size_t)(p0 + n) * ldo + k0 + 8 * c) = o;
            if (W8) { int w0 = 0, w1 = 0;
                w0 = __builtin_amdgcn_cvt_pk_fp8_f32(s[0 * 33] * 64.f, s[1 * 33] * 64.f, w0, false); w0 = __builtin_amdgcn_cvt_pk_fp8_f32(s[2 * 33] * 64.f, s[3 * 33] * 64.f, w0, true);
                w1 = __builtin_amdgcn_cvt_pk_fp8_f32(s[4 * 33] * 64.f, s[5 * 33] * 64.f, w1, false); w1 = __builtin_amdgcn_cvt_pk_fp8_f32(s[6 * 33] * 64.f, s[7 * 33] * 64.f, w1, true);
                uint2 o8; o8.x = (unsigned)w0; o8.y = (unsigned)w1; *(uint2*)(W8 + (size_t)(p0 + n) * 1024 + k0 + 8 * c) = o8; } }
        asm volatile("s_waitcnt lgkmcnt(0)" ::: "memory");
    }
}

__device__ __forceinline__ void ph_rope_table(float* ROPE) {
    int tix_ = threadIdx.x; asm volatile("" : "+v"(tix_));
    for (int e = blockIdx.x * NTHR + tix_; e < 128 * 16; e += gridDim.x * NTHR) { const int pos = e >> 4, f = e & 15; const float ang = (float)pos * expf(-(float)f * 0.5756462732485114f); float sn, cs; sincosf(ang, &sn, &cs); ROPE[2 * e] = cs; ROPE[2 * e + 1] = sn; }
}

__device__ __forceinline__ void ph_cq(const bf16_t* WQ_T, const float* mod, float* CQ) {
    int tix_ = threadIdx.x; asm volatile("" : "+v"(tix_));
    const int wave = tix_ >> 6, lane = tix_ & 63;
    for (int n = blockIdx.x * NWAVE + wave; n < 2048; n += opq_gx() * NWAVE) {
        const uint4 w0 = *(const uint4*)(WQ_T + (size_t)n * DM + 16 * lane), w1 = *(const uint4*)(WQ_T + (size_t)n * DM + 16 * lane + 8);
        const unsigned ww[8] = {w0.x, w0.y, w0.z, w0.w, w1.x, w1.y, w1.z, w1.w};
        float a0 = 0.f, a1 = 0.f;
#pragma unroll
        for (int j = 0; j < 8; ++j) { const float lo = __uint_as_float(ww[j] << 16), hi = __uint_as_float(ww[j] & 0xffff0000u); const int k = 16 * lane + 2 * j;
            a0 += lo * mod[3 * 1024 + k] + hi * mod[3 * 1024 + k + 1]; a1 += lo * mod[6144 + 3 * 1024 + k] + hi * mod[6144 + 3 * 1024 + k + 1]; }
        a0 = wave_sum(a0); a1 = wave_sum(a1);
        if (lane == 0) { CQ[n] = a0; CQ[2048 + n] = a1; }
    }
}
__device__ __forceinline__ void ph_adaln(const P& p, float* mod, float* lds) {
    int tix_ = threadIdx.x; asm volatile("" : "+v"(tix_));
    float* sc = lds;
    float* part = lds + 3072;
    if (blockIdx.x >= 192) return;
    for (int i = tix_; i < 3 * 1024; i += NTHR) { const int v = i >> 10, k = i & 1023; const float x = v < 2 ? p.c[v * 1024 + k] : p.c_ctx[k]; sc[i] = x / (1.f + expf(-x)); }
    __syncthreads();
    for (int it = blockIdx.x; it < 192; it += gridDim.x) {
        const int c4 = tix_ & 7, kg = tix_ >> 3, j0 = it * 32 + 4 * c4;
        f32x4 w[16];
#pragma unroll
        for (int i = 0; i < 16; ++i) w[i] = *(const f32x4*)(p.w_ada + (size_t)(kg * 16 + i) * 6144 + j0);
        f32x4 a0 = (f32x4){0.f, 0.f, 0.f, 0.f}, a1 = a0, a2 = a0;
#pragma unroll
        for (int i = 0; i < 16; ++i) { const int k = kg * 16 + i; a0 += w[i] * sc[k]; a1 += w[i] * sc[1024 + k]; a2 += w[i] * sc[2048 + k]; }
        *(f32x4*)(part + (kg * 3 + 0) * 32 + 4 * c4) = a0; *(f32x4*)(part + (kg * 3 + 1) * 32 + 4 * c4) = a1; *(f32x4*)(part + (kg * 3 + 2) * 32 + 4 * c4) = a2;
        __syncthreads();
        if (tix_ < 96) { const int v = tix_ >> 5, jj = tix_ & 31; const int jo = it * 32 + jj; float s = p.b_ada[jo];
#pragma unroll 8
            for (int q = 0; q < 64; ++q) s += part[(q * 3 + v) * 32 + jj];
            mod[v * 6144 + jo] = s; }
        __syncthreads();
    }
}

__device__ __forceinline__ void ph_modulate(const float* x, int nrows, const float* g, const float* mod, int shift_chunk, int rows_per_vec, int vec0, bf16_t* out, unsigned char* out8 = nullptr) {
    int tix_ = threadIdx.x; asm volatile("" : "+v"(tix_));
    const int wave = tix_ >> 6, lane = tix_ & 63, step = opq_gx() * NWAVE;
    int bx_ = blockIdx.x; asm volatile("" : "+s"(bx_));
    int row = bx_ * NWAVE + wave; if (row >= nrows) return;
    f32x4 xn[4], gs[4], sv[4]; int cur_v = -1;
#pragma unroll
    for (int j = 0; j < 4; ++j) xn[j] = *(const f32x4*)(x + (size_t)row * DM + 8 * lane + 512 * (j >> 1) + 4 * (j & 1));
    for (; row < nrows; row += step) {
        f32x4 xv[4];
#pragma unroll
        for (int j = 0; j < 4; ++j) xv[j] = xn[j];
        if (row + step < nrows) {
#pragma unroll
            for (int j = 0; j < 4; ++j) xn[j] = *(const f32x4*)(x + (size_t)(row + step) * DM + 8 * lane + 512 * (j >> 1) + 4 * (j & 1));
        }
        const int v = vec0 + (rows_per_vec > 0 ? row / rows_per_vec : 0);
        if (v != cur_v) { cur_v = v; const float* sh = mod + v * 6144 + shift_chunk * 1024;
#pragma unroll
            for (int j = 0; j < 4; ++j) { const int c0 = 8 * lane + 512 * (j >> 1) + 4 * (j & 1); gs[j] = *(const f32x4*)(g + c0) * (*(const f32x4*)(sh + 1024 + c0) + 1.f); sv[j] = *(const f32x4*)(sh + c0); } }
        float s = 0.f;
#pragma unroll
        for (int j = 0; j < 4; ++j) s += (xv[j][0] * xv[j][0] + xv[j][1] * xv[j][1]) + (xv[j][2] * xv[j][2] + xv[j][3] * xv[j][3]);
        const float rstd = 1.f / sqrtf(wave_sum(s) * (1.f / DM) + EPS);
#pragma unroll
        for (int jj = 0; jj < 2; ++jj) { const f32x4 a = xv[2 * jj] * rstd * gs[2 * jj] + sv[2 * jj], c = xv[2 * jj + 1] * rstd * gs[2 * jj + 1] + sv[2 * jj + 1];
            uint4 o; o.x = pk_bf16(a[0], a[1]); o.y = pk_bf16(a[2], a[3]); o.z = pk_bf16(c[0], c[1]); o.w = pk_bf16(c[2], c[3]);
            *(uint4*)(out + (size_t)row * DM + 8 * lane + 512 * jj) = o;
            if (out8) { int w0 = 0, w1 = 0;
                w0 = __builtin_amdgcn_cvt_pk_fp8_f32(fminf(fmaxf(a[0], -448.f), 448.f), fminf(fmaxf(a[1], -448.f), 448.f), w0, false); w0 = __builtin_amdgcn_cvt_pk_fp8_f32(fminf(fmaxf(a[2], -448.f), 448.f), fminf(fmaxf(a[3], -448.f), 448.f), w0, true);
                w1 = __builtin_amdgcn_cvt_pk_fp8_f32(fminf(fmaxf(c[0], -448.f), 448.f), fminf(fmaxf(c[1], -448.f), 448.f), w1, false); w1 = __builtin_amdgcn_cvt_pk_fp8_f32(fminf(fmaxf(c[2], -448.f), 448.f), fminf(fmaxf(c[3], -448.f), 448.f), w1, true);
                uint2 o8; o8.x = (unsigned)w0; o8.y = (unsigned)w1; *(uint2*)(out8 + (size_t)row * DM + 8 * lane + 512 * jj) = o8; } }
    }
}

template <class Epi, bool DUAL>
__device__ __forceinline__ void ph_gemm(const bf16_t* A, const bf16_t* Bt, int M, int N, int K, const bf16_t* A2, const bf16_t* Bt2, int K2, const Epi& epi) {
    int tix_ = threadIdx.x; asm volatile("" : "+v"(tix_));
    const int wave = tix_ >> 6, lane = tix_ & 63, fr = lane & 15, fq = lane >> 4;
    const int ntn = N / 64, ntiles = (M / 64) * ntn;
    for (int wt = blockIdx.x * NWAVE + wave; wt < ntiles; wt += opq_gx() * NWAVE) {
        const int row0 = (wt / ntn) * 64, col0 = (wt % ntn) * 64;
        f32x4 acc[4][4], acc2[4][4];
#pragma unroll
        for (int m = 0; m < 4; ++m)
#pragma unroll
            for (int n = 0; n < 4; ++n) { acc[m][n] = (f32x4){0.f, 0.f, 0.f, 0.f}; acc2[m][n] = (f32x4){0.f, 0.f, 0.f, 0.f}; }
        for (int k0 = 0; k0 < K; k0 += 32) {
            bf16x8 a[4], b[4];
#pragma unroll
            for (int m = 0; m < 4; ++m) a[m] = *(const bf16x8*)(A + (size_t)(row0 + m * 16 + fr) * K + k0 + fq * 8);
#pragma unroll
            for (int n = 0; n < 4; ++n) b[n] = *(const bf16x8*)(Bt + (size_t)(col0 + n * 16 + fr) * K + k0 + fq * 8);
#pragma unroll
            for (int m = 0; m < 4; ++m)
#pragma unroll
                for (int n = 0; n < 4; ++n) acc[m][n] = __builtin_amdgcn_mfma_f32_16x16x32_bf16(a[m], b[n], acc[m][n], 0, 0, 0);
        }
        if (DUAL) {
            for (int k0 = 0; k0 < K2; k0 += 32) {
                bf16x8 a[4], b[4];
#pragma unroll
                for (int m = 0; m < 4; ++m) a[m] = *(const bf16x8*)(A2 + (size_t)(row0 + m * 16 + fr) * K2 + k0 + fq * 8);
#pragma unroll
                for (int n = 0; n < 4; ++n) b[n] = *(const bf16x8*)(Bt2 + (size_t)(col0 + n * 16 + fr) * K2 + k0 + fq * 8);
#pragma unroll
                for (int m = 0; m < 4; ++m)
#pragma unroll
                    for (int n = 0; n < 4; ++n) acc2[m][n] = __builtin_amdgcn_mfma_f32_16x16x32_bf16(a[m], b[n], acc2[m][n], 0, 0, 0);
            }
        }
#pragma unroll
        for (int m = 0; m < 4; ++m)
#pragma unroll
            for (int n = 0; n < 4; ++n)
#pragma unroll
                for (int j = 0; j < 4; ++j) epi(row0 + m * 16 + fq * 4 + j, col0 + n * 16 + fr, acc[m][n][j], acc2[m][n][j]);
    }
}

struct EpiZT {
    bf16_t* ZT; const float* b_in;
    __device__ __forceinline__ void operator()(int r, int c, float v, float) const { ZT[(size_t)r * T + c] = f2bf(v + b_in[r < 1536 ? r : r + 1024]); }
};
struct EpiZN {
    bf16_t* ZN; const float* b_in;
    __device__ __forceinline__ void operator()(int r, int c, float v, float) const {
        const int lc = c < 1024 ? c + 1536 : c + 2048; float o = v + b_in[lc];
        if (c >= 1024) o = 1.f / (1.f + expf(-o));
        ZN[(size_t)r * 3072 + c] = f2bf(o); }
};
struct EpiKctx {
    bf16_t* KC; const float* b_in;
    __device__ __forceinline__ void operator()(int r, int c, float v, float) const { KC[(size_t)r * 512 + c] = f2bf(v + b_in[2048 + c]); }
};
struct EpiVctxT {
    bf16_t* VT; const float* b_in;
    __device__ __forceinline__ void operator()(int r, int c, float v, float) const { VT[(size_t)r * 512 + c] = f2bf(v + b_in[2560 + r]); }
};
struct EpiMerged {
    bf16_t* MG; const bf16_t* ZN;
    __device__ __forceinline__ void operator()(int r, int c, float v, float v2) const {
        const float gh = bf2f(ZN[(size_t)r * 3072 + 1024 + c]), gn = bf2f(ZN[(size_t)r * 3072 + 2048 + c]);
        MG[(size_t)r * DM + c] = f2bf(gh * v + gn * v2); }
};
struct EpiOut {
    float* X1; const float* x; const float* mod;
    __device__ __forceinline__ void operator()(int r, int c, float v, float) const { const int b = r / SEQ; X1[(size_t)r * DM + c] = x[(size_t)r * DM + c] + mod[b * 6144 + 2 * 1024 + c] * v; }
};
struct EpiQP {
    bf16_t* QP;
    __device__ __forceinline__ void operator()(int r, int c, float v, float) const { QP[(size_t)r * 2048 + c] = f2bf(v); }
};


template <int MODE>
__device__ __forceinline__ void ph_gemm_ctx(const bf16_t* A, const bf16_t* Bt, const float* b_in, const float* kg, bf16_t* O, int wt0) {
    int tix_ = threadIdx.x; asm volatile("" : "+v"(tix_));
    const int wave = tix_ >> 6, lane = tix_ & 63, fr = lane & 15, fq = lane >> 4;
    for (int wt = blockIdx.x * NWAVE + wave - wt0; wt < 256; wt += opq_gx() * NWAVE) {
        if (wt < 0) continue;
        const int row0 = (wt >> 3) * 16, col0 = (wt & 7) * 64;
        f32x4 acc[4];
#pragma unroll
        for (int n = 0; n < 4; ++n) acc[n] = (f32x4){0.f, 0.f, 0.f, 0.f};
        const bf16_t* ap = A + (size_t)(row0 + fr) * 1024 + fq * 8; const bf16_t* bp = Bt + (size_t)(col0 + fr) * 1024 + fq * 8;
#pragma unroll 4
        for (int k0 = 0; k0 < 1024; k0 += 32) {
            const bf16x8 a = *(const bf16x8*)(ap + k0);
#pragma unroll
            for (int n = 0; n < 4; ++n) acc[n] = __builtin_amdgcn_mfma_f32_16x16x32_bf16(a, *(const bf16x8*)(bp + (size_t)n * 16 * 1024 + k0), acc[n], 0, 0, 0);
        }
#pragma unroll
        for (int j = 0; j < 4; ++j) {
            const int r = row0 + 4 * fq + j;
            if (MODE == 0) {
                float v[4]; float ss = 0.f;
#pragma unroll
                for (int n = 0; n < 4; ++n) { v[n] = acc[n][j] + b_in[2048 + col0 + 16 * n + fr]; ss += v[n] * v[n]; }
                ss += __shfl_xor(ss, 1); ss += __shfl_xor(ss, 2); ss += __shfl_xor(ss, 4); ss += __shfl_xor(ss, 8);
                const float rstd = 1.f / sqrtf(ss * (1.f / 64.f) + EPS);
#pragma unroll
                for (int n = 0; n < 4; ++n) O[(size_t)r * 512 + col0 + 16 * n + fr] = f2bf(v[n] * rstd * kg[16 * n + fr]);
            } else {
                const float bias = b_in[2560 + r];
#pragma unroll
                for (int n = 0; n < 4; ++n) O[(size_t)r * 512 + col0 + 16 * n + fr] = f2bf(acc[n][j] + bias);
            }
        }
    }
}
__device__ __forceinline__ void ph_gemm_ctx2(const bf16_t* HCTX, const bf16_t* WKC_T, const bf16_t* WV_T, const float* b_in, const float* kg, bf16_t* KC, bf16_t* VCT, LAS float* lds) {
    int tix_ = threadIdx.x; asm volatile("" : "+v"(tix_));
    const int wave = __builtin_amdgcn_readfirstlane(tix_ >> 6), lane = tix_ & 63, fr = lane & 15, fq = lane >> 4;
    for (int tt = blockIdx.x; tt < 512; tt += gridDim.x) {
        const int mode = tt >> 8, wt = tt & 255, row0 = (wt >> 3) * 16, col0 = (wt & 7) * 64;
        const bf16_t* A = mode == 0 ? HCTX : WV_T; const bf16_t* Bt = mode == 0 ? WKC_T : HCTX;
        const bf16_t* ap = A + (size_t)(row0 + fr) * 1024 + wave * 128 + fq * 8; const bf16_t* bp = Bt + (size_t)(col0 + fr) * 1024 + wave * 128 + fq * 8;
        bf16x8 a[4], bq[4][4];
#pragma unroll
        for (int ks = 0; ks < 4; ++ks) { a[ks] = *(const bf16x8*)(ap + ks * 32);
#pragma unroll
            for (int n = 0; n < 4; ++n) bq[n][ks] = *(const bf16x8*)(bp + (size_t)n * 16 * 1024 + ks * 32); }
        f32x4 acc[4];
#pragma unroll
        for (int n = 0; n < 4; ++n) { acc[n] = (f32x4){0.f, 0.f, 0.f, 0.f};
#pragma unroll
            for (int ks = 0; ks < 4; ++ks) acc[n] = __builtin_amdgcn_mfma_f32_16x16x32_bf16(a[ks], bq[n][ks], acc[n], 0, 0, 0); }
#pragma unroll
        for (int n = 0; n < 4; ++n) *(LAS f32x4*)(lds + (wave * 64 + lane) * 16 + 4 * n) = acc[n];
        __syncthreads();
        if (wave == 0) {
#pragma unroll
            for (int w = 1; w < 8; ++w)
#pragma unroll
                for (int n = 0; n < 4; ++n) acc[n] += *(const LAS f32x4*)(lds + (w * 64 + lane) * 16 + 4 * n);
#pragma unroll
            for (int j = 0; j < 4; ++j) {
                const int r = row0 + 4 * fq + j;
                if (mode == 0) {
                    float v[4]; float ss = 0.f;
#pragma unroll
                    for (int n = 0; n < 4; ++n) { v[n] = acc[n][j] + b_in[2048 + col0 + 16 * n + fr]; ss += v[n] * v[n]; }
                    ss += __shfl_xor(ss, 1); ss += __shfl_xor(ss, 2); ss += __shfl_xor(ss, 4); ss += __shfl_xor(ss, 8);
                    const float rstd = 1.f / sqrtf(ss * (1.f / 64.f) + EPS);
#pragma unroll
                    for (int n = 0; n < 4; ++n) KC[(size_t)r * 512 + col0 + 16 * n + fr] = f2bf(v[n] * rstd * kg[16 * n + fr]);
                } else {
                    const float bias = b_in[2560 + r];
#pragma unroll
                    for (int n = 0; n < 4; ++n) VCT[(size_t)r * 512 + col0 + 16 * n + fr] = f2bf(acc[n][j] + bias);
                }
            }
        }
        __syncthreads();
    }
}

__device__ __forceinline__ void ph_headnorm(bf16_t* buf, int ld, int col0, int nrows, const float* g, int rope) {
    int tix_ = threadIdx.x; asm volatile("" : "+v"(tix_));
    for (int gi = blockIdx.x * NTHR + tix_; gi < nrows * NH; gi += gridDim.x * NTHR) {
        const int row = gi / NH, h = gi % NH;
        bf16_t* p = buf + (size_t)row * ld + col0 + h * HD;
        float v[64]; float s = 0.f;
#pragma unroll
        for (int i = 0; i < 64; ++i) { v[i] = bf2f(p[i]); s += v[i] * v[i]; }
        const float rstd = 1.f / sqrtf(s * (1.f / 64.f) + EPS);
#pragma unroll
        for (int i = 0; i < 64; ++i) v[i] = v[i] * rstd * g[i];
        if (rope) {
            const int pos = row % SEQ; const float pr = (float)(pos / GRID_W), pc = (float)(pos % GRID_W);
#pragma unroll
            for (int i = 0; i < 16; ++i) {
                const float inv = expf(-(float)i * 0.5756462732485114f);
                float sn = __sinf(pr * inv), cs = __cosf(pr * inv);
                const float a = v[i], b = v[16 + i]; v[i] = a * cs - b * sn; v[16 + i] = a * sn + b * cs;
                sn = __sinf(pc * inv); cs = __cosf(pc * inv);
                const float a2 = v[32 + i], b2 = v[48 + i]; v[32 + i] = a2 * cs - b2 * sn; v[48 + i] = a2 * sn + b2 * cs;
            }
        }
#pragma unroll
        for (int i = 0; i < 64; ++i) p[i] = f2bf(v[i]);
    }
}

__device__ __forceinline__ void ph_filter_mlp(const P& p, _Float16* h3, float* lds) {
    int tix_ = threadIdx.x; asm volatile("" : "+v"(tix_));
    float* hA = lds; float* hB = lds + 64 * 65;
    const int tl = tix_ & 63, part = __builtin_amdgcn_readfirstlane(tix_ >> 6);
    for (int it = blockIdx.x; it < SEQ / 64; it += gridDim.x) {
        const int t = it * 64 + tl;
        {
            const float tt = (float)t / (float)(SEQ - 1), w = (6.283185307179586f / (float)SEQ) * (float)t;
            if (part == 0) hA[0 * 65 + tl] = tt;
            for (int k = part * 2; k < part * 2 + 2; ++k) { const float band = 1e-4f + (float)k * ((15.f - 1e-4f) / 15.f); float sn, cs; sincosf(band * w, &sn, &cs); hA[(1 + k) * 65 + tl] = cs; hA[(17 + k) * 65 + tl] = -sn; }
        }
        __syncthreads();
        float acc[8];
#pragma unroll
        for (int o = 0; o < 8; ++o) acc[o] = p.f1b[part * 8 + o];
#pragma unroll 3
        for (int i = 0; i < HY_EMB; ++i) { const float x = hA[i * 65 + tl];
#pragma unroll
            for (int o = 0; o < 8; ++o) acc[o] += x * p.f1w[i * 64 + part * 8 + o]; }
#pragma unroll
        for (int o = 0; o < 8; ++o) hB[(part * 8 + o) * 65 + tl] = sinf(p.freq[part * 8 + o] * acc[o]);
        __syncthreads();
#pragma unroll
        for (int o = 0; o < 8; ++o) acc[o] = p.f2b[part * 8 + o];
#pragma unroll 4
        for (int i = 0; i < 64; ++i) { const float x = hB[i * 65 + tl];
#pragma unroll
            for (int o = 0; o < 8; ++o) acc[o] += x * p.f2w[i * 64 + part * 8 + o]; }
#pragma unroll
        for (int o = 0; o < 8; ++o) hA[(part * 8 + o) * 65 + tl] = sinf(p.freq[part * 8 + o] * acc[o]);
        __syncthreads();
#pragma unroll
        for (int o = 0; o < 8; ++o) acc[o] = p.f3b[part * 8 + o];
#pragma unroll 4
        for (int i = 0; i < 64; ++i) { const float x = hA[i * 65 + tl];
#pragma unroll
            for (int o = 0; o < 8; ++o) acc[o] += x * p.f3w[i * 64 + part * 8 + o]; }
#pragma unroll
        for (int o = 0; o < 8; ++o) h3[(size_t)t * 64 + part * 8 + o] = (_Float16)sinf(p.freq[part * 8 + o] * acc[o]);
        __syncthreads();
    }
}

typedef _Float16 f16x8 __attribute__((ext_vector_type(8)));
__device__ __forceinline__ void ph_f4t(const float* f4w, _Float16* F4T) {
    int tix_ = threadIdx.x; asm volatile("" : "+v"(tix_));
    for (int e = blockIdx.x * NTHR + tix_; e < 2048 * 64; e += gridDim.x * NTHR) { const int c = e >> 6, i = e & 63; F4T[e] = (_Float16)f4w[(size_t)i * 2048 + c]; }
}
__device__ __forceinline__ void ph_filter_gemm(const _Float16* F4T, const _Float16* h3, _Float16* FILT) {
    int tix_ = threadIdx.x; asm volatile("" : "+v"(tix_));
    const int wave = tix_ >> 6, lane = tix_ & 63, fr = lane & 15, fq = lane >> 4;
    for (int wt = blockIdx.x * NWAVE + wave; wt < 32 * 128; wt += opq_gx() * NWAVE) {
        const int c0 = (wt >> 7) * 64, t0 = (wt & 127) * 64;
        f16x8 a[4][2], bb[4][2];
#pragma unroll
        for (int m = 0; m < 4; ++m)
#pragma unroll
            for (int ks = 0; ks < 2; ++ks) { a[m][ks] = *(const f16x8*)(F4T + (size_t)(c0 + m * 16 + fr) * 64 + ks * 32 + fq * 8); bb[m][ks] = *(const f16x8*)(h3 + (size_t)(t0 + m * 16 + fr) * 64 + ks * 32 + fq * 8); }
#pragma unroll
        for (int m = 0; m < 4; ++m) {
            const float a0 = -4.605170185988091f / 1.5f, a1 = -4.605170185988091f / 0.3f;
#pragma unroll
            for (int n = 0; n < 4; ++n) {
                f32x4 acc = (f32x4){0.f, 0.f, 0.f, 0.f};
                acc = __builtin_amdgcn_mfma_f32_16x16x32_f16(bb[n][0], a[m][0], acc, 0, 0, 0);
                acc = __builtin_amdgcn_mfma_f32_16x16x32_f16(bb[n][1], a[m][1], acc, 0, 0, 0);
                const int c = c0 + m * 16 + fr, tq = t0 + n * 16 + fq * 4; const float delta = fabsf(a0 + (float)(c & 511) * ((a1 - a0) / 511.f));
                typedef _Float16 f16x4_t __attribute__((ext_vector_type(4)));
                f16x4_t o;
#pragma unroll
                for (int j = 0; j < 4; ++j) { const float tt = (float)(tq + j) / (float)(SEQ - 1); o[j] = (_Float16)(acc[j] * __expf(-tt * delta)); }
                *(f16x4_t*)(FILT + (size_t)c * SEQ + tq) = o;
            }
        }
    }
}

__device__ __forceinline__ void ph_filter_fin(const float* h3, const float* f4w, float* FILT, float* lds) {
    int tix_ = threadIdx.x; asm volatile("" : "+v"(tix_));
    float* w4 = lds;
    float* red = lds + 256;
    const int tid = tix_, lane = tid & 63, wid = tid >> 6;
    for (int d = blockIdx.x; d < D_HY; d += gridDim.x) {
        if (tid < 256) { const int i = tid >> 2, q = tid & 3; w4[i * 4 + q] = f4w[(size_t)i * 2048 + q * 512 + d]; }
        __syncthreads();
        const float a = -4.605170185988091f / 1.5f, bq = -4.605170185988091f / 0.3f;
        const float delta = fabsf(a + (float)d * ((bq - a) / 511.f));
        float s0 = 0.f, s1 = 0.f;
#pragma unroll 1
        for (int t = tid; t < SEQ; t += NTHR) {
            const f32x4* hr = (const f32x4*)(h3 + (size_t)t * 64);
            float v0 = 0.f, v1 = 0.f, v2 = 0.f, v3 = 0.f;
#pragma unroll 2
            for (int i4 = 0; i4 < 16; ++i4) { const f32x4 hv = hr[i4];
                const f32x4 wa = *(const f32x4*)(w4 + 16 * i4), wb = *(const f32x4*)(w4 + 16 * i4 + 4), wc = *(const f32x4*)(w4 + 16 * i4 + 8), wd = *(const f32x4*)(w4 + 16 * i4 + 12);
                v0 += hv.x * wa.x + hv.y * wb.x + hv.z * wc.x + hv.w * wd.x;
                v1 += hv.x * wa.y + hv.y * wb.y + hv.z * wc.y + hv.w * wd.y;
                v2 += hv.x * wa.z + hv.y * wb.z + hv.z * wc.z + hv.w * wd.z;
                v3 += hv.x * wa.w + hv.y * wb.w + hv.z * wc.w + hv.w * wd.w; }
            const float tt = (float)t / (float)(SEQ - 1), dec = expf(-tt * delta);
            v0 *= dec; v1 *= dec; v2 *= dec; v3 *= dec;
            s0 += fabsf(v0) + fabsf(v1); s1 += fabsf(v2) + fabsf(v3);
            FILT[((size_t)(0 * 512 + d) * 2 + 0) * SEQ + t] = v0; FILT[((size_t)(0 * 512 + d) * 2 + 1) * SEQ + t] = v1;
            FILT[((size_t)(1 * 512 + d) * 2 + 0) * SEQ + t] = v2; FILT[((size_t)(1 * 512 + d) * 2 + 1) * SEQ + t] = v3;
        }
        s0 = wave_sum(s0); s1 = wave_sum(s1);
        if (lane == 0) { red[wid] = s0; red[8 + wid] = s1; }
        __syncthreads();
        float t0 = 0.f, t1 = 0.f;
#pragma unroll
        for (int w = 0; w < 8; ++w) { t0 += red[w]; t1 += red[8 + w]; }
        const float r0 = 1.f / t0, r1 = 1.f / t1;
        for (int t = tid; t < SEQ; t += NTHR) {
            FILT[((size_t)(0 * 512 + d) * 2 + 0) * SEQ + t] *= r0; FILT[((size_t)(0 * 512 + d) * 2 + 1) * SEQ + t] *= r0;
            FILT[((size_t)(1 * 512 + d) * 2 + 0) * SEQ + t] *= r1; FILT[((size_t)(1 * 512 + d) * 2 + 1) * SEQ + t] *= r1;
        }
        __syncthreads();
    }
}

typedef _Float16 h2_t __attribute__((ext_vector_type(2)));
__device__ __forceinline__ float shortconv(const bf16_t* row, int t, float w0, float w1, float w2, float cb) {
    const float zm = t > 0 ? bf2f(row[t - 1]) : 0.f, z0 = bf2f(row[t]), zp = t < SEQ - 1 ? bf2f(row[t + 1]) : 0.f;
    return w0 * zm + w1 * z0 + w2 * zp + cb;
}
__device__ __forceinline__ void ph_hyena_fft(bf16_t* ZT, const _Float16* FILT, const float* cw, const float* cb, const float* skip, bf16_t* HYO, h2_t* KFS, LAS fc2* L) {
    int tix_ = threadIdx.x; asm volatile("" : "+v"(tix_));
    const int tid = tix_;
    h2_t* KF0 = KFS; h2_t* KF1 = KFS + FN;
    LAS float* FS = (LAS float*)(L + FLDS_ELEMS);
    for (int d = blockIdx.x; d < D_HY; d += gridDim.x) {
        {
            LAS _Float16* FL = (LAS _Float16*)L;
            int tq = tid; asm volatile("" : "+v"(tq));
            __syncthreads();
#pragma unroll
            for (int k = 0; k < 8; ++k) { const int ch = tq + 512 * k, s = ch >> 10, off = (ch & 1023) * 8;
                typedef unsigned u32x4v_t __attribute__((ext_vector_type(4)));
                const u32x4v_t v = *(const u32x4v_t*)(FILT + (size_t)(s * 512 + d) * SEQ + off);
                *(LAS u32x4v_t*)(FL + s * SEQ + off) = v; }
            __syncthreads();
            float re[32], im[32];
            float s0 = 0.f, s1 = 0.f;
#pragma unroll
            for (int n1 = 0; n1 < 16; ++n1) { re[n1] = (float)FL[0 * SEQ + tq + 512 * n1]; im[n1] = (float)FL[2 * SEQ + tq + 512 * n1]; s0 += fabsf(re[n1]); s1 += fabsf(im[n1]); }
#pragma unroll
            for (int n1 = 16; n1 < 32; ++n1) { const int m = tq + 512 * (n1 - 16); const float vb0 = (float)FL[1 * SEQ + (m == 0 ? 0 : SEQ - m)], vb1 = (float)FL[3 * SEQ + (m == 0 ? 0 : SEQ - m)]; s0 += fabsf(vb0); s1 += fabsf(vb1);
                re[n1] = m == 0 ? 0.f : vb0; im[n1] = m == 0 ? 0.f : vb1; }
            s0 = wave_sum(s0); s1 = wave_sum(s1);
            if ((tid & 63) == 0) { FS[(tid >> 6) * 2] = s0; FS[(tid >> 6) * 2 + 1] = s1; }
            __syncthreads();
            fpassF1(tid, L, re, im);
        }
        __syncthreads();
        float sc0 = 0.f, sc1 = 0.f;
#pragma unroll
        for (int w = 0; w < 8; ++w) { sc0 += FS[2 * w]; sc1 += FS[2 * w + 1]; }
        sc0 = 1.f / sc0; sc1 = 1.f / sc1;
        fpassF2(tid, L);
        __syncthreads();
        fpassF3(tid, L);
        __syncthreads();
        funpack<h2_t, _Float16>(tid, L, KF0, KF1, sc0, sc1, skip[d], skip[512 + d]);
        __syncthreads();
        LAS bf16_t* ZL = (LAS bf16_t*)L;
        {
            int tq = tid; asm volatile("" : "+v"(tq));
#pragma unroll
            for (int k = 0; k < 12; ++k) { const int ch = tq + 512 * k, s = ch >> 10, off = (ch & 1023) * 8;
                typedef unsigned u32x4v_t __attribute__((ext_vector_type(4)));
                const u32x4v_t v = *(const u32x4v_t*)(ZT + (size_t)((s >> 1) * 512 + d) * T + (size_t)(s & 1) * SEQ + off);
                *(LAS u32x4v_t*)(ZL + s * SEQ + off) = v; }
        }
        __syncthreads();
        float xr[16], xi[16];
        {
            int tq = tid; asm volatile("" : "+v"(tq));
#pragma unroll
            for (int sg = 0; sg < 3; ++sg) {
                const int c = sg * 512 + d; const float w0 = cw[c], w1 = cw[1536 + c], w2 = cw[3072 + c], bb = cb[c];
#pragma unroll
                for (int bt = 0; bt < 2; ++bt) {
                    const LAS bf16_t* zr = ZL + (sg * 2 + bt) * SEQ; float cv[16];
#pragma unroll
                    for (int i = 0; i < 16; ++i) { const int t = tq + 512 * i;
                        const float zm = t > 0 ? bf2f(zr[t - 1]) : 0.f, z0 = bf2f(zr[t]), zp = t < SEQ - 1 ? bf2f(zr[t + 1]) : 0.f;
                        cv[i] = w0 * zm + w1 * z0 + w2 * zp + bb; }
                    if (sg == 0) {
#pragma unroll
                        for (int i = 0; i < 16; ++i) { if (bt == 0) xr[i] = cv[i]; else xi[i] = cv[i]; }
                    } else {
                        uint4 p0, p1; p0.x = pk_bf16(cv[0], cv[1]); p0.y = pk_bf16(cv[2], cv[3]); p0.z = pk_bf16(cv[4], cv[5]); p0.w = pk_bf16(cv[6], cv[7]);
                        p1.x = pk_bf16(cv[8], cv[9]); p1.y = pk_bf16(cv[10], cv[11]); p1.z = pk_bf16(cv[12], cv[13]); p1.w = pk_bf16(cv[14], cv[15]);
                        bf16_t* gp = ZT + (size_t)c * T + (size_t)bt * SEQ + tq * 16;
                        *(uint4*)gp = p0; *(uint4*)(gp + 8) = p1;
                    }
                }
            }
        }
        __syncthreads();
#pragma unroll 1
        for (int o = 0; o < 2; ++o) {
            fpassF1z(tid, L, xr, xi);
            __syncthreads();
            fpassF2(tid, L);
            __syncthreads();
            fpassF3KI3<h2_t>(tid, L, o == 0 ? KF0 : KF1);
            __syncthreads();
            fpassI2(tid, L);
            __syncthreads();
            uint4 a0, a1, b0, b1;
            { int tq = tid; asm volatile("" : "+v"(tq));
              const bf16_t* gp = ZT + (size_t)((o + 1) * 512 + d) * T + tq * 16;
              a0 = *(const uint4*)gp; a1 = *(const uint4*)(gp + 8); b0 = *(const uint4*)(gp + SEQ); b1 = *(const uint4*)(gp + SEQ + 8); }
            __builtin_amdgcn_sched_barrier(0);
            fpassI1h(tid, L, xr, xi);
            {
                const unsigned ga[8] = {a0.x, a0.y, a0.z, a0.w, a1.x, a1.y, a1.z, a1.w}, gb[8] = {b0.x, b0.y, b0.z, b0.w, b1.x, b1.y, b1.z, b1.w};
#pragma unroll
                for (int i = 0; i < 8; ++i) {
                    xr[2 * i] *= __uint_as_float(ga[i] << 16) * (1.f / FN); xr[2 * i + 1] *= __uint_as_float(ga[i] & 0xffff0000u) * (1.f / FN);
                    xi[2 * i] *= __uint_as_float(gb[i] << 16) * (1.f / FN); xi[2 * i + 1] *= __uint_as_float(gb[i] & 0xffff0000u) * (1.f / FN);
                }
            }
        }
        {
            int tq = tid; asm volatile("" : "+v"(tq));
            uint4 p0, p1;
            p0.x = pk_bf16(xr[0], xr[1]); p0.y = pk_bf16(xr[2], xr[3]); p0.z = pk_bf16(xr[4], xr[5]); p0.w = pk_bf16(xr[6], xr[7]);
            p1.x = pk_bf16(xr[8], xr[9]); p1.y = pk_bf16(xr[10], xr[11]); p1.z = pk_bf16(xr[12], xr[13]); p1.w = pk_bf16(xr[14], xr[15]);
            bf16_t* op = ZT + (size_t)d * T + tq * 16;
            *(uint4*)op = p0; *(uint4*)(op + 8) = p1;
            p0.x = pk_bf16(xi[0], xi[1]); p0.y = pk_bf16(xi[2], xi[3]); p0.z = pk_bf16(xi[4], xi[5]); p0.w = pk_bf16(xi[6], xi[7]);
            p1.x = pk_bf16(xi[8], xi[9]); p1.y = pk_bf16(xi[10], xi[11]); p1.z = pk_bf16(xi[12], xi[13]); p1.w = pk_bf16(xi[14], xi[15]);
            *(uint4*)(op + SEQ) = p0; *(uint4*)(op + SEQ + 8) = p1;
        }
    }
}

#define HN_PITCH 1024
__device__ __forceinline__ void ph_hy_transpose(const bf16_t* ZT, bf16_t* HYO, LAS unsigned char* ldsb) {
    int tix_ = threadIdx.x; asm volatile("" : "+v"(tix_));
    const int wave = tix_ >> 6, lane = tix_ & 63;
    LAS bf16_t* tl = (LAS bf16_t*)ldsb + wave * (64 * 66);
    for (int wt = blockIdx.x * NWAVE + wave; wt < 2 * 8 * 128; wt += opq_gx() * NWAVE) {
        const int tc = wt & 127, dc = (wt >> 7) & 7, bt = wt >> 10;
#pragma unroll
        for (int k = 0; k < 8; ++k) { const int r = 8 * k + (lane >> 3), c8 = (lane & 7) * 8;
            const uint4 v = *(const uint4*)(ZT + (size_t)(dc * 64 + r) * T + (size_t)bt * SEQ + tc * 64 + c8);
            const unsigned w[4] = {v.x, v.y, v.z, v.w};
#pragma unroll
            for (int e = 0; e < 4; ++e) { tl[(c8 + 2 * e) * 66 + r] = (bf16_t)(w[e] & 0xffffu); tl[(c8 + 2 * e + 1) * 66 + r] = (bf16_t)(w[e] >> 16); } }
        asm volatile("s_waitcnt lgkmcnt(0)" ::: "memory");
#pragma unroll
        for (int k = 0; k < 8; ++k) { const int x = 8 * k + (lane >> 3), c8 = (lane & 7) * 8; const int t = (tc * 4 + (x >> 4)) + 512 * (x & 15);
            const LAS bf16_t* sp = tl + x * 66 + c8;
            uint4 o; o.x = (unsigned)sp[0] | ((unsigned)sp[1] << 16); o.y = (unsigned)sp[2] | ((unsigned)sp[3] << 16); o.z = (unsigned)sp[4] | ((unsigned)sp[5] << 16); o.w = (unsigned)sp[6] | ((unsigned)sp[7] << 16);
            *(uint4*)(HYO + ((size_t)bt * SEQ + t) * HN_PITCH + dc * 64 + c8) = o; }
        asm volatile("s_waitcnt lgkmcnt(0)" ::: "memory");
    }
}

typedef short s16x4_t __attribute__((ext_vector_type(4)));

__device__ __forceinline__ void ph_natten_mfma(const bf16_t* ZN, const bf16_t* VT, const bf16_t* KC, const bf16_t* VCT, const float* rpb, bf16_t* NAO) {
    int tix_ = threadIdx.x; asm volatile("" : "+v"(tix_));
    const int wave = tix_ >> 6, lane = tix_ & 63, q = lane & 15, g = lane >> 4;
    const bool xcdmap = (gridDim.x & 7) == 0;
    const int ustart = xcdmap ? (int)(blockIdx.x >> 3) * NWAVE + wave : (int)blockIdx.x * NWAVE + wave, ustep = xcdmap ? (int)(gridDim.x >> 3) * NWAVE : (int)opq_gx() * NWAVE;
    const int uend = xcdmap ? BATCH * 128 * 4 : BATCH * 128 * NH * 4;
    for (int uu = ustart; uu < uend; uu += ustep) {
        const int unit = xcdmap ? (((uu >> 2) << 5) | ((int)(blockIdx.x & 7) << 2) | (uu & 3)) : uu;
        const int c0 = (unit & 3) * 16, h = (unit >> 2) & 7, r = (unit >> 5) & 127, b = unit >> 12;
        int w0 = c0 - 8; w0 = w0 < 0 ? 0 : (w0 > 32 ? 32 : w0);
        int rs = r - 4; rs = rs < 0 ? 0 : (rs > 120 ? 120 : rs);
        const int tq = b * SEQ + r * GRID_W + c0 + q;
        bf16x8 qf[2];
#pragma unroll
        for (int ks = 0; ks < 2; ++ks) qf[ks] = *(const bf16x8*)(ZN + (size_t)tq * 3072 + h * HD + ks * 32 + g * 8);
        f32x4 s[32];
#pragma unroll
        for (int grp = 0; grp < 4; ++grp) {
            bf16x8 ka[8][2];
#pragma unroll
            for (int i8 = 0; i8 < 8; ++i8) {
                const int blk = grp * 8 + i8;
                const bf16_t* kp = blk < 16
                    ? ZN + (size_t)(b * SEQ + (rs + (blk >> 1)) * GRID_W + w0 + 8 * (q >> 2) + 4 * (blk & 1) + (q & 3)) * 3072 + 512 + h * HD + g * 8
                    : KC + (size_t)(b * CTX + ((blk - 16) >> 1) * 32 + 8 * (q >> 2) + 4 * (blk & 1) + (q & 3)) * 512 + h * HD + g * 8;
                ka[i8][0] = *(const bf16x8*)kp; ka[i8][1] = *(const bf16x8*)(kp + 32);
            }
            __builtin_amdgcn_sched_barrier(0);
#pragma unroll
            for (int i8 = 0; i8 < 8; ++i8) {
                f32x4 acc = (f32x4){0.f, 0.f, 0.f, 0.f};
                acc = __builtin_amdgcn_mfma_f32_16x16x32_bf16(ka[i8][0], qf[0], acc, 0, 0, 0);
                s[grp * 8 + i8] = __builtin_amdgcn_mfma_f32_16x16x32_bf16(ka[i8][1], qf[1], acc, 0, 0, 0);
            }
            __builtin_amdgcn_sched_barrier(0);
        }
        const int qc = c0 + q; int cs = qc - 8; cs = cs < 0 ? 0 : (cs > 48 ? 48 : cs);
        float mx = -1e30f;
        {
            float bia[16][4];
#pragma unroll
            for (int blk = 0; blk < 16; ++blk) {
                const float* brow = rpb + (h * 15 + (rs + (blk >> 1) - r + 7)) * 31 + 15;
#pragma unroll
                for (int e = 0; e < 4; ++e) { int dc = w0 + 8 * g + 4 * (blk & 1) + e - qc; dc = dc < -15 ? -15 : (dc > 15 ? 15 : dc); bia[blk][e] = brow[dc]; }
            }
            __builtin_amdgcn_sched_barrier(0);
#pragma unroll
            for (int blk = 0; blk < 16; ++blk)
#pragma unroll
                for (int e = 0; e < 4; ++e) {
                    const int kc = w0 + 8 * g + 4 * (blk & 1) + e;
                    const bool ok = kc >= cs && kc < cs + 16;
                    const float v = ok ? s[blk][e] * 0.125f + bia[blk][e] : -1e30f;
                    s[blk][e] = v; mx = fmaxf(mx, v);
                }
        }
#pragma unroll
        for (int j = 16; j < 32; ++j)
#pragma unroll
            for (int e = 0; e < 4; ++e) { const float v = s[j][e] * 0.125f; s[j][e] = v; mx = fmaxf(mx, v); }
        mx = fmaxf(mx, __shfl_xor(mx, 16)); mx = fmaxf(mx, __shfl_xor(mx, 32));
        float sum = 0.f;
        unsigned pbu[16][4];
#pragma unroll
        for (int kk = 0; kk < 16; ++kk) {
            float pe[8];
#pragma unroll
            for (int e = 0; e < 4; ++e) { pe[e] = __expf(s[2 * kk][e] - mx); pe[4 + e] = __expf(s[2 * kk + 1][e] - mx); }
#pragma unroll
            for (int e = 0; e < 8; ++e) sum += pe[e];
            pbu[kk][0] = pk_bf16(pe[0], pe[1]); pbu[kk][1] = pk_bf16(pe[2], pe[3]); pbu[kk][2] = pk_bf16(pe[4], pe[5]); pbu[kk][3] = pk_bf16(pe[6], pe[7]);
        }
        sum += __shfl_xor(sum, 16); sum += __shfl_xor(sum, 32);
        const float rinv = 1.f / sum;
        f32x4 o[4];
#pragma unroll
        for (int mt = 0; mt < 4; ++mt) o[mt] = (f32x4){0.f, 0.f, 0.f, 0.f};
#pragma unroll
        for (int grp = 0; grp < 4; ++grp) {
            bf16x8 va[4][4];
#pragma unroll
            for (int k4 = 0; k4 < 4; ++k4) {
                const int kk = grp * 4 + k4;
#pragma unroll
                for (int mt = 0; mt < 4; ++mt) {
                    const bf16_t* vp = kk < 8 ? VT + (size_t)(h * HD + 16 * mt + q) * VPITCH + b * SEQ + (rs + kk) * GRID_W + w0 + 8 * g
                                              : VCT + (size_t)(h * HD + 16 * mt + q) * 512 + b * CTX + (kk - 8) * 32 + 8 * g;
                    va[k4][mt] = *(const bf16x8*)vp;
                }
            }
            __builtin_amdgcn_sched_barrier(0);
#pragma unroll
            for (int k4 = 0; k4 < 4; ++k4) {
                const int kk = grp * 4 + k4;
                union { unsigned u[4]; bf16x8 v; } pb; pb.u[0] = pbu[kk][0]; pb.u[1] = pbu[kk][1]; pb.u[2] = pbu[kk][2]; pb.u[3] = pbu[kk][3];
#pragma unroll
                for (int mt = 0; mt < 4; ++mt) o[mt] = __builtin_amdgcn_mfma_f32_16x16x32_bf16(va[k4][mt], pb.v, o[mt], 0, 0, 0);
            }
            __builtin_amdgcn_sched_barrier(0);
        }
#pragma unroll
        for (int mt = 0; mt < 4; ++mt) {
            uint2 w; w.x = pk_bf16(o[mt][0] * rinv, o[mt][1] * rinv); w.y = pk_bf16(o[mt][2] * rinv, o[mt][3] * rinv);
            *(uint2*)(NAO + (size_t)tq * HN_PITCH + h * HD + 16 * mt + 4 * g) = w;
        }
    }
}

__device__ __forceinline__ void ph_natten_lds(const bf16_t* ZN, const bf16_t* VT, const bf16_t* KC, const bf16_t* VCT, const float* rpb, bf16_t* NAO, LAS unsigned char* lds) {
    int tix_ = threadIdx.x; asm volatile("" : "+v"(tix_));
    const int tid = tix_, wave = __builtin_amdgcn_readfirstlane(tid >> 6), lane = tid & 63, q_ = lane & 15, g_ = lane >> 4;
    typedef unsigned u32x4v_t __attribute__((ext_vector_type(4)));
    LAS unsigned char* KR = lds; LAS unsigned char* VR = lds + 65536; LAS float* XO = (LAS float*)(lds + 131072); LAS float* XM = XO + 4 * 1024;
    const int h = blockIdx.x & 7, nper = 256 / (int)(gridDim.x >> 3);
    const int i0 = (int)(blockIdx.x >> 3) * nper;
    const int tile = wave & 3, half = wave >> 2, c0 = tile * 16;
    int w0 = c0 - 8; w0 = w0 < 0 ? 0 : (w0 > 32 ? 32 : w0);
    const int cr = tid >> 3, ch = tid & 7;
    const int swz = ((ch ^ (cr & 7)) << 4) + cr * 128;
    int prev_b = -1, prev_rs = 0;
    u32x4v_t pre_k = (u32x4v_t){0u, 0u, 0u, 0u}, pre_v = (u32x4v_t){0u, 0u, 0u, 0u};
    bf16x8 qf[2], qn[2];
    { const int b = i0 >> 7, r = i0 & 127; const int tq = b * SEQ + r * GRID_W + c0 + q_;
#pragma unroll
      for (int ks = 0; ks < 2; ++ks) qn[ks] = *(const bf16x8*)(ZN + (size_t)tq * 3072 + h * HD + ks * 32 + g_ * 8); }
    for (int it = 0; it < nper; ++it) {
        int q = q_, g = g_; asm volatile("" : "+v"(q), "+v"(g));
        const int br = i0 + it, b = br >> 7, r = br & 127;
        int rs = r - 4; rs = rs < 0 ? 0 : (rs > 120 ? 120 : rs);
        const int tq = b * SEQ + r * GRID_W + c0 + q;
        qf[0] = qn[0]; qf[1] = qn[1];
        if (it == 0 || b != prev_b) {
            for (int R = rs; R < rs + 8; ++R) {
                const int slot = R & 7;
                const u32x4v_t kv = *(const u32x4v_t*)(ZN + (size_t)(b * SEQ + R * GRID_W + cr) * 3072 + 512 + h * HD + ch * 8);
                const u32x4v_t vv = *(const u32x4v_t*)(VT + (size_t)(h * HD + cr) * VPITCH + b * SEQ + R * GRID_W + ch * 8);
                *(LAS u32x4v_t*)(KR + slot * 8192 + swz) = kv; *(LAS u32x4v_t*)(VR + slot * 8192 + swz) = vv;
            }
        } else if (rs != prev_rs) {
            const int slot = (rs + 7) & 7;
            *(LAS u32x4v_t*)(KR + slot * 8192 + swz) = pre_k; *(LAS u32x4v_t*)(VR + slot * 8192 + swz) = pre_v;
        }
        prev_b = b; prev_rs = rs;
        __syncthreads();
        if (it + 1 < nper) {
            const int br2 = br + 1, b2 = br2 >> 7, r2 = br2 & 127; int rs2 = r2 - 4; rs2 = rs2 < 0 ? 0 : (rs2 > 120 ? 120 : rs2);
            if (b2 == b && rs2 != rs) {
                pre_k = *(const u32x4v_t*)(ZN + (size_t)(b * SEQ + (rs2 + 7) * GRID_W + cr) * 3072 + 512 + h * HD + ch * 8);
                pre_v = *(const u32x4v_t*)(VT + (size_t)(h * HD + cr) * VPITCH + b * SEQ + (rs2 + 7) * GRID_W + ch * 8);
            }
            const int tq2 = b2 * SEQ + r2 * GRID_W + c0 + q;
#pragma unroll
            for (int ks = 0; ks < 2; ++ks) qn[ks] = *(const bf16x8*)(ZN + (size_t)tq2 * 3072 + h * HD + ks * 32 + g * 8);
        }
        float mx = -1e30f, sum = 0.f;
        f32x4 o[4];
#pragma unroll
        for (int mt = 0; mt < 4; ++mt) o[mt] = (f32x4){0.f, 0.f, 0.f, 0.f};
        if (half == 0) {
            float bia[16][4];
            const int qc = c0 + q; int cs = qc - 8; cs = cs < 0 ? 0 : (cs > 48 ? 48 : cs);
#pragma unroll
            for (int blk = 0; blk < 16; ++blk) {
                const float* brow = rpb + (h * 15 + (rs + (blk >> 1) - r + 7)) * 31 + 15;
#pragma unroll
                for (int e = 0; e < 4; ++e) { int dc = w0 + 8 * g + 4 * (blk & 1) + e - qc; dc = dc < -15 ? -15 : (dc > 15 ? 15 : dc); bia[blk][e] = brow[dc]; }
            }
            f32x4 s[16];
#pragma unroll
            for (int blk = 0; blk < 16; ++blk) {
                const int col = w0 + 8 * (q >> 2) + 4 * (blk & 1) + (q & 3), slot = (rs + (blk >> 1)) & 7;
                const LAS unsigned char* kp = KR + slot * 8192 + col * 128;
                const bf16x8 a0 = *(const LAS bf16x8*)(kp + ((g ^ (col & 7)) << 4)), a1 = *(const LAS bf16x8*)(kp + (((4 + g) ^ (col & 7)) << 4));
                f32x4 acc = (f32x4){0.f, 0.f, 0.f, 0.f};
                acc = __builtin_amdgcn_mfma_f32_16x16x32_bf16(a0, qf[0], acc, 0, 0, 0);
                s[blk] = __builtin_amdgcn_mfma_f32_16x16x32_bf16(a1, qf[1], acc, 0, 0, 0);
            }
#pragma unroll
            for (int blk = 0; blk < 16; ++blk)
#pragma unroll
                for (int e = 0; e < 4; ++e) {
                    const int kc = w0 + 8 * g + 4 * (blk & 1) + e;
                    const bool ok = kc >= cs && kc < cs + 16;
                    const float v = ok ? s[blk][e] * 0.125f + bia[blk][e] : -1e30f;
                    s[blk][e] = v; mx = fmaxf(mx, v);
                }
            mx = fmaxf(mx, __shfl_xor(mx, 16)); mx = fmaxf(mx, __shfl_xor(mx, 32));
#pragma unroll
            for (int kk = 0; kk < 8; ++kk) {
                float pe[8];
#pragma unroll
                for (int e = 0; e < 4; ++e) { pe[e] = __expf(s[2 * kk][e] - mx); pe[4 + e] = __expf(s[2 * kk + 1][e] - mx); }
#pragma unroll
                for (int e = 0; e < 8; ++e) sum += pe[e];
                union { unsigned u[4]; bf16x8 v; } pb; pb.u[0] = pk_bf16(pe[0], pe[1]); pb.u[1] = pk_bf16(pe[2], pe[3]); pb.u[2] = pk_bf16(pe[4], pe[5]); pb.u[3] = pk_bf16(pe[6], pe[7]);
                const int slot = (rs + kk) & 7;
#pragma unroll
                for (int mt = 0; mt < 4; ++mt) { const int dr = 16 * mt + q;
                    const bf16x8 vf = *(const LAS bf16x8*)(VR + slot * 8192 + dr * 128 + ((((w0 >> 3) + g) ^ (dr & 7)) << 4));
                    o[mt] = __builtin_amdgcn_mfma_f32_16x16x32_bf16(vf, pb.v, o[mt], 0, 0, 0); }
            }
            sum += __shfl_xor(sum, 16); sum += __shfl_xor(sum, 32);
        } else {
            f32x4 s[16];
#pragma unroll
            for (int grp = 0; grp < 2; ++grp) {
                bf16x8 ka[8][2];
#pragma unroll
                for (int i8 = 0; i8 < 8; ++i8) { const int j2 = grp * 8 + i8;
                    const bf16_t* kp = KC + (size_t)(b * CTX + (j2 >> 1) * 32 + 8 * (q >> 2) + 4 * (j2 & 1) + (q & 3)) * 512 + h * HD + g * 8;
                    ka[i8][0] = *(const bf16x8*)kp; ka[i8][1] = *(const bf16x8*)(kp + 32); }
                __builtin_amdgcn_sched_barrier(0);
#pragma unroll
                for (int i8 = 0; i8 < 8; ++i8) { f32x4 acc = (f32x4){0.f, 0.f, 0.f, 0.f};
                    acc = __builtin_amdgcn_mfma_f32_16x16x32_bf16(ka[i8][0], qf[0], acc, 0, 0, 0);
                    s[grp * 8 + i8] = __builtin_amdgcn_mfma_f32_16x16x32_bf16(ka[i8][1], qf[1], acc, 0, 0, 0); }
                __builtin_amdgcn_sched_barrier(0);
            }
            bf16x8 va[8][4];
#pragma unroll
            for (int kk = 0; kk < 8; ++kk)
#pragma unroll
                for (int mt = 0; mt < 4; ++mt) va[kk][mt] = *(const bf16x8*)(VCT + (size_t)(h * HD + 16 * mt + q) * 512 + b * CTX + kk * 32 + 8 * g);
            __builtin_amdgcn_sched_barrier(0);
#pragma unroll
            for (int j2 = 0; j2 < 16; ++j2)
#pragma unroll
                for (int e = 0; e < 4; ++e) { const float v = s[j2][e] * 0.125f; s[j2][e] = v; mx = fmaxf(mx, v); }
            mx = fmaxf(mx, __shfl_xor(mx, 16)); mx = fmaxf(mx, __shfl_xor(mx, 32));
#pragma unroll
            for (int kk = 0; kk < 8; ++kk) {
                float pe[8];
#pragma unroll
                for (int e = 0; e < 4; ++e) { pe[e] = __expf(s[2 * kk][e] - mx); pe[4 + e] = __expf(s[2 * kk + 1][e] - mx); }
#pragma unroll
                for (int e = 0; e < 8; ++e) sum += pe[e];
                union { unsigned u[4]; bf16x8 v; } pb; pb.u[0] = pk_bf16(pe[0], pe[1]); pb.u[1] = pk_bf16(pe[2], pe[3]); pb.u[2] = pk_bf16(pe[4], pe[5]); pb.u[3] = pk_bf16(pe[6], pe[7]);
#pragma unroll
                for (int mt = 0; mt < 4; ++mt) o[mt] = __builtin_amdgcn_mfma_f32_16x16x32_bf16(va[kk][mt], pb.v, o[mt], 0, 0, 0);
            }
            sum += __shfl_xor(sum, 16); sum += __shfl_xor(sum, 32);
#pragma unroll
            for (int mt = 0; mt < 4; ++mt) *(LAS f32x4*)(XO + tile * 1024 + lane * 16 + 4 * mt) = o[mt];
            if (g == 0) { XM[tile * 32 + q] = mx; XM[tile * 32 + 16 + q] = sum; }
        }
        __syncthreads();
        if (half == 0) {
            const float mb = XM[tile * 32 + q], lb = XM[tile * 32 + 16 + q];
            const float m = fmaxf(mx, mb), fa = __expf(mx - m), fb = __expf(mb - m);
            const float rinv = 1.f / (sum * fa + lb * fb);
#pragma unroll
            for (int mt = 0; mt < 4; ++mt) {
                const f32x4 ob = *(const LAS f32x4*)(XO + tile * 1024 + lane * 16 + 4 * mt);
                const f32x4 oc = (o[mt] * fa + ob * fb) * rinv;
                uint2 w; w.x = pk_bf16(oc[0], oc[1]); w.y = pk_bf16(oc[2], oc[3]);
                *(uint2*)(NAO + (size_t)tq * HN_PITCH + h * HD + 16 * mt + 4 * g) = w;
            }
        }
    }
    __syncthreads();
}

__device__ __forceinline__ void ph_natten2(const bf16_t* ZN, const bf16_t* VT, const bf16_t* KC, const bf16_t* VCT, const float* rpb, bf16_t* NAO, unsigned char* SCR, LAS unsigned char* lds) {
    int tix_ = threadIdx.x; asm volatile("" : "+v"(tix_));
    const int tid = tix_, wave = __builtin_amdgcn_readfirstlane(tid >> 6), lane = tid & 63, q_ = lane & 15, g_ = lane >> 4;
    typedef unsigned u32x4v_t __attribute__((ext_vector_type(4)));
    const int h = blockIdx.x & 7, i0 = (int)(blockIdx.x >> 3) * 8, b = i0 >> 7;
    constexpr int TSTR = 2304;
    {
        LAS unsigned char* KL = lds; LAS unsigned char* VL = lds + 32768;
#pragma unroll
        for (int i = 0; i < 4; ++i) {
            const int key = (tid >> 3) + 64 * i, ch = tid & 7;
            *(LAS u32x4v_t*)(KL + key * 128 + ((ch ^ (key & 7)) << 4)) = *(const u32x4v_t*)(KC + (size_t)(b * CTX + key) * 512 + h * HD + ch * 8);
            const int dim = (tid >> 5) + 16 * i, c = tid & 31;
            *(LAS u32x4v_t*)(VL + dim * 512 + ((c ^ (dim & 7)) << 4)) = *(const u32x4v_t*)(VCT + (size_t)(h * HD + dim) * 512 + b * CTX + c * 8);
        }
        __syncthreads();
        bf16x8 qn[2];
        { const int tq = b * SEQ + (i0 & 127) * GRID_W + (wave & 3) * 16 + q_ + (wave >> 2) * GRID_W;
#pragma unroll
          for (int ks = 0; ks < 2; ++ks) qn[ks] = *(const bf16x8*)(ZN + (size_t)tq * 3072 + h * HD + ks * 32 + g_ * 8); }
#pragma unroll 1
        for (int tt = 0; tt < 4; ++tt) {
            int q = q_, g = g_; asm volatile("" : "+v"(q), "+v"(g));
            const int tile = wave + 8 * tt;
            bf16x8 qf[2]; qf[0] = qn[0]; qf[1] = qn[1];
            if (tt < 3) { const int t2 = tile + 8; const int tq2 = b * SEQ + ((i0 & 127) + (t2 >> 2)) * GRID_W + (t2 & 3) * 16 + q;
#pragma unroll
                for (int ks = 0; ks < 2; ++ks) qn[ks] = *(const bf16x8*)(ZN + (size_t)tq2 * 3072 + h * HD + ks * 32 + g * 8); }
            f32x4 s[16];
#pragma unroll
            for (int j = 0; j < 16; ++j) {
                const int key = (j >> 1) * 32 + 8 * (q >> 2) + 4 * (j & 1) + (q & 3);
                const LAS unsigned char* kp = KL + key * 128;
                const bf16x8 a0 = *(const LAS bf16x8*)(kp + ((g ^ (key & 7)) << 4)), a1 = *(const LAS bf16x8*)(kp + (((4 + g) ^ (key & 7)) << 4));
                f32x4 acc = (f32x4){0.f, 0.f, 0.f, 0.f};
                acc = __builtin_amdgcn_mfma_f32_16x16x32_bf16(a0, qf[0], acc, 0, 0, 0);
                s[j] = __builtin_amdgcn_mfma_f32_16x16x32_bf16(a1, qf[1], acc, 0, 0, 0);
            }
            float mx = -1e30f, sum = 0.f;
#pragma unroll
            for (int j = 0; j < 16; ++j)
#pragma unroll
                for (int e = 0; e < 4; ++e) { const float v = s[j][e] * 0.125f; s[j][e] = v; mx = fmaxf(mx, v); }
            mx = fmaxf(mx, __shfl_xor(mx, 16)); mx = fmaxf(mx, __shfl_xor(mx, 32));
            f32x4 o[4];
#pragma unroll
            for (int mt = 0; mt < 4; ++mt) o[mt] = (f32x4){0.f, 0.f, 0.f, 0.f};
#pragma unroll
            for (int kk = 0; kk < 8; ++kk) {
                float pe[8];
#pragma unroll
                for (int e = 0; e < 4; ++e) { pe[e] = __expf(s[2 * kk][e] - mx); pe[4 + e] = __expf(s[2 * kk + 1][e] - mx); }
#pragma unroll
                for (int e = 0; e < 8; ++e) sum += pe[e];
                union { unsigned u[4]; bf16x8 v; } pb; pb.u[0] = pk_bf16(pe[0], pe[1]); pb.u[1] = pk_bf16(pe[2], pe[3]); pb.u[2] = pk_bf16(pe[4], pe[5]); pb.u[3] = pk_bf16(pe[6], pe[7]);
#pragma unroll
                for (int mt = 0; mt < 4; ++mt) { const int dr = 16 * mt + q;
                    const bf16x8 vf = *(const LAS bf16x8*)(VL + dr * 512 + ((((4 * kk + g) ^ (dr & 7))) << 4));
                    o[mt] = __builtin_amdgcn_mfma_f32_16x16x32_bf16(vf, pb.v, o[mt], 0, 0, 0); }
            }
            sum += __shfl_xor(sum, 16); sum += __shfl_xor(sum, 32);
            unsigned char* sp = SCR + (size_t)tile * TSTR;
            uint4 w0, w1; w0.x = pk_bf16(o[0][0], o[0][1]); w0.y = pk_bf16(o[0][2], o[0][3]); w0.z = pk_bf16(o[1][0], o[1][1]); w0.w = pk_bf16(o[1][2], o[1][3]);
            w1.x = pk_bf16(o[2][0], o[2][1]); w1.y = pk_bf16(o[2][2], o[2][3]); w1.z = pk_bf16(o[3][0], o[3][1]); w1.w = pk_bf16(o[3][2], o[3][3]);
            *(uint4*)(sp + (q + 16 * g) * 32) = w0; *(uint4*)(sp + (q + 16 * g) * 32 + 16) = w1;
            if (g == 0) { *(float*)(sp + 2048 + 4 * q) = mx; *(float*)(sp + 2112 + 4 * q) = sum; }
        }
    }
    __syncthreads();
    {
        LAS unsigned char* KR = lds; LAS unsigned char* VR = lds + 73728;
        const int tile = wave & 3, rsel = wave >> 2, c0 = tile * 16;
        int w0 = c0 - 8; w0 = w0 < 0 ? 0 : (w0 > 32 ? 32 : w0);
        const int cr = tid >> 3, ch = tid & 7, swz = ((ch ^ (cr & 7)) << 4) + cr * 128;
        int have_hi = 0, bias_dro = -100;
        u32x4v_t pre_k[2], pre_v[2];
#pragma unroll
        for (int i = 0; i < 2; ++i) { pre_k[i] = (u32x4v_t){0u, 0u, 0u, 0u}; pre_v[i] = (u32x4v_t){0u, 0u, 0u, 0u}; }
        bf16x8 qn[2]; uint4 on0, on1; float mcn, lcn; float bia[16][4];
        {
            const int r = (i0 & 127) + rsel; const int tq = b * SEQ + r * GRID_W + c0 + q_;
#pragma unroll
            for (int ks = 0; ks < 2; ++ks) qn[ks] = *(const bf16x8*)(ZN + (size_t)tq * 3072 + h * HD + ks * 32 + g_ * 8);
            const unsigned char* sp = SCR + (size_t)(rsel * 4 + tile) * TSTR;
            on0 = *(const uint4*)(sp + lane * 32); on1 = *(const uint4*)(sp + lane * 32 + 16); mcn = *(const float*)(sp + 2048 + 4 * q_); lcn = *(const float*)(sp + 2112 + 4 * q_);
        }
#pragma unroll 1
        for (int pp = 0; pp < 4; ++pp) {
            int q = q_, g = g_; asm volatile("" : "+v"(q), "+v"(g));
            const int r0 = (i0 & 127) + 2 * pp, r = r0 + rsel;
            int lo = r0 - 4; lo = lo < 0 ? 0 : (lo > 120 ? 120 : lo);
            int rs1 = r0 - 3; rs1 = rs1 < 0 ? 0 : (rs1 > 120 ? 120 : rs1);
            const int hi = rs1 + 8;
            int rs = r - 4; rs = rs < 0 ? 0 : (rs > 120 ? 120 : rs);
            if (pp == 0) {
                for (int R = lo; R < hi; ++R) { const int slot = R % 9;
                    const u32x4v_t kv = *(const u32x4v_t*)(ZN + (size_t)(b * SEQ + R * GRID_W + cr) * 3072 + 512 + h * HD + ch * 8);
                    const u32x4v_t vv = *(const u32x4v_t*)(VT + (size_t)(h * HD + cr) * VPITCH + b * SEQ + R * GRID_W + ch * 8);
                    *(LAS u32x4v_t*)(KR + slot * 8192 + swz) = kv; *(LAS u32x4v_t*)(VR + slot * 8192 + swz) = vv; }
            } else {
                __syncthreads();
#pragma unroll
                for (int i = 0; i < 2; ++i) if (have_hi + i < hi) { const int slot = (have_hi + i) % 9;
                    *(LAS u32x4v_t*)(KR + slot * 8192 + swz) = pre_k[i]; *(LAS u32x4v_t*)(VR + slot * 8192 + swz) = pre_v[i]; }
            }
            have_hi = hi;
            __syncthreads();
            bf16x8 qf[2]; qf[0] = qn[0]; qf[1] = qn[1];
            const uint4 oc0 = on0, oc1 = on1; const float mc = mcn, lc = lcn;
            if (pp < 3) {
                const int r0n = r0 + 2; int rs1n = r0n - 3; rs1n = rs1n < 0 ? 0 : (rs1n > 120 ? 120 : rs1n); const int hin = rs1n + 8;
#pragma unroll
                for (int i = 0; i < 2; ++i) if (hi + i < hin) { const int R = hi + i;
                    pre_k[i] = *(const u32x4v_t*)(ZN + (size_t)(b * SEQ + R * GRID_W + cr) * 3072 + 512 + h * HD + ch * 8);
                    pre_v[i] = *(const u32x4v_t*)(VT + (size_t)(h * HD + cr) * VPITCH + b * SEQ + R * GRID_W + ch * 8); }
                const int tq2 = b * SEQ + (r + 2) * GRID_W + c0 + q;
#pragma unroll
                for (int ks = 0; ks < 2; ++ks) qn[ks] = *(const bf16x8*)(ZN + (size_t)tq2 * 3072 + h * HD + ks * 32 + g * 8);
                const unsigned char* sp = SCR + (size_t)((2 * pp + 2 + rsel) * 4 + tile) * TSTR;
                on0 = *(const uint4*)(sp + (q + 16 * g) * 32); on1 = *(const uint4*)(sp + (q + 16 * g) * 32 + 16); mcn = *(const float*)(sp + 2048 + 4 * q); lcn = *(const float*)(sp + 2112 + 4 * q);
            }
            if (rs - r != bias_dro) {
                bias_dro = rs - r; const int qc = c0 + q;
#pragma unroll
                for (int blk = 0; blk < 16; ++blk) {
                    const float* brow = rpb + (h * 15 + (rs + (blk >> 1) - r + 7)) * 31 + 15;
#pragma unroll
                    for (int e = 0; e < 4; ++e) { int dc = w0 + 8 * g + 4 * (blk & 1) + e - qc; dc = dc < -15 ? -15 : (dc > 15 ? 15 : dc); bia[blk][e] = brow[dc]; }
                }
            }
            const int tq = b * SEQ + r * GRID_W + c0 + q;
            const int qc = c0 + q; int cs = qc - 8; cs = cs < 0 ? 0 : (cs > 48 ? 48 : cs);
            f32x4 s[16];
#pragma unroll
            for (int blk = 0; blk < 16; ++blk) {
                const int col = w0 + 8 * (q >> 2) + 4 * (blk & 1) + (q & 3), slot = (rs + (blk >> 1)) % 9;
                const LAS unsigned char* kp = KR + slot * 8192 + col * 128;
                const bf16x8 a0 = *(const LAS bf16x8*)(kp + ((g ^ (col & 7)) << 4)), a1 = *(const LAS bf16x8*)(kp + (((4 + g) ^ (col & 7)) << 4));
                f32x4 acc = (f32x4){0.f, 0.f, 0.f, 0.f};
                acc = __builtin_amdgcn_mfma_f32_16x16x32_bf16(a0, qf[0], acc, 0, 0, 0);
                s[blk] = __builtin_amdgcn_mfma_f32_16x16x32_bf16(a1, qf[1], acc, 0, 0, 0);
            }
            float mx = -1e30f, sum = 0.f;
#pragma unroll
            for (int blk = 0; blk < 16; ++blk)
#pragma unroll
                for (int e = 0; e < 4; ++e) {
                    const int kc = w0 + 8 * g + 4 * (blk & 1) + e;
                    const bool ok = kc >= cs && kc < cs + 16;
                    const float v = ok ? s[blk][e] * 0.125f + bia[blk][e] : -1e30f;
                    s[blk][e] = v; mx = fmaxf(mx, v);
                }
            mx = fmaxf(mx, __shfl_xor(mx, 16)); mx = fmaxf(mx, __shfl_xor(mx, 32));
            f32x4 o[4];
#pragma unroll
            for (int mt = 0; mt < 4; ++mt) o[mt] = (f32x4){0.f, 0.f, 0.f, 0.f};
#pragma unroll
            for (int kk = 0; kk < 8; ++kk) {
                float pe[8];
#pragma unroll
                for (int e = 0; e < 4; ++e) { pe[e] = __expf(s[2 * kk][e] - mx); pe[4 + e] = __expf(s[2 * kk + 1][e] - mx); }
#pragma unroll
                for (int e = 0; e < 8; ++e) sum += pe[e];
                union { unsigned u[4]; bf16x8 v; } pb; pb.u[0] = pk_bf16(pe[0], pe[1]); pb.u[1] = pk_bf16(pe[2], pe[3]); pb.u[2] = pk_bf16(pe[4], pe[5]); pb.u[3] = pk_bf16(pe[6], pe[7]);
                const int slot = (rs + kk) % 9;
#pragma unroll
                for (int mt = 0; mt < 4; ++mt) { const int dr = 16 * mt + q;
                    const bf16x8 vf = *(const LAS bf16x8*)(VR + slot * 8192 + dr * 128 + ((((w0 >> 3) + g) ^ (dr & 7)) << 4));
                    o[mt] = __builtin_amdgcn_mfma_f32_16x16x32_bf16(vf, pb.v, o[mt], 0, 0, 0); }
            }
            sum += __shfl_xor(sum, 16); sum += __shfl_xor(sum, 32);
            const float m = fmaxf(mx, mc), fa = __expf(mx - m), fb = __expf(mc - m);
            const float rinv = 1.f / (sum * fa + lc * fb);
            const unsigned ow[8] = {oc0.x, oc0.y, oc0.z, oc0.w, oc1.x, oc1.y, oc1.z, oc1.w};
#pragma unroll
            for (int mt = 0; mt < 4; ++mt) {
                const f32x4 ob = (f32x4){__uint_as_float(ow[2 * mt] << 16), __uint_as_float(ow[2 * mt] & 0xffff0000u), __uint_as_float(ow[2 * mt + 1] << 16), __uint_as_float(ow[2 * mt + 1] & 0xffff0000u)};
                const f32x4 oc = (o[mt] * fa + ob * fb) * rinv;
                uint2 w; w.x = pk_bf16(oc[0], oc[1]); w.y = pk_bf16(oc[2], oc[3]);
                *(uint2*)(NAO + (size_t)tq * HN_PITCH + h * HD + 16 * mt + 4 * g) = w;
            }
        }
    }
    __syncthreads();
}

__device__ __forceinline__ void ph_natten(const bf16_t* ZN, const bf16_t* ZT, const bf16_t* KC, const bf16_t* VCT, const float* rpb, bf16_t* NAO, float* lds) {
    int tix_ = threadIdx.x; asm volatile("" : "+v"(tix_));
    const int wid = tix_ >> 6, lane = tix_ & 63;
    float* sc = lds + wid * 384;
    for (int gw = blockIdx.x * NWAVE + wid; gw < T * NH; gw += opq_gx() * NWAVE) {
        const int t = gw >> 3, h = gw & 7, b = t / SEQ, pos = t % SEQ, r = pos / GRID_W, c = pos % GRID_W;
        int rs = r - 4; rs = rs < 0 ? 0 : (rs > 120 ? 120 : rs);
        int cs = c - 8; cs = cs < 0 ? 0 : (cs > 48 ? 48 : cs);
        const float q = bf2f(ZN[(size_t)t * 3072 + h * HD + lane]);
        for (int i = 0; i < 8; ++i)
            for (int kc = cs; kc < cs + 16; ++kc) {
                const int tk = b * SEQ + (rs + i) * GRID_W + kc;
                const float kv = bf2f(ZN[(size_t)tk * 3072 + 512 + h * HD + lane]);
                float s = wave_sum(q * kv) * 0.125f;
                int dc = kc - c; dc = dc < -15 ? -15 : (dc > 15 ? 15 : dc);
                s += rpb[(h * 15 + (rs + i - r + 7)) * 31 + dc + 15];
                if (lane == 0) sc[i * 16 + (kc - cs)] = s;
            }
        for (int j = 0; j < CTX; ++j) {
            const float kv = bf2f(KC[(size_t)(b * CTX + j) * 512 + h * HD + lane]);
            const float s = wave_sum(q * kv) * 0.125f;
            if (lane == 0) sc[128 + j] = s;
        }
        __builtin_amdgcn_s_waitcnt(0);
        float mx = -INFINITY;
#pragma unroll
        for (int k = 0; k < 6; ++k) mx = fmaxf(mx, sc[lane + 64 * k]);
        mx = wave_max(mx);
        float pv[6], sum = 0.f;
#pragma unroll
        for (int k = 0; k < 6; ++k) { pv[k] = expf(sc[lane + 64 * k] - mx); sum += pv[k]; }
        sum = wave_sum(sum); const float rinv = 1.f / sum;
#pragma unroll
        for (int k = 0; k < 6; ++k) sc[lane + 64 * k] = pv[k] * rinv;
        __builtin_amdgcn_s_waitcnt(0);
        float o = 0.f;
        const bf16_t* vrow = ZT + (size_t)(1536 + h * HD + lane) * T;
        for (int i = 0; i < 8; ++i)
            for (int kk = 0; kk < 16; ++kk) { const int tk = b * SEQ + (rs + i) * GRID_W + cs + kk; o += sc[i * 16 + kk] * bf2f(vrow[tk]); }
        const bf16_t* vcrow = VCT + (size_t)(h * HD + lane) * 512 + b * CTX;
        for (int j = 0; j < CTX; ++j) o += sc[128 + j] * bf2f(vcrow[j]);
        NAO[(size_t)t * HN_PITCH + h * HD + lane] = f2bf(o);
        __builtin_amdgcn_s_waitcnt(0);
    }
}

__device__ __forceinline__ void ph_cvt_bf16(const float* src, bf16_t* dst, size_t n) {
    int tix_ = threadIdx.x; asm volatile("" : "+v"(tix_));
    const size_t stride = (size_t)gridDim.x * NTHR * 8;
    for (size_t i = ((size_t)blockIdx.x * NTHR + tix_) * 8; i < n; i += stride) {
        const f32x4 a = *(const f32x4*)(src + i), c = *(const f32x4*)(src + i + 4);
        uint4 w; w.x = pk_bf16(a[0], a[1]); w.y = pk_bf16(a[2], a[3]); w.z = pk_bf16(c[0], c[1]); w.w = pk_bf16(c[2], c[3]);
        *(uint4*)(dst + i) = w;
    }
}

constexpr int PROW = 768;
typedef float f32x2_t __attribute__((ext_vector_type(2)));
__device__ __forceinline__ void ph_cvt_fp8_rows(const float* src, unsigned char* dst, float* scales, int nrows, const float* mod = nullptr, float* SU = nullptr) {
    int tix_ = threadIdx.x; asm volatile("" : "+v"(tix_));
    const int wave = tix_ >> 6, lane = tix_ & 63;
    f32x4 sh0[4], sh1[4];
#pragma unroll
    for (int i = 0; i < 4; ++i) { sh0[i] = SU ? *(const f32x4*)(mod + 3 * 1024 + 16 * lane + 4 * i) : (f32x4){0.f, 0.f, 0.f, 0.f}; sh1[i] = SU ? *(const f32x4*)(mod + 6144 + 3 * 1024 + 16 * lane + 4 * i) : (f32x4){0.f, 0.f, 0.f, 0.f}; }
    int bx_ = blockIdx.x; asm volatile("" : "+s"(bx_));
    const int rstep = opq_gx() * NWAVE; int row = bx_ * NWAVE + wave; if (row >= nrows) return;
    f32x4 vn[4];
#pragma unroll
    for (int i = 0; i < 4; ++i) vn[i] = *(const f32x4*)(src + (size_t)row * DM + 16 * lane + 4 * i);
    for (; row < nrows; row += rstep) {
        f32x4 v[4]; float am = 0.f;
#pragma unroll
        for (int i = 0; i < 4; ++i) v[i] = vn[i];
        if (row + rstep < nrows) {
#pragma unroll
            for (int i = 0; i < 4; ++i) vn[i] = *(const f32x4*)(src + (size_t)(row + rstep) * DM + 16 * lane + 4 * i);
        }
#pragma unroll
        for (int i = 0; i < 4; ++i) { am = fmaxf(am, fmaxf(fmaxf(fabsf(v[i][0]), fabsf(v[i][1])), fmaxf(fabsf(v[i][2]), fabsf(v[i][3])))); }
        am = wave_max(am);
        const float inv = am > 0.f ? 7.5f / am : 1.f, sc = am > 0.f ? am * (1.f / 7.5f) : 1.f;
        {
            typedef float v16f_t __attribute__((ext_vector_type(16))); typedef unsigned v6u_t __attribute__((ext_vector_type(6))); typedef unsigned v3u_t __attribute__((ext_vector_type(3)));
            v16f_t xe, xo;
#pragma unroll
            for (int i = 0; i < 4; ++i) { xe[2 * i] = v[i][0] * inv; xo[2 * i] = v[i][1] * inv; xe[2 * i + 1] = v[i][2] * inv; xo[2 * i + 1] = v[i][3] * inv; }
#pragma unroll
            for (int i = 8; i < 16; ++i) { xe[i] = 0.f; xo[i] = 0.f; }
            const v6u_t w6 = __builtin_amdgcn_cvt_scalef32_2xpk16_fp6_f32(xe, xo, 1.0f);
            *(v3u_t*)(dst + (size_t)row * PROW + 12 * lane) = (v3u_t){w6[0], w6[1], w6[2]};
        }
        if (lane == 0) scales[row] = sc;
        if (SU) { float d0 = 0.f, d1 = 0.f;
#pragma unroll
            for (int i = 0; i < 4; ++i) { d0 += (v[i][0] * sh0[i][0] + v[i][1] * sh0[i][1]) + (v[i][2] * sh0[i][2] + v[i][3] * sh0[i][3]); d1 += (v[i][0] * sh1[i][0] + v[i][1] * sh1[i][1]) + (v[i][2] * sh1[i][2] + v[i][3] * sh1[i][3]); }
            d0 = wave_sum(d0); d1 = wave_sum(d1); if (lane == 0) { SU[row] = d0; SU[PNK * PNK + row] = d1; } }
    }
}

typedef __bf16 bf2_t __attribute__((ext_vector_type(2)));
template <int CTRL> __device__ __forceinline__ int dpp_i(int v) { return __builtin_amdgcn_update_dpp(0, v, CTRL, 0xF, 0xF, false); }
__device__ __forceinline__ int row_allmax_i(int v) { int o;
    o = dpp_i<0x121>(v); v = v > o ? v : o; o = dpp_i<0x122>(v); v = v > o ? v : o; o = dpp_i<0x124>(v); v = v > o ? v : o; o = dpp_i<0x128>(v); v = v > o ? v : o; return v; }
__device__ __forceinline__ float row_allsum_f(float v) {
    v += __int_as_float(dpp_i<0x121>(__float_as_int(v))); v += __int_as_float(dpp_i<0x122>(__float_as_int(v)));
    v += __int_as_float(dpp_i<0x124>(__float_as_int(v))); v += __int_as_float(dpp_i<0x128>(__float_as_int(v))); return v; }
__device__ __forceinline__ int f2key(float f) { const int i = __float_as_int(f); return i ^ ((i >> 31) & 0x7fffffff); }
__device__ __forceinline__ float key2f(int k) { return __int_as_float(k ^ ((k >> 31) & 0x7fffffff)); }
__device__ __forceinline__ float gelu_erf(float v) {
    const float av = fabsf(v), t = __builtin_amdgcn_rcpf(av * 0.2316418882f + 1.0f);
    float qq = t * 0.5307027145f + (-0.7265760135f); qq = qq * t + 0.7107068705f; qq = qq * t + (-0.142248368f); qq = qq * t + 0.127414796f; qq = qq * t;
    const float e = __builtin_amdgcn_exp2f((v * v) * (-0.72134752044f)), m = v * (qq * e);
    return v < 0.f ? m : v - m;
}
__device__ __forceinline__ float dot8(const uint4& a, const uint4& h, float acc) {
    acc = __builtin_amdgcn_fdot2_f32_bf16(__builtin_bit_cast(bf2_t, a.x), __builtin_bit_cast(bf2_t, h.x), acc, false);
    acc = __builtin_amdgcn_fdot2_f32_bf16(__builtin_bit_cast(bf2_t, a.y), __builtin_bit_cast(bf2_t, h.y), acc, false);
    acc = __builtin_amdgcn_fdot2_f32_bf16(__builtin_bit_cast(bf2_t, a.z), __builtin_bit_cast(bf2_t, h.z), acc, false);
    acc = __builtin_amdgcn_fdot2_f32_bf16(__builtin_bit_cast(bf2_t, a.w), __builtin_bit_cast(bf2_t, h.w), acc, false);
    return acc;
}
__device__ __forceinline__ void fma8(float (&o)[8], const uint4& v, float c) {
    o[0] += c * __uint_as_float(v.x << 16); o[1] += c * __uint_as_float(v.x & 0xffff0000u);
    o[2] += c * __uint_as_float(v.y << 16); o[3] += c * __uint_as_float(v.y & 0xffff0000u);
    o[4] += c * __uint_as_float(v.z << 16); o[5] += c * __uint_as_float(v.z & 0xffff0000u);
    o[6] += c * __uint_as_float(v.w << 16); o[7] += c * __uint_as_float(v.w & 0xffff0000u);
}
typedef unsigned v3u32_t __attribute__((ext_vector_type(3)));
typedef float f32x2_t __attribute__((ext_vector_type(2)));
template <int OFF> __device__ __forceinline__ v3u32_t ldrow_(__amdgpu_buffer_rsrc_t r, int voff, int soff) { return __builtin_amdgcn_raw_buffer_load_b96(r, voff + OFF, soff, 0); }
__device__ __forceinline__ void dec16(const v3u32_t& r, float (&f)[16]) { typedef unsigned v6u_t __attribute__((ext_vector_type(6))); typedef float v32f_t __attribute__((ext_vector_type(32)));
    const v32f_t d = __builtin_amdgcn_cvt_scalef32_pk32_f32_fp6((v6u_t){r[0], r[1], r[2], 0u, 0u, 0u}, 1.0f);
#pragma unroll
    for (int i = 0; i < 16; ++i) f[i] = d[i]; }
__device__ __forceinline__ void dec32(const v3u32_t& a, const v3u32_t& b, float (&f)[32]) { typedef unsigned v6u_t __attribute__((ext_vector_type(6))); typedef float v32f_t __attribute__((ext_vector_type(32)));
    const v32f_t d = __builtin_amdgcn_cvt_scalef32_pk32_f32_fp6((v6u_t){a[0], a[1], a[2], b[0], b[1], b[2]}, 1.0f);
#pragma unroll
    for (int i = 0; i < 32; ++i) f[i] = d[i]; }
#define ldrow(r, vo, so, OFF) ldrow_<OFF>(r, vo, so)
__device__ __forceinline__ void peer_A(const bf16_t* QP, const bf16_t* KEYB, const int t0, int* IDX, float* GW, const int hsel) {
    int tix_ = threadIdx.x; asm volatile("" : "+v"(tix_));
    const int lane = tix_ & 63, q = lane & 15, g = lane >> 4;
    {
        const int h = hsel; int qo = q, lo_ = lane; asm volatile("" : "+v"(qo), "+v"(lo_));
        int tk0[4], tk1[4];
#pragma unroll
        for (int p = 0; p < 2; ++p) {
            bf16x8 aq[4];
#pragma unroll
            for (int ks = 0; ks < 4; ++ks) aq[ks] = *(const bf16x8*)(QP + (size_t)(t0 + qo) * 2048 + h * 256 + p * 128 + ks * 32 + g * 8);
            f32x4 sc[8];
#pragma unroll
            for (int grp = 0; grp < 2; ++grp) {
                bf16x8 kb[4][4];
#pragma unroll
                for (int n4 = 0; n4 < 4; ++n4) {
                    const bf16_t* kp = KEYB + ((size_t)((h * 2 + p) * PNK + (grp * 4 + n4) * 16 + qo)) * PDH + g * 8;
#pragma unroll
                    for (int ks = 0; ks < 4; ++ks) kb[n4][ks] = *(const bf16x8*)(kp + ks * 32);
                }
                __builtin_amdgcn_sched_barrier(0);
#pragma unroll
                for (int n4 = 0; n4 < 4; ++n4) {
                    f32x4 acc = (f32x4){0.f, 0.f, 0.f, 0.f};
#pragma unroll
                    for (int ks = 0; ks < 4; ++ks) acc = __builtin_amdgcn_mfma_f32_16x16x32_bf16(aq[ks], kb[n4][ks], acc, 0, 0, 0);
                    sc[grp * 4 + n4] = acc;
                }
                __builtin_amdgcn_sched_barrier(0);
            }
            int key[4][8], mine[4];
#pragma unroll
            for (int e = 0; e < 4; ++e) { mine[e] = (int)0x80000000;
#pragma unroll
                for (int nt = 0; nt < 8; ++nt) key[e][nt] = (f2key(sc[nt][e]) & ~127) | (127 - (nt * 16 + qo));
#define CSWAP(i, j) { const int hi_ = key[e][i] > key[e][j] ? key[e][i] : key[e][j], lo_2 = key[e][i] > key[e][j] ? key[e][j] : key[e][i]; key[e][i] = hi_; key[e][j] = lo_2; }
                CSWAP(0, 1) CSWAP(2, 3) CSWAP(4, 5) CSWAP(6, 7) CSWAP(0, 2) CSWAP(1, 3) CSWAP(4, 6) CSWAP(5, 7) CSWAP(1, 2) CSWAP(5, 6)
                CSWAP(0, 4) CSWAP(1, 5) CSWAP(2, 6) CSWAP(3, 7) CSWAP(2, 4) CSWAP(3, 5) CSWAP(1, 2) CSWAP(3, 4) CSWAP(5, 6)
#undef CSWAP
            }
#pragma unroll 1
            for (int k = 0; k < PTOPK; ++k) {
                int m[4];
#pragma unroll
                for (int e = 0; e < 4; ++e) m[e] = key[e][0];
#pragma unroll
                for (int e = 0; e < 4; ++e) { const int o = dpp_i<0x121>(m[e]); m[e] = m[e] > o ? m[e] : o; }
#pragma unroll
                for (int e = 0; e < 4; ++e) { const int o = dpp_i<0x122>(m[e]); m[e] = m[e] > o ? m[e] : o; }
#pragma unroll
                for (int e = 0; e < 4; ++e) { const int o = dpp_i<0x124>(m[e]); m[e] = m[e] > o ? m[e] : o; }
#pragma unroll
                for (int e = 0; e < 4; ++e) { const int o = dpp_i<0x128>(m[e]); m[e] = m[e] > o ? m[e] : o; }
#pragma unroll
                for (int e = 0; e < 4; ++e) {
                    const bool win = key[e][0] == m[e];
#pragma unroll
                    for (int nt = 0; nt < 7; ++nt) key[e][nt] = win ? key[e][nt + 1] : key[e][nt];
                    key[e][7] = win ? (int)0x80000000 : key[e][7];
                    mine[e] = qo == k ? m[e] : mine[e];
                }
            }
#pragma unroll
            for (int e = 0; e < 4; ++e) { if (p == 0) tk0[e] = mine[e]; else tk1[e] = mine[e]; }
        }
        {
            float av[4], bself[4], bv[4]; int ptr[4], mine[4];
#pragma unroll
            for (int e = 0; e < 4; ++e) { av[e] = key2f(tk0[e] & ~127); bself[e] = key2f(tk1[e] & ~127); ptr[e] = 0; bv[e] = __shfl(bself[e], (lo_ & 48)); mine[e] = (int)0x80000000; }
#pragma unroll 1
            for (int k = 0; k < PTOPK; ++k) {
                int ck[4], m[4];
#pragma unroll
                for (int e = 0; e < 4; ++e) { ck[e] = ptr[e] < 16 ? ((f2key(av[e] + bv[e]) & ~255) | (255 - (qo * 16 + ptr[e]))) : (int)0x80000000; m[e] = ck[e]; }
#pragma unroll
                for (int e = 0; e < 4; ++e) { const int o = dpp_i<0x121>(m[e]); m[e] = m[e] > o ? m[e] : o; }
#pragma unroll
                for (int e = 0; e < 4; ++e) { const int o = dpp_i<0x122>(m[e]); m[e] = m[e] > o ? m[e] : o; }
#pragma unroll
                for (int e = 0; e < 4; ++e) { const int o = dpp_i<0x124>(m[e]); m[e] = m[e] > o ? m[e] : o; }
#pragma unroll
                for (int e = 0; e < 4; ++e) { const int o = dpp_i<0x128>(m[e]); m[e] = m[e] > o ? m[e] : o; }
#pragma unroll
                for (int e = 0; e < 4; ++e) { mine[e] = qo == k ? m[e] : mine[e]; if (ck[e] == m[e]) ++ptr[e]; }
#pragma unroll
                for (int e = 0; e < 4; ++e) bv[e] = __shfl(bself[e], (lo_ & 48) + (ptr[e] & 15));
            }
#pragma unroll
            for (int e = 0; e < 4; ++e) {
                const int code = 255 - (mine[e] & 255), wi = code >> 4, wj = code & 15;
                const int ka = __shfl(tk0[e], (lo_ & 48) + wi), kb = __shfl(tk1[e], (lo_ & 48) + wj);
                const int expert = (127 - (ka & 127)) * PNK + (127 - (kb & 127));
                const float bs = key2f(mine[e] & ~255);
                const float mxv = key2f(row_allmax_i(mine[e]) & ~255);
                const float ex = __expf(bs - mxv);
                const float gsm = ex / row_allsum_f(ex);
                IDX[(4 * g + e) * 128 + h * 16 + qo] = expert; GW[(4 * g + e) * 128 + h * 16 + qo] = gsm;
            }
        }
    }
}
typedef int v8i32_t __attribute__((ext_vector_type(8)));
typedef int i32x4_t __attribute__((ext_vector_type(4)));
typedef unsigned u32x2_t __attribute__((ext_vector_type(2)));
#define PEER_UPITCH 784
#define PEER_LDS_HL 32768
#define PEER_LDS_U 49152
struct PeerNext { float uscl, vsc, sue, gw; };
__device__ __forceinline__ void peer_issue(const unsigned char* UB, const __amdgpu_buffer_rsrc_t vsrd, const float* USC, const float* VSC, const float* subn, const int* ipn, const float* gwn,
                                           LAS unsigned char* UL, const int voffb, const int myj, v3u32_t (&ry)[16], PeerNext& nx) {
    int ex[16];
#pragma unroll
    for (int j = 0; j < 16; ++j) ex[j] = __builtin_amdgcn_readfirstlane(ipn[j]);
    const int mye = ipn[myj];
    nx.gw = gwn[myj];
    __builtin_amdgcn_sched_barrier(0);
    if (voffb < 48 * 12) {
        const int vo16 = (voffb / 12) * 16;
#pragma unroll
        for (int j = 0; j < 16; ++j) __builtin_amdgcn_global_load_lds((const unsigned*)(UB + (size_t)ex[j] * PROW + vo16), (LAS unsigned*)(UL + j * PEER_UPITCH), 16, 0, 0);
    }
#pragma unroll
    for (int j = 0; j < 16; ++j) ry[j] = ldrow(vsrd, voffb, ex[j] * PROW, 0);
    nx.uscl = USC[mye]; nx.vsc = VSC[mye]; nx.sue = subn[mye];
    __builtin_amdgcn_sched_barrier(0);
}
__device__ __forceinline__ float peer_udots(const LAS unsigned char* UL, const v8i32_t hbv, const int scb, const int cb, const int gb, const int myj) {
    asm volatile("s_waitcnt vmcnt(0)" ::: "memory");
    __builtin_amdgcn_sched_barrier(0);
    f32x4 acc[8];
    const LAS unsigned char* ua = UL + cb * PEER_UPITCH + 24 * gb;
#pragma unroll
    for (int s8 = 0; s8 < 8; ++s8) {
        const u32x2_t a0 = *(const LAS u32x2_t*)(ua + 96 * s8), a1 = *(const LAS u32x2_t*)(ua + 96 * s8 + 8), a2 = *(const LAS u32x2_t*)(ua + 96 * s8 + 16);
        const v8i32_t av = (v8i32_t){(int)a0.x, (int)a0.y, (int)a1.x, (int)a1.y, (int)a2.x, (int)a2.y, 0, 0};
        acc[s8] = __builtin_amdgcn_mfma_scale_f32_16x16x128_f8f6f4(av, hbv, (f32x4){0.f, 0.f, 0.f, 0.f}, 2, 0, 0, 0x7F7F7F7F, 0, scb);
    }
    float tsum[4];
    const int cs = cb & 7;
#pragma unroll
    for (int i = 0; i < 4; ++i) {
        const float s01 = (cs & 1) ? acc[1][i] : acc[0][i], s23 = (cs & 1) ? acc[3][i] : acc[2][i], s45 = (cs & 1) ? acc[5][i] : acc[4][i], s67 = (cs & 1) ? acc[7][i] : acc[6][i];
        const float s03 = (cs & 2) ? s23 : s01, s47 = (cs & 2) ? s67 : s45;
        tsum[i] = row_allsum_f((cs & 4) ? s47 : s03);
    }
    return (myj & 2) ? ((myj & 1) ? tsum[3] : tsum[2]) : ((myj & 1) ? tsum[1] : tsum[0]);
}
__device__ __forceinline__ void peer_vacc(const v3u32_t (&ry)[16], const float cf, float (&oo)[16]) {
#pragma unroll
    for (int j = 0; j < 16; j += 2) {
        const float c = __int_as_float(__builtin_amdgcn_readlane(__float_as_int(cf), 4 * j)), c2 = __int_as_float(__builtin_amdgcn_readlane(__float_as_int(cf), 4 * j + 4));
        float f[32]; dec32(ry[j], ry[j + 1], f);
#pragma unroll
        for (int k = 0; k < 16; ++k) { oo[k] = fmaf(c, f[k], oo[k]); oo[k] = fmaf(c2, f[16 + k], oo[k]); }
        asm volatile("" : "+v"(oo[0]), "+v"(oo[1]), "+v"(oo[2]), "+v"(oo[3]), "+v"(oo[4]), "+v"(oo[5]), "+v"(oo[6]), "+v"(oo[7]), "+v"(oo[8]), "+v"(oo[9]), "+v"(oo[10]), "+v"(oo[11]), "+v"(oo[12]), "+v"(oo[13]), "+v"(oo[14]), "+v"(oo[15]));
        __builtin_amdgcn_sched_barrier(0);
    }
}
__device__ __forceinline__ void peer_B(const bf16_t* H2, const unsigned char* UB, const unsigned char* VB, const float* USC, const float* VSC, const float* PSS, const float* SU, const float* mod, const bf16_t* X1B, float* out, const int t0, const int* IDX, const float* GW, LAS unsigned char* ldsl) {
    int tix_ = threadIdx.x; asm volatile("" : "+v"(tix_));
    const int wave = __builtin_amdgcn_readfirstlane(tix_ >> 6), lane = tix_ & 63;
    const __amdgpu_buffer_rsrc_t vsrd = __builtin_amdgcn_make_buffer_rsrc((void*)VB, 0, PNK * PNK * PROW, 0x00020000);
    LAS unsigned char* HL = ldsl + PEER_LDS_HL + wave * 2048;
    LAS unsigned char* UL = ldsl + PEER_LDS_U + wave * (16 * PEER_UPITCH);
    int lb_ = lane; asm volatile("" : "+v"(lb_)); const int voffb = lb_ * 12;
    const int cb = lb_ & 15, gb = lb_ >> 4, myj = (lb_ >> 2) & 15;
    v3u32_t ry0[16], ry1[16]; PeerNext n0, n1;
    peer_issue(UB, vsrd, USC, VSC, SU + (t0 + 4 * wave >= SEQ ? PNK * PNK : 0), IDX + 4 * wave * 128, GW + 4 * wave * 128, UL, voffb, myj, ry0, n0);
    f32x4 g2v[4];
    { const float* g2 = mod + (t0 >= SEQ ? 6144 : 0) + 5 * 1024;
#pragma unroll
      for (int v4 = 0; v4 < 4; ++v4) g2v[v4] = *(const f32x4*)(g2 + 16 * lb_ + 4 * v4); }
#pragma unroll 1
    for (int tk = 0; tk < 4; ++tk) {
        const int tl = 4 * wave + tk, t = t0 + tl;
        const float rstd = 1.f / sqrtf(row_allsum_f(PSS[(size_t)t * 16 + (lb_ & 15)]) * (1.f / DM) + EPS);
        v8i32_t hbv;
        { const uint4 ha = *(const uint4*)(H2 + (size_t)t * DM + 16 * lb_), hc = *(const uint4*)(H2 + (size_t)t * DM + 16 * lb_ + 8);
          const unsigned hw[8] = {ha.x, ha.y, ha.z, ha.w, hc.x, hc.y, hc.z, hc.w};
          int hi[4], lo[4];
#pragma unroll
          for (int q4 = 0; q4 < 4; ++q4) {
              float v[4];
              v[0] = __uint_as_float(hw[2 * q4] << 16); v[1] = __uint_as_float(hw[2 * q4] & 0xffff0000u); v[2] = __uint_as_float(hw[2 * q4 + 1] << 16); v[3] = __uint_as_float(hw[2 * q4 + 1] & 0xffff0000u);
#pragma unroll
              for (int i = 0; i < 4; ++i) v[i] = fminf(fmaxf(v[i], -448.f), 448.f);
              int w = 0;
              w = __builtin_amdgcn_cvt_pk_fp8_f32(v[0], v[1], w, false); w = __builtin_amdgcn_cvt_pk_fp8_f32(v[2], v[3], w, true);
              const f32x2_t r01 = __builtin_amdgcn_cvt_pk_f32_fp8(w, false), r23 = __builtin_amdgcn_cvt_pk_f32_fp8(w, true);
              int x = 0;
              x = __builtin_amdgcn_cvt_pk_fp8_f32((v[0] - r01[0]) * 16.f, (v[1] - r01[1]) * 16.f, x, false); x = __builtin_amdgcn_cvt_pk_fp8_f32((v[2] - r23[0]) * 16.f, (v[3] - r23[1]) * 16.f, x, true);
              hi[q4] = w; lo[q4] = x;
          }
          *(LAS i32x4_t*)(HL + 16 * lb_) = (i32x4_t){hi[0], hi[1], hi[2], hi[3]};
          *(LAS i32x4_t*)(HL + 1024 + 16 * lb_) = (i32x4_t){lo[0], lo[1], lo[2], lo[3]};
          __builtin_amdgcn_fence(__ATOMIC_RELEASE, "wavefront"); __builtin_amdgcn_wave_barrier(); __builtin_amdgcn_fence(__ATOMIC_ACQUIRE, "wavefront");
          const LAS unsigned char* src = HL + (cb & 8) * 128 + (cb & 7) * 128 + 16 * gb;
          const i32x4_t p0 = *(const LAS i32x4_t*)(src), p1 = *(const LAS i32x4_t*)(src + 64);
          hbv = (v8i32_t){p0.x, p0.y, p0.z, p0.w, p1.x, p1.y, p1.z, p1.w};
          __builtin_amdgcn_fence(__ATOMIC_RELEASE, "wavefront"); __builtin_amdgcn_wave_barrier();
        }
        const int scb = cb >= 8 ? 0x7B7B7B7B : 0x7F7F7F7F;
        float oo[16];
#pragma unroll
        for (int j = 0; j < 16; ++j) oo[j] = 0.f;
#pragma unroll 1
        for (int b2 = 0; b2 < 4; ++b2) {
            {
              const float d1 = peer_udots(UL, hbv, scb, cb, gb, myj);
              const int ni = tl * 128 + (2 * b2 + 1) * 16;
              peer_issue(UB, vsrd, USC, VSC, SU + (t >= SEQ ? PNK * PNK : 0), IDX + ni, GW + ni, UL, voffb, myj, ry1, n1);
              const float cf = n0.gw * gelu_erf(d1 * (n0.uscl * rstd) + n0.sue) * n0.vsc;
              peer_vacc(ry0, cf, oo); }
            {
              const float d1 = peer_udots(UL, hbv, scb, cb, gb, myj);
              if (!(tk == 3 && b2 == 3)) {
                  const int ni = tl * 128 + (2 * b2 + 2) * 16, tn = t0 + (ni >> 7);
                  peer_issue(UB, vsrd, USC, VSC, SU + (tn >= SEQ ? PNK * PNK : 0), IDX + ni, GW + ni, UL, voffb, myj, ry0, n0);
              }
              const float cf = n1.gw * gelu_erf(d1 * (n1.uscl * rstd) + n1.sue) * n1.vsc;
              peer_vacc(ry1, cf, oo); }
        }
        float* orow = out + (size_t)t * DM;
        const uint4 xa = *(const uint4*)(X1B + (size_t)t * DM + 16 * lb_), xb = *(const uint4*)(X1B + (size_t)t * DM + 16 * lb_ + 8);
        const unsigned xw[8] = {xa.x, xa.y, xa.z, xa.w, xb.x, xb.y, xb.z, xb.w};
#pragma unroll
        for (int v4 = 0; v4 < 4; ++v4) {
            const int c0 = 16 * lb_ + 4 * v4;
            const f32x4 gv = g2v[v4];
            const f32x4 xv = (f32x4){__uint_as_float(xw[2 * v4] << 16), __uint_as_float(xw[2 * v4] & 0xffff0000u), __uint_as_float(xw[2 * v4 + 1] << 16), __uint_as_float(xw[2 * v4 + 1] & 0xffff0000u)};
            f32x4 ov;
#pragma unroll
            for (int j = 0; j < 4; ++j) ov[j] = xv[j] + gv[j] * oo[4 * v4 + j];
            *(f32x4*)(orow + c0) = ov;
        }
    }
}
__device__ __forceinline__ void ph_peer2(const bf16_t* QP, const bf16_t* H2, const bf16_t* KEYB, const unsigned char* UB, const unsigned char* VB, const float* USC, const float* VSC, const float* PSS, const float* SU, const float* mod, const bf16_t* X1B, float* out, LAS unsigned char* ldsl) {
    const int nit = (T / 16 - (int)blockIdx.x + (int)gridDim.x - 1) / (int)gridDim.x;
    int* IDXb = (int*)(unsigned char*)ldsl;
    float* GWb = (float*)((unsigned char*)ldsl + 16384);
    int tix_ = threadIdx.x; asm volatile("" : "+v"(tix_));
    const int wave = __builtin_amdgcn_readfirstlane(tix_ >> 6);
    if (nit > 0) peer_A(QP, KEYB, (int)blockIdx.x * 16, IDXb, GWb, wave);
    __syncthreads();
#pragma unroll 1
    for (int s = 0; s < nit; ++s) {
        if (wave < 4) peer_B(H2, UB, VB, USC, VSC, PSS, SU, mod, X1B, out, ((int)blockIdx.x + s * (int)gridDim.x) * 16, IDXb + (s & 1) * 2048, GWb + (s & 1) * 2048, ldsl);
        else if (s + 1 < nit) {
#pragma unroll 1
            for (int hh = 0; hh < 2; ++hh) peer_A(QP, KEYB, ((int)blockIdx.x + (s + 1) * (int)gridDim.x) * 16, IDXb + ((s + 1) & 1) * 2048, GWb + ((s + 1) & 1) * 2048, (wave - 4) + 4 * hh);
        }
        __syncthreads();
    }
}

__device__ __forceinline__ void ph_peer(const bf16_t* QP, const bf16_t* H2, const float* keys, const float* pu, const float* pv, const float* mod, float* out, float* lds) {
    int tix_ = threadIdx.x; asm volatile("" : "+v"(tix_));
    float* qsa = lds;
    float* part = lds + 2048;
    const int h = tix_ >> 6, lane = tix_ & 63;
    float* qs = qsa + h * 256;
    for (int t = blockIdx.x; t < T; t += gridDim.x) {
        const int b = t / SEQ;
        for (int i = lane; i < 256; i += 64) qs[i] = bf2f(QP[(size_t)t * 2048 + h * 256 + i]);
        __builtin_amdgcn_s_waitcnt(0);
        float s00 = 0.f, s01 = 0.f, s10 = 0.f, s11 = 0.f;
        {
            const float* k00 = keys + ((size_t)(h * 2 + 0) * PNK + lane) * PDH; const float* k01 = k00 + 64 * PDH;
            const float* k10 = keys + ((size_t)(h * 2 + 1) * PNK + lane) * PDH; const float* k11 = k10 + 64 * PDH;
#pragma unroll 2
            for (int d4 = 0; d4 < 32; ++d4) {
                const f32x4 a = *(const f32x4*)(k00 + 4 * d4), bq = *(const f32x4*)(k01 + 4 * d4), cq = *(const f32x4*)(k10 + 4 * d4), dq = *(const f32x4*)(k11 + 4 * d4);
                const float q0 = qs[4 * d4], q1 = qs[4 * d4 + 1], q2 = qs[4 * d4 + 2], q3 = qs[4 * d4 + 3];
                const float r0 = qs[128 + 4 * d4], r1 = qs[128 + 4 * d4 + 1], r2 = qs[128 + 4 * d4 + 2], r3 = qs[128 + 4 * d4 + 3];
                s00 += a.x * q0 + a.y * q1 + a.z * q2 + a.w * q3; s01 += bq.x * q0 + bq.y * q1 + bq.z * q2 + bq.w * q3;
                s10 += cq.x * r0 + cq.y * r1 + cq.z * r2 + cq.w * r3; s11 += dq.x * r0 + dq.y * r1 + dq.z * r2 + dq.w * r3;
            }
        }
        float a0s = 0.f, a1s = 0.f; int a0i = 0, a1i = 0;
        for (int k = 0; k < PTOPK; ++k) {
            float v = s00 >= s01 ? s00 : s01; int idx = s00 >= s01 ? lane : lane + 64;
            wave_argmax(v, idx);
            if (lane == (idx & 63)) { if (idx < 64) s00 = -INFINITY; else s01 = -INFINITY; }
            if (lane == k) { a0s = v; a0i = idx; }
        }
        for (int k = 0; k < PTOPK; ++k) {
            float v = s10 >= s11 ? s10 : s11; int idx = s10 >= s11 ? lane : lane + 64;
            wave_argmax(v, idx);
            if (lane == (idx & 63)) { if (idx < 64) s10 = -INFINITY; else s11 = -INFINITY; }
            if (lane == k) { a1s = v; a1i = idx; }
        }
        float c0, c1, c2, c3;
        { const float ai = __shfl(a0s, lane >> 2); const int jb = (lane & 3) * 4;
          c0 = ai + __shfl(a1s, jb); c1 = ai + __shfl(a1s, jb + 1); c2 = ai + __shfl(a1s, jb + 2); c3 = ai + __shfl(a1s, jb + 3); }
        float bs = -INFINITY; int bc = 0;
        for (int k = 0; k < PTOPK; ++k) {
            float v = c0; int idx = lane * 4;
            if (c1 > v) { v = c1; idx = lane * 4 + 1; }
            if (c2 > v) { v = c2; idx = lane * 4 + 2; }
            if (c3 > v) { v = c3; idx = lane * 4 + 3; }
            wave_argmax(v, idx);
            if (lane == (idx >> 2)) { const int e = idx & 3; if (e == 0) c0 = -INFINITY; else if (e == 1) c1 = -INFINITY; else if (e == 2) c2 = -INFINITY; else c3 = -INFINITY; }
            if (lane == k) { bs = v; bc = idx; }
        }
        const int ei = __shfl(a0i, bc >> 4) * PNK + __shfl(a1i, bc & 15);
        const float mx = wave_max(bs);
        const float ex = lane < PTOPK ? expf(bs - mx) : 0.f;
        const float g = ex / wave_sum(ex);
        f32x4 hx[4], oacc[4];
#pragma unroll
        for (int j = 0; j < 4; ++j) { const ushort4 hv = *(const ushort4*)(H2 + (size_t)t * DM + 4 * lane + 256 * j); hx[j] = (f32x4){bf2f(hv.x), bf2f(hv.y), bf2f(hv.z), bf2f(hv.w)}; oacc[j] = (f32x4){0.f, 0.f, 0.f, 0.f}; }
#pragma unroll 1
        for (int k = 0; k < PTOPK; ++k) {
            const int e = __builtin_amdgcn_readfirstlane(__shfl(ei, k)); const float gk = __shfl(g, k);
            const f32x4* ur = (const f32x4*)(pu + (size_t)e * DM) + lane; const f32x4* vr = (const f32x4*)(pv + (size_t)e * DM) + lane;
            float dsum = 0.f;
#pragma unroll
            for (int j = 0; j < 4; ++j) { const f32x4 uv = ur[64 * j]; dsum += uv.x * hx[j].x + uv.y * hx[j].y + uv.z * hx[j].z + uv.w * hx[j].w; }
            dsum = wave_sum(dsum);
            const float act = 0.5f * dsum * (1.f + erff(dsum * 0.7071067811865476f));
            const float cf = gk * act;
#pragma unroll
            for (int j = 0; j < 4; ++j) { const f32x4 vv = vr[64 * j]; oacc[j] += vv * cf; }
        }
#pragma unroll
        for (int j = 0; j < 4; ++j) *(f32x4*)(&part[h * 1024 + 4 * lane + 256 * j]) = oacc[j];
        __syncthreads();
        for (int cc = tix_; cc < DM; cc += NTHR) {
            float s = 0.f;
#pragma unroll
            for (int w = 0; w < 8; ++w) s += part[w * 1024 + cc];
            out[(size_t)t * DM + cc] += mod[b * 6144 + 5 * 1024 + cc] * s;
        }
        __syncthreads();
    }
}


namespace pg8 {
__device__ __forceinline__ u32x4 pack8(const f32x4& a, const f32x4& b) { u32x4 w; w.x = cvt_pk_bf16(a[0], a[1]); w.y = cvt_pk_bf16(a[2], a[3]); w.z = cvt_pk_bf16(b[0], b[1]); w.w = cvt_pk_bf16(b[2], b[3]); return w; }
__device__ __forceinline__ float bflo(unsigned u) { return __builtin_bit_cast(float, u << 16); }
__device__ __forceinline__ float bfhi(unsigned u) { return __builtin_bit_cast(float, u & 0xffff0000u); }
__device__ __forceinline__ float sigm(float x) { return 1.f / (1.f + __expf(-x)); }
struct EpiZT {
    static constexpr bool PERM = true, AFTER_DRAIN = false, MID = false, FP8 = false;
    bf16_t* ZT; const float* b_in; bf16_t* VT;
    __device__ __forceinline__ void operator()(const f32x4 (&acc)[2][2][4][2], const Unit& u, int wr, int wc, int fr, int fq) const {
        const int row0 = u.pm * BM + wr * 64 + fr, col0 = u.pn * BM + wc * 32 + 8 * fq;
#pragma unroll
        for (int ai = 0; ai < 2; ++ai)
#pragma unroll
            for (int m = 0; m < 4; ++m) { const int r = row0 + ai * HALF + m * 16; const float bias = b_in[r < 1536 ? r : r + 1024]; bf16_t* rowp = (r < 1536 ? ZT + (size_t)r * T : VT + (size_t)(r - 1536) * VPITCH) + col0;
#pragma unroll
                for (int bj = 0; bj < 2; ++bj) { const f32x4 v0 = acc[ai][bj][m][0] + bias, v1 = acc[ai][bj][m][1] + bias; *(u32x4*)(rowp + bj * HALF) = pack8(v0, v1); } }
    }
};
struct EpiZT8 {
    static constexpr bool PERM = true, AFTER_DRAIN = false, MID = false, FP8 = true;
    bf16_t* ZT; const float* b_in; bf16_t* VT;
    __device__ __forceinline__ void operator()(const f32x4 (&acc)[2][2][4][2], const Unit& u, int wr, int wc, int fr, int fq) const {
        asm volatile("" : "+v"(fr), "+v"(fq));
        const int row0 = u.pm * BM + wr * 64 + fr, col0 = u.pn * BM + wc * 32 + 8 * fq;
#pragma unroll
        for (int ai = 0; ai < 2; ++ai)
#pragma unroll
            for (int m = 0; m < 4; ++m) { const int r = row0 + ai * HALF + m * 16; const float bias = b_in[r < 1536 ? r : r + 1024]; bf16_t* rowp = (r < 1536 ? ZT + (size_t)r * T : VT + (size_t)(r - 1536) * VPITCH) + col0;
#pragma unroll
                for (int bj = 0; bj < 2; ++bj) { const f32x4 v0 = acc[ai][bj][m][0] * (1.f / 64.f) + bias, v1 = acc[ai][bj][m][1] * (1.f / 64.f) + bias; *(u32x4*)(rowp + bj * HALF) = pack8(v0, v1); } }
    }
};
struct EpiZN {
    static constexpr bool PERM = true, AFTER_DRAIN = false, MID = false, FP8 = false;
    bf16_t* ZN; const float* b_in;
    __device__ __forceinline__ void operator()(const f32x4 (&acc)[2][2][4][2], const Unit& u, int wr, int wc, int fr, int fq) const {
        const int row0 = u.pm * BM + wr * 64 + fr, col0 = u.pn * BM + wc * 32 + 8 * fq; const bool gate = col0 >= 1024;
        const int lc0 = gate ? col0 + 2048 : col0 + 1536;
        f32x4 bv[2][2];
#pragma unroll
        for (int bj = 0; bj < 2; ++bj)
#pragma unroll
            for (int n = 0; n < 2; ++n) bv[bj][n] = *(const f32x4*)(b_in + lc0 + bj * HALF + 4 * n);
#pragma unroll
        for (int ai = 0; ai < 2; ++ai)
#pragma unroll
            for (int m = 0; m < 4; ++m) { bf16_t* rowp = ZN + (size_t)(row0 + ai * HALF + m * 16) * 3072 + col0;
#pragma unroll
                for (int bj = 0; bj < 2; ++bj) { f32x4 v0 = acc[ai][bj][m][0] + bv[bj][0], v1 = acc[ai][bj][m][1] + bv[bj][1];
                    if (gate) { v0 = (f32x4){sigm(v0[0]), sigm(v0[1]), sigm(v0[2]), sigm(v0[3])}; v1 = (f32x4){sigm(v1[0]), sigm(v1[1]), sigm(v1[2]), sigm(v1[3])}; }
                    *(u32x4*)(rowp + bj * HALF) = pack8(v0, v1); } }
    }
};

struct EpiQK {
    static constexpr bool PERM = false, AFTER_DRAIN = false, MID = false, FP8 = false;
    bf16_t* ZN; const float* b_in; const float* qg; const float* kg; const float* rope;
    __device__ __forceinline__ void operator()(const f32x4 (&acc)[2][2][4][2], const Unit& u, int wr, int wc, int fr, int fq) const {
        const float* gn = u.pn >= 2 ? kg : qg; const int lcol0 = u.pn * BM + 64 * wc;
        f32x4 bv[2][2], gv[2][2];
#pragma unroll
        for (int bj = 0; bj < 2; ++bj)
#pragma unroll
            for (int n = 0; n < 2; ++n) { bv[bj][n] = *(const f32x4*)(b_in + 1536 + lcol0 + 32 * bj + 16 * n + 4 * fq); gv[bj][n] = *(const f32x4*)(gn + 32 * bj + 16 * n + 4 * fq); }
#pragma unroll
        for (int ai = 0; ai < 2; ++ai) {
            f32x4 rt[4][2][2];
#pragma unroll
            for (int m = 0; m < 4; ++m) { const int pos = (u.pm * BM + ai * HALF + wr * 64 + m * 16 + fr) & (SEQ - 1);
#pragma unroll
                for (int bj = 0; bj < 2; ++bj) { const float* rp = rope + ((bj == 0 ? (pos >> 6) : (pos & 63)) * 16 + 4 * fq) * 2; rt[m][bj][0] = *(const f32x4*)rp; rt[m][bj][1] = *(const f32x4*)(rp + 4); } }
            __builtin_amdgcn_sched_barrier(0);
#pragma unroll
            for (int m = 0; m < 4; ++m) {
                const int r = u.pm * BM + ai * HALF + wr * 64 + m * 16 + fr;
                f32x4 v[2][2]; float ss = 0.f;
#pragma unroll
                for (int bj = 0; bj < 2; ++bj)
#pragma unroll
                    for (int n = 0; n < 2; ++n) { v[bj][n] = acc[ai][bj][m][n] + bv[bj][n]; ss += (v[bj][n][0] * v[bj][n][0] + v[bj][n][1] * v[bj][n][1]) + (v[bj][n][2] * v[bj][n][2] + v[bj][n][3] * v[bj][n][3]); }
                ss += __shfl_xor(ss, 16); ss += __shfl_xor(ss, 32);
                const float rstd = 1.f / sqrtf(ss * (1.f / 64.f) + EPS);
                bf16_t* rowp = ZN + (size_t)r * 3072 + lcol0 + 4 * fq;
#pragma unroll
                for (int bj = 0; bj < 2; ++bj) {
                    const f32x4 cs01 = rt[m][bj][0], cs23 = rt[m][bj][1];
                    const f32x4 a = v[bj][0] * rstd * gv[bj][0], bb = v[bj][1] * rstd * gv[bj][1];
                    const f32x4 cc = (f32x4){cs01[0], cs01[2], cs23[0], cs23[2]}, sn = (f32x4){cs01[1], cs01[3], cs23[1], cs23[3]};
                    const f32x4 ra = a * cc - bb * sn, rb = a * sn + bb * cc;
                    uint2 w0, w1; w0.x = cvt_pk_bf16(ra[0], ra[1]); w0.y = cvt_pk_bf16(ra[2], ra[3]); w1.x = cvt_pk_bf16(rb[0], rb[1]); w1.y = cvt_pk_bf16(rb[2], rb[3]);
                    *(uint2*)(rowp + 32 * bj) = w0; *(uint2*)(rowp + 32 * bj + 16) = w1;
                }
            }
            __builtin_amdgcn_sched_barrier(0);
        }
    }
};
struct EpiQK8 {
    static constexpr bool PERM = false, AFTER_DRAIN = false, MID = false, FP8 = true;
    bf16_t* ZN; const float* b_in; const float* qg; const float* kg; const float* rope;
    __device__ __forceinline__ void operator()(const f32x4 (&acc)[2][2][4][2], const Unit& u, int wr, int wc, int fr, int fq) const {
        asm volatile("" : "+v"(fr), "+v"(fq));
        const float* gn = u.pn >= 2 ? kg : qg; const int lcol0 = u.pn * BM + 64 * wc;
        f32x4 bv[2][2], gv[2][2];
#pragma unroll
        for (int bj = 0; bj < 2; ++bj)
#pragma unroll
            for (int n = 0; n < 2; ++n) { bv[bj][n] = *(const f32x4*)(b_in + 1536 + lcol0 + 32 * bj + 16 * n + 4 * fq); gv[bj][n] = *(const f32x4*)(gn + 32 * bj + 16 * n + 4 * fq); }
#pragma unroll
        for (int ai = 0; ai < 2; ++ai) {
            f32x4 rt[4][2][2];
#pragma unroll
            for (int m = 0; m < 4; ++m) { const int pos = (u.pm * BM + ai * HALF + wr * 64 + m * 16 + fr) & (SEQ - 1);
#pragma unroll
                for (int bj = 0; bj < 2; ++bj) { const float* rp = rope + ((bj == 0 ? (pos >> 6) : (pos & 63)) * 16 + 4 * fq) * 2; rt[m][bj][0] = *(const f32x4*)rp; rt[m][bj][1] = *(const f32x4*)(rp + 4); } }
            __builtin_amdgcn_sched_barrier(0);
#pragma unroll
            for (int m = 0; m < 4; ++m) {
                const int r = u.pm * BM + ai * HALF + wr * 64 + m * 16 + fr;
                f32x4 v[2][2]; float ss = 0.f;
#pragma unroll
                for (int bj = 0; bj < 2; ++bj)
#pragma unroll
                    for (int n = 0; n < 2; ++n) { v[bj][n] = acc[ai][bj][m][n] * (1.f / 64.f) + bv[bj][n]; ss += (v[bj][n][0] * v[bj][n][0] + v[bj][n][1] * v[bj][n][1]) + (v[bj][n][2] * v[bj][n][2] + v[bj][n][3] * v[bj][n][3]); }
                ss += __shfl_xor(ss, 16); ss += __shfl_xor(ss, 32);
                const float rstd = 1.f / sqrtf(ss * (1.f / 64.f) + EPS);
                bf16_t* rowp = ZN + (size_t)r * 3072 + lcol0 + 4 * fq;
#pragma unroll
                for (int bj = 0; bj < 2; ++bj) {
                    const f32x4 cs01 = rt[m][bj][0], cs23 = rt[m][bj][1];
                    const f32x4 a = v[bj][0] * rstd * gv[bj][0], bb = v[bj][1] * rstd * gv[bj][1];
                    const f32x4 cc = (f32x4){cs01[0], cs01[2], cs23[0], cs23[2]}, sn = (f32x4){cs01[1], cs01[3], cs23[1], cs23[3]};
                    const f32x4 ra = a * cc - bb * sn, rb = a * sn + bb * cc;
                    uint2 w0, w1; w0.x = cvt_pk_bf16(ra[0], ra[1]); w0.y = cvt_pk_bf16(ra[2], ra[3]); w1.x = cvt_pk_bf16(rb[0], rb[1]); w1.y = cvt_pk_bf16(rb[2], rb[3]);
                    *(uint2*)(rowp + 32 * bj) = w0; *(uint2*)(rowp + 32 * bj + 16) = w1;
                }
            }
            __builtin_amdgcn_sched_barrier(0);
        }
    }
};
struct EpiGate {
    static constexpr bool PERM = true, AFTER_DRAIN = false, MID = false, FP8 = false;
    bf16_t* ZN; const float* b_in;
    __device__ __forceinline__ void operator()(const f32x4 (&acc)[2][2][4][2], const Unit& u, int wr, int wc, int fr, int fq) const {
        const int row0 = u.pm * BM + wr * 64 + fr, col0 = u.pn * BM + wc * 32 + 8 * fq;
        f32x4 bv[2][2];
#pragma unroll
        for (int bj = 0; bj < 2; ++bj)
#pragma unroll
            for (int n = 0; n < 2; ++n) bv[bj][n] = *(const f32x4*)(b_in + 3072 + col0 + bj * HALF + 4 * n);
#pragma unroll
        for (int ai = 0; ai < 2; ++ai)
#pragma unroll
            for (int m = 0; m < 4; ++m) { bf16_t* rowp = ZN + (size_t)(row0 + ai * HALF + m * 16) * 3072 + 1024 + col0;
#pragma unroll
                for (int bj = 0; bj < 2; ++bj) { f32x4 v0 = acc[ai][bj][m][0] + bv[bj][0], v1 = acc[ai][bj][m][1] + bv[bj][1];
                    v0 = (f32x4){sigm(v0[0]), sigm(v0[1]), sigm(v0[2]), sigm(v0[3])}; v1 = (f32x4){sigm(v1[0]), sigm(v1[1]), sigm(v1[2]), sigm(v1[3])};
                    *(u32x4*)(rowp + bj * HALF) = pack8(v0, v1); } }
    }
};
struct EpiGate8 {
    static constexpr bool PERM = true, AFTER_DRAIN = false, MID = false, FP8 = true;
    bf16_t* ZN; const float* b_in;
    __device__ __forceinline__ void operator()(const f32x4 (&acc)[2][2][4][2], const Unit& u, int wr, int wc, int fr, int fq) const {
        asm volatile("" : "+v"(fr), "+v"(fq));
        const int row0 = u.pm * BM + wr * 64 + fr, col0 = u.pn * BM + wc * 32 + 8 * fq;
        f32x4 bv[2][2];
#pragma unroll
        for (int bj = 0; bj < 2; ++bj)
#pragma unroll
            for (int n = 0; n < 2; ++n) bv[bj][n] = *(const f32x4*)(b_in + 3072 + col0 + bj * HALF + 4 * n);
#pragma unroll
        for (int ai = 0; ai < 2; ++ai)
#pragma unroll
            for (int m = 0; m < 4; ++m) { bf16_t* rowp = ZN + (size_t)(row0 + ai * HALF + m * 16) * 3072 + 1024 + col0;
#pragma unroll
                for (int bj = 0; bj < 2; ++bj) { f32x4 v0 = acc[ai][bj][m][0] * (1.f / 64.f) + bv[bj][0], v1 = acc[ai][bj][m][1] * (1.f / 64.f) + bv[bj][1];
                    v0 = (f32x4){sigm(v0[0]), sigm(v0[1]), sigm(v0[2]), sigm(v0[3])}; v1 = (f32x4){sigm(v1[0]), sigm(v1[1]), sigm(v1[2]), sigm(v1[3])};
                    *(u32x4*)(rowp + bj * HALF) = pack8(v0, v1); } }
    }
};
struct EpiB16 {
    static constexpr bool PERM = true, AFTER_DRAIN = false, MID = false, FP8 = false;
    bf16_t* O; int ldc, pad;
    __device__ __forceinline__ void operator()(const f32x4 (&acc)[2][2][4][2], const Unit& u, int wr, int wc, int fr, int fq) const {
        const int row0 = u.pm * BM + wr * 64 + fr, col0 = u.pn * BM + wc * 32 + 8 * fq;
#pragma unroll
        for (int ai = 0; ai < 2; ++ai)
#pragma unroll
            for (int m = 0; m < 4; ++m) { bf16_t* rowp = O + (size_t)(row0 + ai * HALF + m * 16) * ldc + col0;
#pragma unroll
                for (int bj = 0; bj < 2; ++bj) *(u32x4*)(rowp + bj * HALF) = pack8(acc[ai][bj][m][0], acc[ai][bj][m][1]); }
    }
};
template <bool ADD> struct EpiMg {
    static constexpr bool PERM = true, AFTER_DRAIN = false, MID = false, FP8 = false;
    bf16_t* MG; const bf16_t* ZN; int goff, pad;
    __device__ __forceinline__ void operator()(const f32x4 (&acc)[2][2][4][2], const Unit& u, int wr, int wc, int fr, int fq) const {
        const int row0 = u.pm * BM + wr * 64 + fr, col0 = u.pn * BM + wc * 32 + 8 * fq;
#pragma unroll
        for (int ai = 0; ai < 2; ++ai) {
            u32x4 gt[4][2], og[4][2];
#pragma unroll
            for (int m = 0; m < 4; ++m)
#pragma unroll
                for (int bj = 0; bj < 2; ++bj) { const int r = row0 + ai * HALF + m * 16; gt[m][bj] = *(const u32x4*)(ZN + (size_t)r * 3072 + goff + col0 + bj * HALF);
                    if (ADD) og[m][bj] = *(const u32x4*)(MG + (size_t)r * DM + col0 + bj * HALF); }
            __builtin_amdgcn_sched_barrier(0);
#pragma unroll
            for (int m = 0; m < 4; ++m) { const int r = row0 + ai * HALF + m * 16; bf16_t* rowp = MG + (size_t)r * DM + col0;
#pragma unroll
                for (int bj = 0; bj < 2; ++bj) { const u32x4 g = gt[m][bj];
                    f32x4 v0 = acc[ai][bj][m][0] * (f32x4){bflo(g.x), bfhi(g.x), bflo(g.y), bfhi(g.y)}, v1 = acc[ai][bj][m][1] * (f32x4){bflo(g.z), bfhi(g.z), bflo(g.w), bfhi(g.w)};
                    if (ADD) { const u32x4 o = og[m][bj]; v0 += (f32x4){bflo(o.x), bfhi(o.x), bflo(o.y), bfhi(o.y)}; v1 += (f32x4){bflo(o.z), bfhi(o.z), bflo(o.w), bfhi(o.w)}; }
                    *(u32x4*)(rowp + bj * HALF) = pack8(v0, v1); } }
            __builtin_amdgcn_sched_barrier(0);
        }
    }
};
struct EpiMg2 {
    static constexpr bool PERM = true, AFTER_DRAIN = false, MID = true, FP8 = false;
    bf16_t* MG; const bf16_t* ZN;
    __device__ __forceinline__ void mid(f32x4 (&acc)[2][2][4][2], const Unit& u, int wr, int wc, int fr, int fq) const {
        int fr_ = fr, fq_ = fq; asm volatile("" : "+v"(fr_), "+v"(fq_));
        const int row0 = u.pm * BM + wr * 64 + fr_, col0 = u.pn * BM + wc * 32 + 8 * fq_;
#pragma unroll
        for (int ai = 0; ai < 2; ++ai)
#pragma unroll
            for (int mp = 0; mp < 2; ++mp) {
                u32x4 gh[2][2], gn[2][2];
#pragma unroll
                for (int mm = 0; mm < 2; ++mm)
#pragma unroll
                    for (int bj = 0; bj < 2; ++bj) { const int r = row0 + ai * HALF + (2 * mp + mm) * 16; const bf16_t* gp = ZN + (size_t)r * 3072 + col0 + bj * HALF;
                        gh[mm][bj] = *(const u32x4*)(gp + 1024); gn[mm][bj] = *(const u32x4*)(gp + 2048); }
                __builtin_amdgcn_sched_barrier(0);
#pragma unroll
                for (int mm = 0; mm < 2; ++mm)
#pragma unroll
                    for (int bj = 0; bj < 2; ++bj) { const u32x4 a = gh[mm][bj], b = gn[mm][bj]; const int m = 2 * mp + mm;
                        const f32x4 n0 = (f32x4){bflo(b.x), bfhi(b.x), bflo(b.y), bfhi(b.y)}, n1 = (f32x4){bflo(b.z), bfhi(b.z), bflo(b.w), bfhi(b.w)};
                        f32x4 r0, r1;
#pragma unroll
                        for (int e = 0; e < 4; ++e) { r0[e] = __builtin_amdgcn_rcpf(fmaxf(n0[e], 1e-30f)); r1[e] = __builtin_amdgcn_rcpf(fmaxf(n1[e], 1e-30f)); }
                        acc[ai][bj][m][0] = acc[ai][bj][m][0] * ((f32x4){bflo(a.x), bfhi(a.x), bflo(a.y), bfhi(a.y)} * r0);
                        acc[ai][bj][m][1] = acc[ai][bj][m][1] * ((f32x4){bflo(a.z), bfhi(a.z), bflo(a.w), bfhi(a.w)} * r1); }
                __builtin_amdgcn_sched_barrier(0);
            }
    }
    __device__ __forceinline__ void operator()(const f32x4 (&acc)[2][2][4][2], const Unit& u, int wr, int wc, int fr, int fq) const {
        const int row0 = u.pm * BM + wr * 64 + fr, col0 = u.pn * BM + wc * 32 + 8 * fq;
#pragma unroll
        for (int ai = 0; ai < 2; ++ai) {
            u32x4 gt[4][2];
#pragma unroll
            for (int m = 0; m < 4; ++m)
#pragma unroll
                for (int bj = 0; bj < 2; ++bj) { const int r = row0 + ai * HALF + m * 16; gt[m][bj] = *(const u32x4*)(ZN + (size_t)r * 3072 + 2048 + col0 + bj * HALF); }
            __builtin_amdgcn_sched_barrier(0);
#pragma unroll
            for (int m = 0; m < 4; ++m) { const int r = row0 + ai * HALF + m * 16; bf16_t* rowp = MG + (size_t)r * DM + col0;
#pragma unroll
                for (int bj = 0; bj < 2; ++bj) { const u32x4 g = gt[m][bj];
                    const f32x4 v0 = acc[ai][bj][m][0] * (f32x4){bflo(g.x), bfhi(g.x), bflo(g.y), bfhi(g.y)}, v1 = acc[ai][bj][m][1] * (f32x4){bflo(g.z), bfhi(g.z), bflo(g.w), bfhi(g.w)};
                    *(u32x4*)(rowp + bj * HALF) = pack8(v0, v1); } }
            __builtin_amdgcn_sched_barrier(0);
        }
    }
};
struct EpiOut {
    static constexpr bool PERM = true, AFTER_DRAIN = false, MID = false, FP8 = false;
    bf16_t* X1; const float* x; const float* mod; const float* n2g; bf16_t* XS; float* PSS;
    __device__ __forceinline__ void operator()(const f32x4 (&acc)[2][2][4][2], const Unit& u, int wr, int wc, int fr, int fq) const {
        const int row0 = u.pm * BM + wr * 64 + fr, col0 = u.pn * BM + wc * 32 + 8 * fq; const float* mb = mod + (u.pm * BM >= SEQ ? 6144 : 0);
        f32x4 gv[2][2], sv[2][2];
#pragma unroll
        for (int bj = 0; bj < 2; ++bj)
#pragma unroll
            for (int n = 0; n < 2; ++n) { const int c = col0 + bj * HALF + n * 4; gv[bj][n] = *(const f32x4*)(mb + 2 * 1024 + c); sv[bj][n] = *(const f32x4*)(n2g + c) * (*(const f32x4*)(mb + 4 * 1024 + c) + 1.f); }
#pragma unroll
        for (int ai = 0; ai < 2; ++ai)
#pragma unroll
            for (int mp = 0; mp < 2; ++mp) {
                f32x4 xr[2][2][2];
#pragma unroll
                for (int mm = 0; mm < 2; ++mm)
#pragma unroll
                    for (int bj = 0; bj < 2; ++bj)
#pragma unroll
                        for (int n = 0; n < 2; ++n) xr[mm][bj][n] = *(const f32x4*)(x + (size_t)(row0 + ai * HALF + (2 * mp + mm) * 16) * DM + col0 + bj * HALF + n * 4);
                __builtin_amdgcn_sched_barrier(0);
#pragma unroll
                for (int mm = 0; mm < 2; ++mm) { const int m = 2 * mp + mm; const int r = row0 + ai * HALF + m * 16; const size_t off = (size_t)r * DM + col0; float ss = 0.f;
#pragma unroll
                    for (int bj = 0; bj < 2; ++bj) {
                        const f32x4 xa = xr[mm][bj][0] + gv[bj][0] * acc[ai][bj][m][0], xb = xr[mm][bj][1] + gv[bj][1] * acc[ai][bj][m][1];
                        *(u32x4*)(X1 + off + bj * HALF) = pack8(xa, xb);
                        ss += ((xa[0] * xa[0] + xa[1] * xa[1]) + (xa[2] * xa[2] + xa[3] * xa[3])) + ((xb[0] * xb[0] + xb[1] * xb[1]) + (xb[2] * xb[2] + xb[3] * xb[3]));
                        *(u32x4*)(XS + off + bj * HALF) = pack8(xa * sv[bj][0], xb * sv[bj][1]); }
                    ss += __shfl_xor(ss, 16); ss += __shfl_xor(ss, 32);
                    if (fq == 0) PSS[(size_t)r * 16 + u.pn * 4 + wc] = ss; }
                __builtin_amdgcn_sched_barrier(0);
            }
    }
};
struct EpiQP {
    static constexpr bool PERM = true, AFTER_DRAIN = false, MID = false, FP8 = false;
    bf16_t* O; const float* PSS; const float* CQ;
    __device__ __forceinline__ void operator()(const f32x4 (&acc)[2][2][4][2], const Unit& u, int wr, int wc, int fr, int fq) const {
        const int row0 = u.pm * BM + wr * 64 + fr, col0 = u.pn * BM + wc * 32 + 8 * fq; const float* cq = CQ + (u.pm * BM >= SEQ ? 2048 : 0);
        f32x4 cv[2][2];
#pragma unroll
        for (int bj = 0; bj < 2; ++bj)
#pragma unroll
            for (int n = 0; n < 2; ++n) cv[bj][n] = *(const f32x4*)(cq + col0 + bj * HALF + 4 * n);
        f32x4 psv[2][4];
#pragma unroll
        for (int ai = 0; ai < 2; ++ai)
#pragma unroll
            for (int m = 0; m < 4; ++m) psv[ai][m] = *(const f32x4*)(PSS + (size_t)(row0 + ai * HALF + m * 16) * 16 + 4 * fq);
        __builtin_amdgcn_sched_barrier(0);
#pragma unroll
        for (int ai = 0; ai < 2; ++ai)
#pragma unroll
            for (int m = 0; m < 4; ++m) { const int r = row0 + ai * HALF + m * 16;
                const f32x4 ps = psv[ai][m]; float ss = (ps[0] + ps[1]) + (ps[2] + ps[3]);
                ss += __shfl_xor(ss, 16); ss += __shfl_xor(ss, 32);
                const float rstd = 1.f / sqrtf(ss * (1.f / DM) + EPS);
                bf16_t* rowp = O + (size_t)r * 2048 + col0;
#pragma unroll
                for (int bj = 0; bj < 2; ++bj) *(u32x4*)(rowp + bj * HALF) = pack8(acc[ai][bj][m][0] * rstd + cv[bj][0], acc[ai][bj][m][1] * rstd + cv[bj][1]); }
    }
};
}

#define XB_TMO      128
#define XB_XCNT(j)  (256  + 64 * (j))
#define XB_XSUB(j)  (1280 + 64 * (j))
#define XB_XGEN(j)  (2304 + 64 * (j))
#define XB_TOP      3328
#define XB_TOPGEN   3392
#define XCD_BAR_WORDS 3456
#define XB_SPIN_CAP (1u << 18)

__device__ __forceinline__ unsigned xb_ld(unsigned* p)              { return __hip_atomic_load(p, __ATOMIC_RELAXED, __HIP_MEMORY_SCOPE_AGENT); }
__device__ __forceinline__ unsigned xb_add(unsigned* p, unsigned v) { return __hip_atomic_fetch_add(p, v, __ATOMIC_RELAXED, __HIP_MEMORY_SCOPE_AGENT); }
__device__ __forceinline__ unsigned xb_xcc_id() { return (unsigned)__builtin_amdgcn_s_getreg((3 << 11) | 20) & 0xFu; }
#define XB_SPIN(cond, bar) do { unsigned _sp = 0; while (cond) { __builtin_amdgcn_s_sleep(1); \
    if ((++_sp & 255u) == 0u) { if (xb_ld(&(bar)[XB_TMO])) break; if (_sp > XB_SPIN_CAP) { atomicAdd(&(bar)[XB_TMO], 1u); break; } } } } while (0)

struct XcdBarrier {
    unsigned* bar; unsigned x;
    volatile LAS unsigned* st;
};

__device__ __forceinline__ XcdBarrier xcd_barrier_post(unsigned* bar, volatile LAS unsigned* st) {
    XcdBarrier b; b.bar = bar; b.x = xb_xcc_id(); b.st = st;
    if (threadIdx.x == 0) (void)xb_add(&bar[XB_XCNT(b.x)], 1u);
    return b;
}
__device__ __forceinline__ void xcd_barrier_complete(unsigned* bar, unsigned x, unsigned& nloc, unsigned& nx) {
    const unsigned G = gridDim.x * gridDim.y * gridDim.z;
    unsigned sum, cnt, mine, sp = 0u;
    for (;;) {
        sum = 0u; cnt = 0u; mine = 0u;
#pragma unroll
        for (unsigned j = 0; j < 16; ++j) { const unsigned c = xb_ld(&bar[XB_XCNT(j)]); sum += c; cnt += (c > 0u) ? 1u : 0u; mine = (j == x) ? c : mine; }
        if (sum == G) break;
        __builtin_amdgcn_s_sleep(1);
        if ((++sp & 255u) == 0u) { if (xb_ld(&bar[XB_TMO])) break; if (sp > XB_SPIN_CAP) { atomicAdd(&bar[XB_TMO], 1u); break; } }
    }
    nloc = mine > 0u ? mine : 1u; nx = cnt > 0u ? cnt : 1u;
}

__device__ __forceinline__ void xcd_barrier(const XcdBarrier& b) {
    asm volatile("s_waitcnt vmcnt(0)" ::: "memory");
    __syncthreads();
    if (threadIdx.x == 0) {
        unsigned* bar = b.bar;
        __builtin_amdgcn_s_waitcnt(0);
        unsigned nloc = b.st[0], nx = b.st[1];
        if (nloc == 0u) { xcd_barrier_complete(bar, b.x, nloc, nx); b.st[0] = nloc; b.st[1] = nx; }
        const unsigned old = xb_add(&bar[XB_XSUB(b.x)], 1u);
        const unsigned gen = old / nloc;
        if (old + 1u == (gen + 1u) * nloc) {
            __builtin_amdgcn_fence(__ATOMIC_RELEASE, "agent");
            asm volatile("s_waitcnt vmcnt(0)" ::: "memory");
            const unsigned og = xb_add(&bar[XB_TOP], 1u);
            const unsigned tg = og / nx;
            if (og + 1u == (tg + 1u) * nx) xb_add(&bar[XB_TOPGEN], 1u);
            else XB_SPIN(xb_ld(&bar[XB_TOPGEN]) == tg, bar);
            __builtin_amdgcn_fence(__ATOMIC_ACQUIRE, "agent");
            xb_add(&bar[XB_XGEN(b.x)], 1u);
            asm volatile("s_waitcnt vmcnt(0)" ::: "memory");
        } else {
            XB_SPIN(xb_ld(&bar[XB_XGEN(b.x)]) == gen, bar);
            __builtin_amdgcn_fence(__ATOMIC_ACQUIRE, "agent");
            asm volatile("s_waitcnt vmcnt(0)" ::: "memory");
        }
    }
    __syncthreads();
}


__global__ void __launch_bounds__(NTHR, 2) mega(P p) {
    extern __shared__ __attribute__((aligned(16))) unsigned char lds_raw[];
    float* lds = (float*)lds_raw;
    PG8_LAS unsigned char* PL = (PG8_LAS unsigned char*)lds_raw;
    cg::grid_group grid = cg::this_grid();
    { LAS unsigned* MISC = (LAS unsigned*)((LAS unsigned char*)lds_raw + LDS_BYTES - 64); if (threadIdx.x < 16) MISC[threadIdx.x] = 0u; }
    __syncthreads();
    const XcdBarrier xbar = xcd_barrier_post((unsigned*)(p.ws + WS_CTL), (volatile LAS unsigned*)((LAS unsigned char*)lds_raw + LDS_BYTES - 64));
    unsigned char* ws = p.ws;
    bf16_t* WIN_T = (bf16_t*)(ws + WS_WIN_T); bf16_t* WHY_T = (bf16_t*)(ws + WS_WHY_T); bf16_t* WNA_T = (bf16_t*)(ws + WS_WNA_T); bf16_t* WOUT_T = (bf16_t*)(ws + WS_WOUT_T); bf16_t* WQ_T = (bf16_t*)(ws + WS_WQ_T);
    float* MOD = (float*)(ws + WS_MOD); bf16_t* HCTX = (bf16_t*)(ws + WS_HCTX); bf16_t* KCTX = (bf16_t*)(ws + WS_KCTX); bf16_t* VCTXT = (bf16_t*)(ws + WS_VCTXT);
    float* H3 = (float*)(ws + WS_H3); bf16_t* XN = (bf16_t*)(ws + WS_XN); bf16_t* ZT = (bf16_t*)(ws + WS_ZT); bf16_t* ZN = (bf16_t*)(ws + WS_ZN);
    bf16_t* HYO = (bf16_t*)(ws + WS_HYO); bf16_t* NAO = HYO + 512;
    _Float16* FILT = (_Float16*)p.out; bf16_t* VT = (bf16_t*)((unsigned char*)p.out + 32 * MiB); bf16_t* MG = XN; bf16_t* H2 = ZT; bf16_t* QP = ZN;
    bf16_t* WKC_T = (bf16_t*)(ws + WS_CTL + MiB); float* ROPE = (float*)(ws + WS_MOD + 512 * 1024);
    bf16_t* X1B = (bf16_t*)(ws + WS_ZN + 64 * MiB);
    float* PSS = (float*)(ws + WS_HCTX); float* CQ = (float*)(ws + WS_MOD + 256 * 1024); float* SU = (float*)(ws + WS_KCTX);
    _Float16* H3h = (_Float16*)(ws + WS_H3); _Float16* F4T = (_Float16*)(ws + WS_H3 + MiB);
    bf16_t* KEYB = (bf16_t*)(ws + WS_H3); unsigned char* UB = ws + WS_ZT + 32 * MiB; unsigned char* VB = ws + WS_ZT + 48 * MiB; float* USC = (float*)(ws + WS_H3 + MiB); float* VSC = USC + PNK * PNK;

    ph_transpose(p.w_in, 1024, NPROJ, WIN_T, 1, lds, 0, 0, ws + WS_NAO);
    ph_transpose(p.w_hy_out, 512, 1024, WHY_T, 0, lds, 0, 1024);
    ph_transpose(p.w_na_out, 512, 1024, WHY_T + 512, 0, lds, 0, 1024);
    ph_transpose(p.w_out, 1024, 1024, WOUT_T, 0, lds);
    ph_transpose(p.peer_w_q, 1024, 2048, WQ_T, 0, lds);
    ph_transpose(p.w_in + 2048, 1024, 512, WKC_T, 0, lds, NPROJ);
    ph_rope_table(ROPE);
    __syncthreads();
    ph_adaln(p, MOD, lds);
    __syncthreads();
    ph_filter_mlp(p, H3h, lds);
    ph_f4t(p.f4w, F4T);
    if (p.ws == nullptr) grid.sync();
    xcd_barrier(xbar);
    ph_filter_gemm(F4T, H3h, FILT);
    ph_modulate(p.x, T, p.norm1_g, MOD, 0, SEQ, 0, XN, ws + WS_HYO);
    ph_modulate(p.ctx, 512, p.norm1_g, MOD, 0, 0, 2, HCTX);
    ph_cq(WQ_T, MOD, CQ);
    xcd_barrier(xbar);
    { pg8::Gemm g{(const bf16_t*)(ws + WS_NAO), (const bf16_t*)(ws + WS_HYO), 2048, T, 512}; pg8::StaticOrder S; S.init(2048, T, (int)gridDim.x, (int)blockIdx.x); pg8::EpiZT8 E{ZT, p.b_in, VT};
      pg8::gemm_phase<pg8::EpiZT8, pg8::StaticOrder, true, true>(PL, g, S, E); }
    { pg8::Gemm g{XN, WIN_T + (size_t)2048 * 1024, T, 1024, 1024}; pg8::StaticOrder S; S.init(T, 1024, (int)gridDim.x, (int)blockIdx.x); pg8::EpiQK E{ZN, p.b_in, p.q_norm_g, p.k_norm_g, ROPE};
      pg8::gemm_phase<pg8::EpiQK, pg8::StaticOrder, true, true>(PL, g, S, E); }
    { pg8::Gemm g{(const bf16_t*)(ws + WS_HYO), (const bf16_t*)(ws + WS_NAO + (size_t)3072 * 1024), T, 2048, 512};
      pg8::StaticOrder S; S.init(T, 2048, (int)gridDim.x, (int)blockIdx.x); pg8::EpiGate8 E{ZN, p.b_in};
      pg8::gemm_phase<pg8::EpiGate8, pg8::StaticOrder, true, true>(PL, g, S, E); }
    ph_gemm_ctx2(HCTX, WKC_T, WIN_T + (size_t)1536 * 1024, p.b_in, p.k_norm_g, KCTX, VCTXT, (LAS float*)lds_raw);
    xcd_barrier(xbar);
    ph_hyena_fft(ZT, FILT, p.hy_conv_w, p.hy_conv_b, p.hy_skip, HYO, (h2_t*)(ws + WS_XN) + (size_t)blockIdx.x * (2 * FN), (LAS fc2*)lds_raw);
    __syncthreads();
    if (gridDim.x == 256) ph_natten2(ZN, VT, KCTX, VCTXT, p.na_rpb, NAO, ws + WS_XN + (size_t)blockIdx.x * 131072, (LAS unsigned char*)lds_raw);
    else ph_natten_mfma(ZN, VT, KCTX, VCTXT, p.na_rpb, NAO);
    xcd_barrier(xbar);
    ph_hy_transpose(ZT, HYO, (LAS unsigned char*)lds_raw);
    xcd_barrier(xbar);
    { pg8::Gemm g{HYO, WHY_T, T, 1024, 1024}; pg8::StaticOrder S; S.init(T, 1024, (int)gridDim.x, (int)blockIdx.x); pg8::EpiMg2 E{MG, ZN};
      pg8::gemm_phase<pg8::EpiMg2, pg8::StaticOrder, true, true>(PL, g, S, E); }
    xcd_barrier(xbar);
    { pg8::Gemm g{MG, WOUT_T, T, 1024, 1024}; pg8::StaticOrder S; S.init(T, 1024, (int)gridDim.x, (int)blockIdx.x); pg8::EpiOut E{X1B, p.x, MOD, p.norm2_g, H2, PSS};
      pg8::gemm_phase<pg8::EpiOut, pg8::StaticOrder, true, true>(PL, g, S, E); }
    xcd_barrier(xbar);
    ph_cvt_bf16(p.peer_keys, KEYB, (size_t)PH * 2 * PNK * PDH);
    ph_cvt_fp8_rows(p.peer_u, UB, USC, PNK * PNK, MOD, SU);
    ph_cvt_fp8_rows(p.peer_v, VB, VSC, PNK * PNK);
    { pg8::Gemm g{H2, WQ_T, T, 2048, 1024}; pg8::StaticOrder S; S.init(T, 2048, (int)gridDim.x, (int)blockIdx.x); pg8::EpiQP E{QP, PSS, CQ};
      pg8::gemm_phase<pg8::EpiQP, pg8::StaticOrder, true, true>(PL, g, S, E); }
    xcd_barrier(xbar);
    ph_peer2(QP, H2, KEYB, UB, VB, USC, VSC, PSS, SU, MOD, X1B, p.out, (LAS unsigned char*)lds_raw);
}

extern "C" void kernel_launch(void* const* d_in, const int* in_sizes, int n_in, void* d_out, int out_size, void* d_ws, size_t ws_size, hipStream_t stream) {
    static int grid_blocks = 0;
    if (grid_blocks == 0) {
        if (n_in != 31 || ws_size < WS_END) { fprintf(stderr, "kernel_launch: unexpected inputs (n_in %d, ws %zu)\n", n_in, ws_size); grid_blocks = -1; return; }
        int dev = 0, cus = 0, per_cu = 0;
        (void)hipGetDevice(&dev);
        (void)hipDeviceGetAttribute(&cus, hipDeviceAttributeMultiprocessorCount, dev);
        (void)hipFuncSetAttribute((const void*)mega, hipFuncAttributeMaxDynamicSharedMemorySize, LDS_BYTES);
        (void)hipOccupancyMaxActiveBlocksPerMultiprocessor(&per_cu, (const void*)mega, NTHR, LDS_BYTES);
        if (per_cu < 1) { fprintf(stderr, "kernel_launch: occupancy query says %d blocks per CU\n", per_cu); per_cu = 1; }
        grid_blocks = cus * per_cu;
    }
    if (grid_blocks < 0) return;
    (void)hipMemsetAsync((unsigned char*)d_ws + WS_CTL, 0, 16384, stream);
    P p{};
    const float** pf = (const float**)&p;
    for (int i = 0; i < 31; ++i) pf[i] = (const float*)d_in[i];
    p.out = (float*)d_out; p.ws = (unsigned char*)d_ws;
    void* args[] = {&p};
    hipError_t e = hipLaunchCooperativeKernel((void*)mega, dim3(grid_blocks), dim3(NTHR), args, LDS_BYTES, stream);
    if (e != hipSuccess) fprintf(stderr, "cooperative launch failed: %s (grid %d)\n", hipGetErrorString(e), grid_blocks);
}
```

```cpp
#include <hip/hip_runtime.h>
#include <hip/hip_cooperative_groups.h>
namespace cg = cooperative_groups;
#include <cstdio>
#include <cstdint>
#include <cmath>

typedef unsigned short bf16_t;
typedef short bf16x8 __attribute__((ext_vector_type(8)));
typedef float f32x4 __attribute__((ext_vector_type(4)));

constexpr int DM = 1024, BATCH = 2, SEQ = 8192, T = BATCH * SEQ;
constexpr int GRID_W = 64, CTX = 256;
constexpr int D_HY = 512, HY_FFN = 64, HY_EMB = 33;
constexpr int NH = 8, HD = 64, D_NA = 512;
constexpr int NPROJ = 5120;
constexpr int PH = 8, PNK = 128, PTOPK = 16, PDK = 256, PDH = 128;
constexpr float EPS = 1e-6f;

constexpr size_t MiB = 1u << 20;
constexpr size_t WS_WIN_T = 0;
constexpr size_t WS_WHY_T = 10 * MiB;
constexpr size_t WS_WNA_T = 11 * MiB;
constexpr size_t WS_WOUT_T = 12 * MiB;
constexpr size_t WS_WQ_T = 14 * MiB;
constexpr size_t WS_MOD = 18 * MiB;
constexpr size_t WS_HCTX = 19 * MiB;
constexpr size_t WS_KCTX = 20 * MiB;
constexpr size_t WS_VCTXT = 21 * MiB;
constexpr size_t WS_H3 = 22 * MiB;
constexpr size_t WS_CTL = 24 * MiB;
constexpr size_t WS_XN = 26 * MiB;
constexpr size_t WS_ZT = 58 * MiB;
constexpr size_t WS_ZN = 122 * MiB;
constexpr size_t WS_HYO = 218 * MiB;
constexpr size_t WS_NAO = 234 * MiB;
constexpr size_t WS_END = 250 * MiB;

__device__ __forceinline__ bf16_t f2bf(float f) { unsigned u = __builtin_bit_cast(unsigned, f); return (bf16_t)((u + 0x7fffu + ((u >> 16) & 1u)) >> 16); }
__device__ __forceinline__ float bf2f(bf16_t h) { return __builtin_bit_cast(float, (unsigned)h << 16); }
__device__ __forceinline__ float wave_sum(float v) {
#pragma unroll
    for (int o = 32; o > 0; o >>= 1) v += __shfl_xor(v, o);
    return v;
}
__device__ __forceinline__ float wave_max(float v) {
#pragma unroll
    for (int o = 32; o > 0; o >>= 1) v = fmaxf(v, __shfl_xor(v, o));
    return v;
}
__device__ __forceinline__ void wave_argmax(float& v, int& idx) {
#pragma unroll
    for (int o = 32; o > 0; o >>= 1) { const float ov = __shfl_xor(v, o); const int oi = __shfl_xor(idx, o); if (ov > v || (ov == v && oi < idx)) { v = ov; idx = oi; } }
}

#define FH __device__ __forceinline__
#define FFT_LDS __attribute__((address_space(3)))
#define FFT_OPAQUE(x) asm volatile("" : "+v"(x))
#define FFT_SCHED() __builtin_amdgcn_sched_barrier(0)
#ifndef FH
#define FH __host__ __device__ __forceinline__
#endif
#ifndef FFT_LDS
#define FFT_LDS
#endif
#ifndef FFT_OPAQUE
#define FFT_OPAQUE(x)
#endif
#ifndef FFT_SCHED
#define FFT_SCHED()
#endif
typedef float fc2 __attribute__((ext_vector_type(2)));
constexpr int FN = 16384, FRS = 560, FLDS_ELEMS = 32 * FRS;
FH int fphys(int a, int b, int c) { return a * FRS + b * 17 + c; }
FH constexpr int fbrev(int k, int bits) { int r = 0; for (int i = 0; i < bits; ++i) r |= ((k >> i) & 1) << (bits - 1 - i); return r; }
FH constexpr float fcos32(int j) {
    return j == 0 ? 1.f : j == 1 ? 0.98078528040323043f : j == 2 ? 0.92387953251128674f : j == 3 ? 0.83146961230254524f : j == 4 ? 0.70710678118654757f
         : j == 5 ? 0.55557023301960229f : j == 6 ? 0.38268343236508984f : j == 7 ? 0.19509032201612833f : 0.f;
}
template <bool INV> FH void fmulw32(float& tr, float& ti, int idx) {
    if (idx == 0) return;
    if (idx == 8) { const float a = tr; if (INV) { tr = -ti; ti = a; } else { tr = ti; ti = -a; } return; }
    const float c = idx <= 8 ? fcos32(idx) : -fcos32(16 - idx), s0 = idx <= 8 ? fcos32(8 - idx) : fcos32(idx - 8);
    const float s = INV ? s0 : -s0;
    const float a = tr * c - ti * s, b = tr * s + ti * c; tr = a; ti = b;
}
template <int R, bool INV> FH void fdif(float (&re)[R], float (&im)[R]) {
#pragma unroll
    for (int span = R; span >= 2; span >>= 1) {
        const int half = span / 2;
#pragma unroll
        for (int b = 0; b < R; b += span)
#pragma unroll
            for (int j = 0; j < half; ++j) {
                const int i0 = b + j, i1 = i0 + half;
                float tr = re[i0] - re[i1], ti = im[i0] - im[i1];
                re[i0] += re[i1]; im[i0] += im[i1];
                fmulw32<INV>(tr, ti, j * (32 / span));
                re[i1] = tr; im[i1] = ti;
            }
    }
}
template <int R, bool INV> FH void fdit(float (&re)[R], float (&im)[R]) {
#pragma unroll
    for (int span = 2; span <= R; span <<= 1) {
        const int half = span / 2;
#pragma unroll
        for (int b = 0; b < R; b += span)
#pragma unroll
            for (int j = 0; j < half; ++j) {
                const int i0 = b + j, i1 = i0 + half;
                float tr = re[i1], ti = im[i1];
                fmulw32<INV>(tr, ti, j * (32 / span));
                re[i1] = re[i0] - tr; im[i1] = im[i0] - ti;
                re[i0] += tr; im[i0] += ti;
            }
    }
}
FH void fsincos_rev(float rev, float& s, float& c) {
#if defined(__HIP_DEVICE_COMPILE__)
    s = __builtin_amdgcn_sinf(rev); c = __builtin_amdgcn_cosf(rev);
#else
    s = sinf(6.283185307179586f * rev); c = cosf(6.283185307179586f * rev);
#endif
}
template <bool INV> FH void ftwid(float& r, float& i, int m, int den) {
    float s, c; fsincos_rev((float)(m & (den - 1)) / (float)den, s, c);
    if (!INV) s = -s;
    const float a = r * c - i * s, b = r * s + i * c; r = a; i = b;
}

FH void fpassF1(int tid, FFT_LDS fc2* L, float (&re)[32], float (&im)[32]) {
    FFT_OPAQUE(tid);
    const int n2 = tid >> 4, n3 = tid & 15;
    fdif<32, false>(re, im);
#pragma unroll
    for (int k1 = 0; k1 < 32; ++k1) { const int r = fbrev(k1, 5); float a = re[r], b = im[r]; if (k1) ftwid<false>(a, b, n2 * k1, 1024); L[fphys(k1, n2, n3)] = (fc2){a, b}; if ((k1 & 3) == 3) FFT_SCHED(); }
}
FH void fpassI1(int tid, const FFT_LDS fc2* L, float (&re)[32], float (&im)[32]) {
    FFT_OPAQUE(tid);
    const int n2 = tid >> 4, n3 = tid & 15;
#pragma unroll
    for (int k1 = 0; k1 < 32; ++k1) { const fc2 v = L[fphys(k1, n2, n3)]; const int r = fbrev(k1, 5); re[r] = v.x; im[r] = v.y; }
    fdit<32, true>(re, im);
}

FH void fpassF1z(int tid, FFT_LDS fc2* L, const float (&xr)[16], const float (&xi)[16]) {
    FFT_OPAQUE(tid);
    const int n2 = tid >> 4, n3 = tid & 15;
    {
        float re[16], im[16];
#pragma unroll
        for (int j = 0; j < 16; ++j) { re[j] = xr[j]; im[j] = xi[j]; }
        fdif<16, false>(re, im);
#pragma unroll
        for (int m = 0; m < 16; ++m) { const int r = fbrev(m, 4); float a = re[r], b = im[r]; if (m) ftwid<false>(a, b, n2 * 2 * m, 1024); L[fphys(2 * m, n2, n3)] = (fc2){a, b}; }
    }
    FFT_SCHED();
    {
        float re[16], im[16];
#pragma unroll
        for (int j = 0; j < 16; ++j) { re[j] = xr[j]; im[j] = xi[j]; fmulw32<false>(re[j], im[j], j); }
        fdif<16, false>(re, im);
#pragma unroll
        for (int m = 0; m < 16; ++m) { const int r = fbrev(m, 4); float a = re[r], b = im[r]; ftwid<false>(a, b, n2 * (2 * m + 1), 1024); L[fphys(2 * m + 1, n2, n3)] = (fc2){a, b}; }
    }
}
FH void fpassI1h(int tid, const FFT_LDS fc2* L, float (&outr)[16], float (&outi)[16]) {
    FFT_OPAQUE(tid);
    const int n2 = tid >> 4, n3 = tid & 15;
    {
        float re[16], im[16];
#pragma unroll
        for (int m = 0; m < 16; ++m) { const fc2 v = L[fphys(2 * m, n2, n3)]; const int r = fbrev(m, 4); re[r] = v.x; im[r] = v.y; }
        fdit<16, true>(re, im);
#pragma unroll
        for (int j = 0; j < 16; ++j) { outr[j] = re[j]; outi[j] = im[j]; }
    }
    FFT_SCHED();
    {
        float re[16], im[16];
#pragma unroll
        for (int m = 0; m < 16; ++m) { const fc2 v = L[fphys(2 * m + 1, n2, n3)]; const int r = fbrev(m, 4); re[r] = v.x; im[r] = v.y; }
        fdit<16, true>(re, im);
#pragma unroll
        for (int j = 0; j < 16; ++j) { fmulw32<true>(re[j], im[j], j); outr[j] += re[j]; outi[j] += im[j]; }
    }
}
FH void fpassF2(int tid, FFT_LDS fc2* L) {
    FFT_OPAQUE(tid);
    const int k1 = tid >> 4, n3 = tid & 15; float re[32], im[32];
#pragma unroll
    for (int n2 = 0; n2 < 32; ++n2) { const fc2 v = L[fphys(k1, n2, n3)]; re[n2] = v.x; im[n2] = v.y; }
    fdif<32, false>(re, im);
#pragma unroll
    for (int k2 = 0; k2 < 32; ++k2) { const int r = fbrev(k2, 5); float a = re[r], b = im[r]; ftwid<false>(a, b, n3 * (k1 + 32 * k2), FN); L[fphys(k1, k2, n3)] = (fc2){a, b}; if ((k2 & 3) == 3) FFT_SCHED(); }
}
FH void fpassI2(int tid, FFT_LDS fc2* L) {
    FFT_OPAQUE(tid);
    const int k1 = tid >> 4, n3 = tid & 15; float re[32], im[32];
#pragma unroll
    for (int k2 = 0; k2 < 32; ++k2) { const fc2 v = L[fphys(k1, k2, n3)]; const int r = fbrev(k2, 5); re[r] = v.x; im[r] = v.y; }
    fdit<32, true>(re, im);
#pragma unroll
    for (int n2 = 0; n2 < 32; ++n2) { float a = re[n2], b = im[n2]; if (n2) ftwid<true>(a, b, n2 * k1, 1024); L[fphys(k1, n2, n3)] = (fc2){a, b}; if ((n2 & 3) == 3) FFT_SCHED(); }
}
FH void fpassF3(int tid, FFT_LDS fc2* L) {
    FFT_OPAQUE(tid);
#pragma unroll 1
    for (int it = 0; it < 2; ++it) {
        const int k2 = tid & 31, k1 = (tid >> 5) + 16 * it; float re[16], im[16];
#pragma unroll
        for (int n3 = 0; n3 < 16; ++n3) { const fc2 v = L[fphys(k1, k2, n3)]; re[n3] = v.x; im[n3] = v.y; }
        fdif<16, false>(re, im);
#pragma unroll
        for (int k3 = 0; k3 < 16; ++k3) { const int r = fbrev(k3, 4); L[fphys(k1, k2, k3)] = (fc2){re[r], im[r]}; }
    }
}
template <class KT>
FH void fpassF3KI3(int tid, FFT_LDS fc2* L, const KT* KF) {
    FFT_OPAQUE(tid);
#pragma unroll 1
    for (int it = 0; it < 2; ++it) {
        const int k2 = tid & 31, k1 = (tid >> 5) + 16 * it; float re[16], im[16];
#pragma unroll
        for (int n3 = 0; n3 < 16; ++n3) { const fc2 v = L[fphys(k1, k2, n3)]; re[n3] = v.x; im[n3] = v.y; }
        fdif<16, false>(re, im);
        const KT* kp = KF + k1 * 512 + k2 * 16;
#pragma unroll
        for (int r = 0; r < 16; ++r) { const KT kv = kp[fbrev(r, 4)]; const float kr = (float)kv.x, ki = (float)kv.y; const float a = re[r] * kr - im[r] * ki, b = re[r] * ki + im[r] * kr; re[r] = a; im[r] = b; }
        fdit<16, true>(re, im);
#pragma unroll
        for (int n3 = 0; n3 < 16; ++n3) { float a = re[n3], b = im[n3]; if (n3) ftwid<true>(a, b, n3 * (k1 + 32 * k2), FN); L[fphys(k1, k2, n3)] = (fc2){a, b}; }
    }
}
template <class KT, class KE>
FH void funpack(int tid, const FFT_LDS fc2* L, KT* KF0, KT* KF1, float scale0, float scale1, float add0, float add1) {
    FFT_OPAQUE(tid);
#pragma unroll 1
    for (int i = 0; i < 32; ++i) {
        const int l = tid + 512 * i, k1 = i, k2 = tid >> 4, k3 = tid & 15;
        const int f = k1 + 32 * k2 + 1024 * k3, g = (FN - f) & (FN - 1);
        const fc2 p = L[fphys(k1, k2, k3)], q = L[fphys(g & 31, (g >> 5) & 31, g >> 10)];
        const float ar = 0.5f * (p.x + q.x), ai = 0.5f * (p.y - q.y);
        const float br = 0.5f * (p.y + q.y), bi = -0.5f * (p.x - q.x);
        KT o0, o1; o0.x = (KE)(ar * scale0 + add0); o0.y = (KE)(ai * scale0); o1.x = (KE)(br * scale1 + add1); o1.y = (KE)(bi * scale1);
        KF0[l] = o0; KF1[l] = o1;
    }
}
namespace pg8 {
#define PG8_LAS __attribute__((address_space(3)))
typedef unsigned short bf16_t;
typedef short bf16x8 __attribute__((ext_vector_type(8)));
typedef float f32x4 __attribute__((ext_vector_type(4)));
typedef unsigned u32x4 __attribute__((ext_vector_type(4)));
constexpr int BM = 256, BK = 64, HALF = 128, HTB = HALF * BK * 2  , STAGE_BYTES = 8 * HTB, NXCD = 8, WGM = 8;

__host__ __device__ __forceinline__ int lds_byte(int r, int c) { const int st = (r >> 4) * 2 + (c >> 5), rr = r & 15, cc = c & 31, ob = rr * 64 + cc * 2; return st * 1024 + (ob ^ (((ob >> 9) & 1) << 5)); }
__host__ __device__ __forceinline__ void stage_rc(int b, int& R, int& C) { const int st = b / 1024, sb = b % 1024, swz = sb ^ (((sb >> 9) & 1) << 5); R = (st >> 1) * 16 + swz / 64; C = (st & 1) * 32 + (swz % 64) / 2; }
__host__ __device__ __forceinline__ int perm32(int rho) { const int n = rho >> 4, i = rho & 15; return 8 * (i >> 2) + 4 * n + (i & 3); }

struct Unit { int pm, pn; };
struct Gemm { const bf16_t* A; const bf16_t* Bt; int M, N, K; int brows = 0x7fffffff; size_t bbatch = 0; };

struct StaticOrder {
    int nM, nN, nwg, G, c;
    __host__ __device__ void init(int M, int N, int G_, int c_) { nM = M / BM; nN = N / BM; nwg = nM * nN; G = G_; c = c_; }
    __host__ __device__ bool next(int i, Unit& u) const {
        const long L = (long)i * G + c; if (L >= nwg) return false;
        int wgid = (int)L; { const int q = nwg / NXCD, r = nwg % NXCD, xcd = wgid % NXCD, off = wgid / NXCD; wgid = (xcd < r ? xcd * (q + 1) : r * (q + 1) + (xcd - r) * q) + off; }
        const int nig = WGM * nN, gid = wgid / nig, fm = gid * WGM, gsz = (nM - fm) < WGM ? (nM - fm) : WGM;
        u.pm = fm + ((wgid % nig) % gsz); u.pn = (wgid % nig) / gsz; return true;
    }
    __device__ __forceinline__ void a_ready(const Unit&) const {}
    __device__ __forceinline__ void done(const Unit&) const {}
};
__device__ __forceinline__ unsigned cvt_pk_bf16(float lo, float hi) { unsigned r; asm volatile("v_cvt_pk_bf16_f32 %0, %1, %2" : "=v"(r) : "v"(lo), "v"(hi)); return r; }

template <class Epi, class Sched, bool ALIGN_EPI = false, bool SP2 = false>
__device__ __forceinline__ void gemm_phase(PG8_LAS unsigned char* lds, const Gemm g, const Sched& S, const Epi& E) {
    int tid_ = threadIdx.x; asm volatile("" : "+v"(tid_));
    const int tid = tid_, wid = __builtin_amdgcn_readfirstlane(tid >> 6), lane = tid & 63, wr = wid >> 2, wc = wid & 3, fr = lane & 15, fq = lane >> 4;
    const int K = g.K; int nt = K / BK; if constexpr (Epi::FP8) asm volatile("" : "+s"(nt));
    unsigned voffA[2], voffB[2];
#pragma unroll
    for (int i = 0; i < 2; ++i) { int R, C; stage_rc(tid * 16 + i * 8192, R, C); const int Rb = Epi::PERM ? ((R & ~31) + perm32(R & 31)) : R;
        voffA[i] = (unsigned)(R * K + C) * 2u; voffB[i] = (unsigned)(Rb * K + C) * 2u; }
    const size_t kstep = (size_t)(BK * 2);
    const size_t hstep = (size_t)HALF * K * 2;
    const size_t tstep = 2 * hstep;
    const unsigned ldsw = (unsigned)wid * 1024u;
    const int aoff = lds_byte(wr * 64 + fr, fq * 8), boff = lds_byte(wc * 32 + fr, fq * 8);
#define PG8_SA(b, h) (((b) * 2 + (h)) * HTB)
#define PG8_SB(b, h) ((4 + (b) * 2 + (h)) * HTB)
    const __amdgpu_buffer_rsrc_t rs_voffA = __builtin_amdgcn_make_buffer_rsrc((void*)g.A, 0, 0x7FFFFFFF, 0x00020000), rs_voffB = __builtin_amdgcn_make_buffer_rsrc((void*)g.Bt, 0, 0x7FFFFFFF, 0x00020000);
    const char* const base_voffA = (const char*)g.A; const char* const base_voffB = (const char*)g.Bt;
#define PG8_STAGE(bufoff, gbase, voff) do { if constexpr (Epi::FP8) { const int so_ = (int)((const char*)(gbase) - base_##voff); _Pragma("unroll") for (int _i = 0; _i < 2; ++_i) \
            __builtin_amdgcn_raw_ptr_buffer_load_lds(rs_##voff, (PG8_LAS void*)(lds + (bufoff) + ldsw + _i * 8192), 16, (int)(voff)[_i], so_, 0, 0); } \
        else { _Pragma("unroll") for (int _i = 0; _i < 2; ++_i) \
            __builtin_amdgcn_global_load_lds((const unsigned*)((const char*)(gbase) + (voff)[_i]), (PG8_LAS unsigned*)(lds + (bufoff) + ldsw + _i * 8192), 16, 0, 0); } } while (0)
#define PG8_LDA(dst, b, h) do { _Pragma("unroll") for (int m = 0; m < 4; ++m) _Pragma("unroll") for (int k = 0; k < 2; ++k) dst[m][k] = *(const PG8_LAS bf16x8*)(lds + PG8_SA(b, h) + aoff + m * 2048 + k * 1024); } while (0)
#define PG8_LDB(dst, b, h) do { _Pragma("unroll") for (int n = 0; n < 2; ++n) _Pragma("unroll") for (int k = 0; k < 2; ++k) dst[n][k] = *(const PG8_LAS bf16x8*)(lds + PG8_SB(b, h) + boff + n * 2048 + k * 1024); } while (0)
#define PG8_MMA(ai, bj, At, Bt) do { __builtin_amdgcn_s_setprio(1); \
        if constexpr (Epi::FP8) { typedef int pg8_v8i_t __attribute__((ext_vector_type(8))); typedef int pg8_v4i_t __attribute__((ext_vector_type(4))); \
            _Pragma("unroll") for (int m = 0; m < 4; ++m) _Pragma("unroll") for (int n = 0; n < 2; ++n) { \
                const pg8_v8i_t bq_ = __builtin_bit_cast(pg8_v8i_t, __builtin_shufflevector(Bt[n][0], Bt[n][1], 0, 1, 2, 3, 4, 5, 6, 7, 8, 9, 10, 11, 12, 13, 14, 15)), \
                                aq_ = __builtin_bit_cast(pg8_v8i_t, __builtin_shufflevector(At[m][0], At[m][1], 0, 1, 2, 3, 4, 5, 6, 7, 8, 9, 10, 11, 12, 13, 14, 15)); \
                acc[ai][bj][m][n] = __builtin_amdgcn_mfma_scale_f32_16x16x128_f8f6f4(bq_, aq_, acc[ai][bj][m][n], 0, 0, 0, 0, 0, 0); } } \
        else { _Pragma("unroll") for (int m = 0; m < 4; ++m) _Pragma("unroll") for (int n = 0; n < 2; ++n) _Pragma("unroll") for (int k = 0; k < 2; ++k) \
            acc[ai][bj][m][n] = __builtin_amdgcn_mfma_f32_16x16x32_bf16(Bt[n][k], At[m][k], acc[ai][bj][m][n], 0, 0, 0); } \
        __builtin_amdgcn_s_setprio(0); } while (0)
#define PG8_WAIT_V(n) asm volatile("s_waitcnt vmcnt(" #n ")" ::: "memory")
#define PG8_WAIT_L(n) asm volatile("s_waitcnt lgkmcnt(" #n ")" ::: "memory")
#define PG8_BAR __builtin_amdgcn_s_barrier()
#define PG8_SCHED __builtin_amdgcn_sched_barrier(0)
    Unit cur, nxt; int ui = 0;
    if (!S.next(0, cur)) return;
    f32x4 acc[2][2][4][2];
#pragma unroll
    for (int a = 0; a < 2; ++a)
#pragma unroll
        for (int b = 0; b < 2; ++b)
#pragma unroll
            for (int m = 0; m < 4; ++m)
#pragma unroll
                for (int n = 0; n < 2; ++n) acc[a][b][m][n] = (f32x4){0.f, 0.f, 0.f, 0.f};
    bf16x8 At[4][2], B0[2][2], B1[2][2];
    const char* cA = (const char*)g.A + (size_t)cur.pm * tstep; const char* cB = (const char*)g.Bt + (size_t)cur.pn * tstep + (cur.pm * BM >= g.brows ? g.bbatch : (size_t)0);
    S.a_ready(cur);
    if constexpr (SP2) {
        PG8_STAGE(PG8_SB(0, 0), cB, voffB); PG8_STAGE(PG8_SB(0, 1), cB + hstep, voffB); PG8_STAGE(PG8_SA(0, 0), cA, voffA); PG8_STAGE(PG8_SA(0, 1), cA + hstep, voffA);
        if (wr == 1) PG8_BAR;
        PG8_WAIT_V(2); PG8_BAR;
        PG8_STAGE(PG8_SB(1, 0), cB + kstep, voffB); PG8_STAGE(PG8_SA(1, 0), cA + kstep, voffA); PG8_STAGE(PG8_SB(1, 1), cB + hstep + kstep, voffB);
        PG8_WAIT_V(6); PG8_BAR;
    } else {
        PG8_STAGE(PG8_SB(0, 0), cB, voffB); PG8_STAGE(PG8_SA(0, 0), cA, voffA); PG8_STAGE(PG8_SB(0, 1), cB + hstep, voffB); PG8_STAGE(PG8_SA(0, 1), cA + hstep, voffA);
        if (wr == 1) PG8_BAR;
        PG8_WAIT_V(4); PG8_BAR;
        PG8_STAGE(PG8_SB(1, 0), cB + kstep, voffB); PG8_STAGE(PG8_SA(1, 0), cA + kstep, voffA); PG8_STAGE(PG8_SB(1, 1), cB + hstep + kstep, voffB);
        PG8_WAIT_V(6); PG8_BAR;
    }
    for (;;) {
        const bool has_next = S.next(ui + 1, nxt);
        const char* nA = has_next ? (const char*)g.A + (size_t)nxt.pm * tstep : cA; const char* nB = has_next ? (const char*)g.Bt + (size_t)nxt.pn * tstep + (nxt.pm * BM >= g.brows ? g.bbatch : (size_t)0) : cB;
        for (int t = 0; t < nt; t += 2) {
            const bool last = (t == nt - 2);
            const char* a1 = cA + (size_t)(t + 1) * kstep;
            const char* a2 = last ? nA : cA + (size_t)(t + 2) * kstep; const char* b2 = last ? nB : cB + (size_t)(t + 2) * kstep;
            const char* a3 = a2 + kstep; const char* b3 = b2 + kstep;
            if (last && has_next) S.a_ready(nxt);
            if constexpr (Epi::MID) { if (t == (nt >> 1)) E.mid(acc, cur, wr, wc, fr, fq); }
            if constexpr (SP2) {
            PG8_LDB(B0, 0, 0); PG8_LDB(B1, 0, 1); PG8_SCHED; PG8_LDA(At, 0, 0); PG8_STAGE(PG8_SA(1, 1), a1 + hstep, voffA);
            PG8_WAIT_V(8); PG8_WAIT_L(0); PG8_BAR; PG8_MMA(0, 0, At, B0); PG8_MMA(0, 1, At, B1); PG8_BAR; PG8_SCHED;
            PG8_LDA(At, 0, 1); PG8_STAGE(PG8_SB(0, 0), b2, voffB); PG8_STAGE(PG8_SB(0, 1), b2 + hstep, voffB); PG8_STAGE(PG8_SA(0, 0), a2, voffA);
            PG8_WAIT_V(8); PG8_WAIT_L(0); PG8_BAR; PG8_MMA(1, 0, At, B0); PG8_MMA(1, 1, At, B1); PG8_BAR; PG8_SCHED;
            PG8_LDB(B0, 1, 0); PG8_LDB(B1, 1, 1); PG8_SCHED; PG8_LDA(At, 1, 0); PG8_STAGE(PG8_SA(0, 1), a2 + hstep, voffA);
            PG8_WAIT_V(8); PG8_WAIT_L(0); PG8_BAR; PG8_MMA(0, 0, At, B0); PG8_MMA(0, 1, At, B1); PG8_BAR; PG8_SCHED;
            PG8_LDA(At, 1, 1); PG8_STAGE(PG8_SB(1, 0), b3, voffB); PG8_STAGE(PG8_SB(1, 1), b3 + hstep, voffB); PG8_STAGE(PG8_SA(1, 0), a3, voffA);
            PG8_WAIT_V(8); PG8_WAIT_L(0); PG8_BAR; PG8_MMA(1, 0, At, B0); PG8_MMA(1, 1, At, B1); PG8_BAR; PG8_SCHED;
            } else {
            PG8_LDB(B0, 0, 0); PG8_SCHED; PG8_LDA(At, 0, 0); PG8_STAGE(PG8_SA(1, 1), a1 + hstep, voffA);
            PG8_WAIT_L(8); PG8_BAR; PG8_WAIT_L(0); PG8_MMA(0, 0, At, B0); PG8_BAR; PG8_SCHED;
            PG8_LDB(B1, 0, 1); PG8_STAGE(PG8_SB(0, 0), b2, voffB);
            PG8_BAR; PG8_WAIT_L(0); PG8_MMA(0, 1, At, B1); PG8_BAR;
            PG8_LDA(At, 0, 1); PG8_STAGE(PG8_SA(0, 0), a2, voffA);
            PG8_BAR; PG8_WAIT_L(0); PG8_MMA(1, 0, At, B0); PG8_BAR; PG8_SCHED;
            PG8_STAGE(PG8_SB(0, 1), b2 + hstep, voffB);
            PG8_WAIT_V(6); PG8_BAR; PG8_MMA(1, 1, At, B1); PG8_BAR;
            PG8_LDB(B0, 1, 0); PG8_SCHED; PG8_LDA(At, 1, 0); PG8_STAGE(PG8_SA(0, 1), a2 + hstep, voffA);
            PG8_WAIT_L(8); PG8_BAR; PG8_WAIT_L(0); PG8_MMA(0, 0, At, B0); PG8_BAR; PG8_SCHED;
            PG8_LDB(B1, 1, 1); PG8_STAGE(PG8_SB(1, 0), b3, voffB);
            PG8_BAR; PG8_WAIT_L(0); PG8_MMA(0, 1, At, B1); PG8_BAR;
            PG8_LDA(At, 1, 1); PG8_STAGE(PG8_SA(1, 0), a3, voffA);
            PG8_BAR; PG8_WAIT_L(0); PG8_MMA(1, 0, At, B0); PG8_BAR; PG8_SCHED;
            PG8_STAGE(PG8_SB(1, 1), b3 + hstep, voffB);
            PG8_WAIT_V(6); PG8_BAR; PG8_MMA(1, 1, At, B1); PG8_BAR;
            }
        }
        if constexpr (ALIGN_EPI) { if (wr == 0) PG8_BAR; }
        if constexpr (!Epi::AFTER_DRAIN) { if constexpr (Epi::FP8) { unsigned z2_ = 0u; asm volatile("" : "+v"(z2_)); int t2_ = (int)__builtin_amdgcn_mbcnt_hi(~0u, __builtin_amdgcn_mbcnt_lo(~0u, z2_));
                E(acc, cur, wr, wc, t2_ & 15, (t2_ & 63) >> 4); } else E(acc, cur, wr, wc, fr, fq);
            S.done(cur); }
        if (!has_next) break;
#pragma unroll
        for (int a = 0; a < 2; ++a)
#pragma unroll
            for (int b = 0; b < 2; ++b)
#pragma unroll
                for (int m = 0; m < 4; ++m)
#pragma unroll
                    for (int n = 0; n < 2; ++n) acc[a][b][m][n] = (f32x4){0.f, 0.f, 0.f, 0.f};
        cur = nxt; cA = nA; cB = nB; ++ui;
        if constexpr (ALIGN_EPI) { if (wr == 1) PG8_BAR; }
    }
    PG8_WAIT_V(0);
    if constexpr (!ALIGN_EPI) { if (wr == 0) PG8_BAR; }
    PG8_BAR;
    if constexpr (Epi::AFTER_DRAIN) { E.fused(acc, cur, wr, wc, fr, fq, lds, wid, lane); S.done(cur); }
#undef PG8_SA
#undef PG8_SB
#undef PG8_STAGE
#undef PG8_LDA
#undef PG8_LDB
#undef PG8_MMA
#undef PG8_WAIT_V
#undef PG8_WAIT_L
#undef PG8_BAR
#undef PG8_SCHED
}
}

#define LAS __attribute__((address_space(3)))
constexpr int NTHR = 512, NWAVE = 8;
constexpr int VPITCH = T + 64;
constexpr int LDS_BYTES = 163840;

struct P {
    const float *x, *c, *ctx, *c_ctx, *norm1_g, *norm2_g, *w_ada, *b_ada, *w_in, *b_in, *hy_conv_w, *hy_conv_b;
    const float *f1w, *f1b, *f2w, *f2b, *f3w, *f3b, *f4w, *freq, *hy_skip, *q_norm_g, *k_norm_g, *na_rpb;
    const float *w_hy_out, *w_na_out, *w_out, *peer_w_q, *peer_keys, *peer_u, *peer_v;
    float* out; unsigned char* ws;
};

typedef float f32x2v_t __attribute__((ext_vector_type(2))); typedef __bf16 bf16x2v_t __attribute__((ext_vector_type(2)));
__device__ __forceinline__ int opq_gx() { int g = (int)gridDim.x; asm volatile("" : "+s"(g)); return g; }
__device__ __forceinline__ unsigned pk_bf16(float lo, float hi) { const f32x2v_t v = {lo, hi}; const bf16x2v_t r = __builtin_convertvector(v, bf16x2v_t); return __builtin_bit_cast(unsigned, r); }
__device__ __forceinline__ int win_logical(int p) { if (p < 1536) return p; if (p < 2048) return p + 1024; if (p >= 3072) { const int q = p - 3072, pn = q >> 8, j = q & 255; return 3072 + (j < 128 ? 128 * pn + j : 1024 + 128 * pn + (j - 128)); }     const int tb = p & ~255, P = p & 255; return tb - 512 + 64 * ((P >> 5) & 3) + 32 * (P >> 7) + (P & 31); }
__device__ __forceinline__ void ph_transpose(const float* W, int K, int N, bf16_t* WT, int mode, float* lds, int ld = 0, int ldo = 0, unsigned char* W8 = nullptr) {
    if (ld == 0) ld = N;
    if (ldo == 0) ldo = K;
    int tix_ = threadIdx.x; asm volatile("" : "+v"(tix_));
    const int wave = tix_ >> 6, lane = tix_ & 63;
    LAS float* scr = (LAS float*)lds + wave * (64 * 33);
    const int nblk = N / 32, nitems = nblk * (K / 64);
    for (int item = blockIdx.x * NWAVE + wave; item < nitems; item += opq_gx() * NWAVE) {
        const int kb = item / nblk, nb = item % nblk, k0 = 64 * kb, p0 = 32 * nb;
        const int l0 = mode ? win_logical(p0) : p0;
        f32x4 tv[8];
#pragma unroll
        for (int i = 0; i < 8; ++i) tv[i] = *(const f32x4*)(W + (size_t)(k0 + 8 * i + (lane >> 3)) * ld + l0 + 4 * (lane & 7));
        __builtin_amdgcn_sched_barrier(0);
#pragma unroll
        for (int i = 0; i < 8; ++i) { LAS float* d = scr + (8 * i + (lane >> 3)) * 33 + 4 * (lane & 7); d[0] = tv[i][0]; d[1] = tv[i][1]; d[2] = tv[i][2]; d[3] = tv[i][3]; }
        asm volatile("s_waitcnt lgkmcnt(0)" ::: "memory");
        const int c = lane & 7;
#pragma unroll
        for (int jj = 0; jj < 4; ++jj) { const int n = (lane >> 3) + 8 * jj; const LAS float* s = scr + (8 * c) * 33 + n;
            uint4 o; o.x = pk_bf16(s[0 * 33], s[1 * 33]); o.y = pk_bf16(s[2 * 33], s[3 * 33]); o.z = pk_bf16(s[4 * 33], s[5 * 33]); o.w = pk_bf16(s[6 * 33], s[7 * 33]);
            *(uint4*)(WT + (size_t)(p0 + n) * ldo + k0 + 8 * c) = o;
            if (W8) { int w0 = 0, w1 = 0;
                w0 = __builtin_amdgcn_cvt_pk_fp8_f32(s[0 * 33] * 64.f, s[1 * 33] * 64.f, w0, false); w0 = __builtin_amdgcn_cvt_pk_fp8_f32(s[2 * 33] * 64.f, s[3 * 33] * 64.f, w0, true);
                w1 = __builtin_amdgcn_cvt_pk_fp8_f32(s[4 * 33] * 64.f, s[5 * 33] * 64.f, w1, false); w1 = __builtin_amdgcn_cvt_pk_fp8_f32(s[6 * 33] * 64.f, s[7 * 33] * 64.f, w1, true);
                uint2 o8; o8.x = (unsigned)w0; o8.y = (unsigned)w1; *(uint2*)(W8 + (size_t)(p0 + n) * 1024 + k0 + 8 * c) = o8; } }
        asm volatile("s_waitcnt lgkmcnt(0)" ::: "memory");
    }
}

__device__ __forceinline__ void ph_rope_table(float* ROPE) {
    int tix_ = threadIdx.x; asm volatile("" : "+v"(tix_));
    for (int e = blockIdx.x * NTHR + tix_; e < 128 * 16; e += gridDim.x * NTHR) { const int pos = e >> 4, f = e & 15; const float ang = (float)pos * expf(-(float)f * 0.5756462732485114f); float sn, cs; sincosf(ang, &sn, &cs); ROPE[2 * e] = cs; ROPE[2 * e + 1] = sn; }
}

__device__ __forceinline__ void ph_scale_wq(const bf16_t* WQ_T, const float* mod, const float* n2g, bf16_t* WQS) {
    int tix_ = threadIdx.x; asm volatile("" : "+v"(tix_));
    for (int e = (int)blockIdx.x * NTHR + tix_; e < 2 * 2048 * 128; e += opq_gx() * NTHR) {
        const int b = e >> 18, n = (e >> 7) & 2047, k0 = (e & 127) * 8;
        const uint4 w = *(const uint4*)(WQ_T + (size_t)n * DM + k0);
        const float* mb = mod + (b ? 6144 : 0) + 4 * 1024 + k0;
        const f32x4 s0 = *(const f32x4*)(n2g + k0) * (*(const f32x4*)mb + 1.f), s1 = *(const f32x4*)(n2g + k0 + 4) * (*(const f32x4*)(mb + 4) + 1.f);
        uint4 o;
        o.x = pk_bf16(__uint_as_float(w.x << 16) * s0[0], __uint_as_float(w.x & 0xffff0000u) * s0[1]); o.y = pk_bf16(__uint_as_float(w.y << 16) * s0[2], __uint_as_float(w.y & 0xffff0000u) * s0[3]);
        o.z = pk_bf16(__uint_as_float(w.z << 16) * s1[0], __uint_as_float(w.z & 0xffff0000u) * s1[1]); o.w = pk_bf16(__uint_as_float(w.w << 16) * s1[2], __uint_as_float(w.w & 0xffff0000u) * s1[3]);
        *(uint4*)(WQS + (size_t)e * 8) = o;
    }
}

__device__ __forceinline__ void ph_cq(const bf16_t* WQ_T, const float* mod, float* CQ) {
    int tix_ = threadIdx.x; asm volatile("" : "+v"(tix_));
    const int wave = tix_ >> 6, lane = tix_ & 63;
    for (int n = blockIdx.x * NWAVE + wave; n < 2048; n += opq_gx() * NWAVE) {
        const uint4 w0 = *(const uint4*)(WQ_T + (size_t)n * DM + 16 * lane), w1 = *(const uint4*)(WQ_T + (size_t)n * DM + 16 * lane + 8);
        const unsigned ww[8] = {w0.x, w0.y, w0.z, w0.w, w1.x, w1.y, w1.z, w1.w};
        float a0 = 0.f, a1 = 0.f;
#pragma unroll
        for (int j = 0; j < 8; ++j) { const float lo = __uint_as_float(ww[j] << 16), hi = __uint_as_float(ww[j] & 0xffff0000u); const int k = 16 * lane + 2 * j;
            a0 += lo * mod[3 * 1024 + k] + hi * mod[3 * 1024 + k + 1]; a1 += lo * mod[6144 + 3 * 1024 + k] + hi * mod[6144 + 3 * 1024 + k + 1]; }
        a0 = wave_sum(a0); a1 = wave_sum(a1);
        if (lane == 0) { CQ[n] = a0; CQ[2048 + n] = a1; }
    }
}
__device__ __forceinline__ void ph_adaln(const P& p, float* mod, float* lds) {
    int tix_ = threadIdx.x; asm volatile("" : "+v"(tix_));
    float* sc = lds;
    float* part = lds + 3072;
    if (blockIdx.x >= 192) return;
    for (int i = tix_; i < 3 * 1024; i += NTHR) { const int v = i >> 10, k = i & 1023; const float x = v < 2 ? p.c[v * 1024 + k] : p.c_ctx[k]; sc[i] = x / (1.f + expf(-x)); }
    __syncthreads();
    for (int it = blockIdx.x; it < 192; it += gridDim.x) {
        const int c4 = tix_ & 7, kg = tix_ >> 3, j0 = it * 32 + 4 * c4;
        f32x4 w[16];
#pragma unroll
        for (int i = 0; i < 16; ++i) w[i] = *(const f32x4*)(p.w_ada + (size_t)(kg * 16 + i) * 6144 + j0);
        f32x4 a0 = (f32x4){0.f, 0.f, 0.f, 0.f}, a1 = a0, a2 = a0;
#pragma unroll
        for (int i = 0; i < 16; ++i) { const int k = kg * 16 + i; a0 += w[i] * sc[k]; a1 += w[i] * sc[1024 + k]; a2 += w[i] * sc[2048 + k]; }
        *(f32x4*)(part + (kg * 3 + 0) * 32 + 4 * c4) = a0; *(f32x4*)(part + (kg * 3 + 1) * 32 + 4 * c4) = a1; *(f32x4*)(part + (kg * 3 + 2) * 32 + 4 * c4) = a2;
        __syncthreads();
        if (tix_ < 96) { const int v = tix_ >> 5, jj = tix_ & 31; const int jo = it * 32 + jj; float s = p.b_ada[jo];
#pragma unroll 8
            for (int q = 0; q < 64; ++q) s += part[(q * 3 + v) * 32 + jj];
            mod[v * 6144 + jo] = s; }
        __syncthreads();
    }
}

__device__ __forceinline__ void ph_modulate(const float* x, int nrows, const float* g, const float* mod, int shift_chunk, int rows_per_vec, int vec0, bf16_t* out, unsigned char* out8 = nullptr) {
    int tix_ = threadIdx.x; asm volatile("" : "+v"(tix_));
    const int wave = tix_ >> 6, lane = tix_ & 63, step = opq_gx() * NWAVE;
    int bx_ = blockIdx.x; asm volatile("" : "+s"(bx_));
    int row = bx_ * NWAVE + wave; if (row >= nrows) return;
    f32x4 xn[4], gs[4], sv[4]; int cur_v = -1;
#pragma unroll
    for (int j = 0; j < 4; ++j) xn[j] = *(const f32x4*)(x + (size_t)row * DM + 8 * lane + 512 * (j >> 1) + 4 * (j & 1));
    for (; row < nrows; row += step) {
        f32x4 xv[4];
#pragma unroll
        for (int j = 0; j < 4; ++j) xv[j] = xn[j];
        if (row + step < nrows) {
#pragma unroll
            for (int j = 0; j < 4; ++j) xn[j] = *(const f32x4*)(x + (size_t)(row + step) * DM + 8 * lane + 512 * (j >> 1) + 4 * (j & 1));
        }
        const int v = vec0 + (rows_per_vec > 0 ? row / rows_per_vec : 0);
        if (v != cur_v) { cur_v = v; const float* sh = mod + v * 6144 + shift_chunk * 1024;
#pragma unroll
            for (int j = 0; j < 4; ++j) { const int c0 = 8 * lane + 512 * (j >> 1) + 4 * (j & 1); gs[j] = *(const f32x4*)(g + c0) * (*(const f32x4*)(sh + 1024 + c0) + 1.f); sv[j] = *(const f32x4*)(sh + c0); } }
        float s = 0.f;
#pragma unroll
        for (int j = 0; j < 4; ++j) s += (xv[j][0] * xv[j][0] + xv[j][1] * xv[j][1]) + (xv[j][2] * xv[j][2] + xv[j][3] * xv[j][3]);
        const float rstd = 1.f / sqrtf(wave_sum(s) * (1.f / DM) + EPS);
#pragma unroll
        for (int jj = 0; jj < 2; ++jj) { const f32x4 a = xv[2 * jj] * rstd * gs[2 * jj] + sv[2 * jj], c = xv[2 * jj + 1] * rstd * gs[2 * jj + 1] + sv[2 * jj + 1];
            uint4 o; o.x = pk_bf16(a[0], a[1]); o.y = pk_bf16(a[2], a[3]); o.z = pk_bf16(c[0], c[1]); o.w = pk_bf16(c[2], c[3]);
            if (out) *(uint4*)(out + (size_t)row * DM + 8 * lane + 512 * jj) = o;
            if (out8) { int w0 = 0, w1 = 0;
                w0 = __builtin_amdgcn_cvt_pk_fp8_f32(fminf(fmaxf(a[0], -448.f), 448.f), fminf(fmaxf(a[1], -448.f), 448.f), w0, false); w0 = __builtin_amdgcn_cvt_pk_fp8_f32(fminf(fmaxf(a[2], -448.f), 448.f), fminf(fmaxf(a[3], -448.f), 448.f), w0, true);
                w1 = __builtin_amdgcn_cvt_pk_fp8_f32(fminf(fmaxf(c[0], -448.f), 448.f), fminf(fmaxf(c[1], -448.f), 448.f), w1, false); w1 = __builtin_amdgcn_cvt_pk_fp8_f32(fminf(fmaxf(c[2], -448.f), 448.f), fminf(fmaxf(c[3], -448.f), 448.f), w1, true);
                uint2 o8; o8.x = (unsigned)w0; o8.y = (unsigned)w1; *(uint2*)(out8 + (size_t)row * DM + 8 * lane + 512 * jj) = o8; } }
    }
}

template <class Epi, bool DUAL>
__device__ __forceinline__ void ph_gemm(const bf16_t* A, const bf16_t* Bt, int M, int N, int K, const bf16_t* A2, const bf16_t* Bt2, int K2, const Epi& epi) {
    int tix_ = threadIdx.x; asm volatile("" : "+v"(tix_));
    const int wave = tix_ >> 6, lane = tix_ & 63, fr = lane & 15, fq = lane >> 4;
    const int ntn = N / 64, ntiles = (M / 64) * ntn;
    for (int wt = blockIdx.x * NWAVE + wave; wt < ntiles; wt += opq_gx() * NWAVE) {
        const int row0 = (wt / ntn) * 64, col0 = (wt % ntn) * 64;
        f32x4 acc[4][4], acc2[4][4];
#pragma unroll
        for (int m = 0; m < 4; ++m)
#pragma unroll
            for (int n = 0; n < 4; ++n) { acc[m][n] = (f32x4){0.f, 0.f, 0.f, 0.f}; acc2[m][n] = (f32x4){0.f, 0.f, 0.f, 0.f}; }
        for (int k0 = 0; k0 < K; k0 += 32) {
            bf16x8 a[4], b[4];
#pragma unroll
            for (int m = 0; m < 4; ++m) a[m] = *(const bf16x8*)(A + (size_t)(row0 + m * 16 + fr) * K + k0 + fq * 8);
#pragma unroll
            for (int n = 0; n < 4; ++n) b[n] = *(const bf16x8*)(Bt + (size_t)(col0 + n * 16 + fr) * K + k0 + fq * 8);
#pragma unroll
            for (int m = 0; m < 4; ++m)
#pragma unroll
                for (int n = 0; n < 4; ++n) acc[m][n] = __builtin_amdgcn_mfma_f32_16x16x32_bf16(a[m], b[n], acc[m][n], 0, 0, 0);
        }
        if (DUAL) {
            for (int k0 = 0; k0 < K2; k0 += 32) {
                bf16x8 a[4], b[4];
#pragma unroll
                for (int m = 0; m < 4; ++m) a[m] = *(const bf16x8*)(A2 + (size_t)(row0 + m * 16 + fr) * K2 + k0 + fq * 8);
#pragma unroll
                for (int n = 0; n < 4; ++n) b[n] = *(const bf16x8*)(Bt2 + (size_t)(col0 + n * 16 + fr) * K2 + k0 + fq * 8);
#pragma unroll
                for (int m = 0; m < 4; ++m)
#pragma unroll
                    for (int n = 0; n < 4; ++n) acc2[m][n] = __builtin_amdgcn_mfma_f32_16x16x32_bf16(a[m], b[n], acc2[m][n], 0, 0, 0);
            }
        }
#pragma unroll
        for (int m = 0; m < 4; ++m)
#pragma unroll
            for (int n = 0; n < 4; ++n)
#pragma unroll
                for (int j = 0; j < 4; ++j) epi(row0 + m * 16 + fq * 4 + j, col0 + n * 16 + fr, acc[m][n][j], acc2[m][n][j]);
    }
}

struct EpiZT {
    bf16_t* ZT; const float* b_in;
    __device__ __forceinline__ void operator()(int r, int c, float v, float) const { ZT[(size_t)r * T + c] = f2bf(v + b_in[r < 1536 ? r : r + 1024]); }
};
struct EpiZN {
    bf16_t* ZN; const float* b_in;
    __device__ __forceinline__ void operator()(int r, int c, float v, float) const {
        const int lc = c < 1024 ? c + 1536 : c + 2048; float o = v + b_in[lc];
        if (c >= 1024) o = 1.f / (1.f + expf(-o));
        ZN[(size_t)r * 3072 + c] = f2bf(o); }
};
struct EpiKctx {
    bf16_t* KC; const float* b_in;
    __device__ __forceinline__ void operator()(int r, int c, float v, float) const { KC[(size_t)r * 512 + c] = f2bf(v + b_in[2048 + c]); }
};
struct EpiVctxT {
    bf16_t* VT; const float* b_in;
    __device__ __forceinline__ void operator()(int r, int c, float v, float) const { VT[(size_t)r * 512 + c] = f2bf(v + b_in[2560 + r]); }
};
struct EpiMerged {
    bf16_t* MG; const bf16_t* ZN;
    __device__ __forceinline__ void operator()(int r, int c, float v, float v2) const {
        const float gh = bf2f(ZN[(size_t)r * 3072 + 1024 + c]), gn = bf2f(ZN[(size_t)r * 3072 + 2048 + c]);
        MG[(size_t)r * DM + c] = f2bf(gh * v + gn * v2); }
};
struct EpiOut {
    float* X1; const float* x; const float* mod;
    __device__ __forceinline__ void operator()(int r, int c, float v, float) const { const int b = r / SEQ; X1[(size_t)r * DM + c] = x[(size_t)r * DM + c] + mod[b * 6144 + 2 * 1024 + c] * v; }
};
struct EpiQP {
    bf16_t* QP;
    __device__ __forceinline__ void operator()(int r, int c, float v, float) const { QP[(size_t)r * 2048 + c] = f2bf(v); }
};


template <int MODE>
__device__ __forceinline__ void ph_gemm_ctx(const bf16_t* A, const bf16_t* Bt, const float* b_in, const float* kg, bf16_t* O, int wt0) {
    int tix_ = threadIdx.x; asm volatile("" : "+v"(tix_));
    const int wave = tix_ >> 6, lane = tix_ & 63, fr = lane & 15, fq = lane >> 4;
    for (int wt = blockIdx.x * NWAVE + wave - wt0; wt < 256; wt += opq_gx() * NWAVE) {
        if (wt < 0) continue;
        const int row0 = (wt >> 3) * 16, col0 = (wt & 7) * 64;
        f32x4 acc[4];
#pragma unroll
        for (int n = 0; n < 4; ++n) acc[n] = (f32x4){0.f, 0.f, 0.f, 0.f};
        const bf16_t* ap = A + (size_t)(row0 + fr) * 1024 + fq * 8; const bf16_t* bp = Bt + (size_t)(col0 + fr) * 1024 + fq * 8;
#pragma unroll 4
        for (int k0 = 0; k0 < 1024; k0 += 32) {
            const bf16x8 a = *(const bf16x8*)(ap + k0);
#pragma unroll
            for (int n = 0; n < 4; ++n) acc[n] = __builtin_amdgcn_mfma_f32_16x16x32_bf16(a, *(const bf16x8*)(bp + (size_t)n * 16 * 1024 + k0), acc[n], 0, 0, 0);
        }
#pragma unroll
        for (int j = 0; j < 4; ++j) {
            const int r = row0 + 4 * fq + j;
            if (MODE == 0) {
                float v[4]; float ss = 0.f;
#pragma unroll
                for (int n = 0; n < 4; ++n) { v[n] = acc[n][j] + b_in[2048 + col0 + 16 * n + fr]; ss += v[n] * v[n]; }
                ss += __shfl_xor(ss, 1); ss += __shfl_xor(ss, 2); ss += __shfl_xor(ss, 4); ss += __shfl_xor(ss, 8);
                const float rstd = 1.f / sqrtf(ss * (1.f / 64.f) + EPS);
#pragma unroll
                for (int n = 0; n < 4; ++n) O[(size_t)r * 512 + col0 + 16 * n + fr] = f2bf(v[n] * rstd * kg[16 * n + fr]);
            } else {
                const float bias = b_in[2560 + r];
#pragma unroll
                for (int n = 0; n < 4; ++n) O[(size_t)r * 512 + col0 + 16 * n + fr] = f2bf(acc[n][j] + bias);
            }
        }
    }
}
__device__ __forceinline__ void ph_gemm_ctx2(const bf16_t* HCTX, const bf16_t* WKC_T, const bf16_t* WV_T, const float* b_in, const float* kg, bf16_t* KC, bf16_t* VCT, LAS float* lds) {
    int tix_ = threadIdx.x; asm volatile("" : "+v"(tix_));
    const int wave = __builtin_amdgcn_readfirstlane(tix_ >> 6), lane = tix_ & 63, fr = lane & 15, fq = lane >> 4;
    for (int tt = blockIdx.x; tt < 512; tt += gridDim.x) {
        const int mode = tt >> 8, wt = tt & 255, row0 = (wt >> 3) * 16, col0 = (wt & 7) * 64;
        const bf16_t* A = mode == 0 ? HCTX : WV_T; const bf16_t* Bt = mode == 0 ? WKC_T : HCTX;
        const bf16_t* ap = A + (size_t)(row0 + fr) * 1024 + wave * 128 + fq * 8; const bf16_t* bp = Bt + (size_t)(col0 + fr) * 1024 + wave * 128 + fq * 8;
        bf16x8 a[4], bq[4][4];
#pragma unroll
        for (int ks = 0; ks < 4; ++ks) { a[ks] = *(const bf16x8*)(ap + ks * 32);
#pragma unroll
            for (int n = 0; n < 4; ++n) bq[n][ks] = *(const bf16x8*)(bp + (size_t)n * 16 * 1024 + ks * 32); }
        f32x4 acc[4];
#pragma unroll
        for (int n = 0; n < 4; ++n) { acc[n] = (f32x4){0.f, 0.f, 0.f, 0.f};
#pragma unroll
            for (int ks = 0; ks < 4; ++ks) acc[n] = __builtin_amdgcn_mfma_f32_16x16x32_bf16(a[ks], bq[n][ks], acc[n], 0, 0, 0); }
#pragma unroll
        for (int n = 0; n < 4; ++n) *(LAS f32x4*)(lds + (wave * 64 + lane) * 16 + 4 * n) = acc[n];
        __syncthreads();
        if (wave == 0) {
#pragma unroll
            for (int w = 1; w < 8; ++w)
#pragma unroll
                for (int n = 0; n < 4; ++n) acc[n] += *(const LAS f32x4*)(lds + (w * 64 + lane) * 16 + 4 * n);
#pragma unroll
            for (int j = 0; j < 4; ++j) {
                const int r = row0 + 4 * fq + j;
                if (mode == 0) {
                    float v[4]; float ss = 0.f;
#pragma unroll
                    for (int n = 0; n < 4; ++n) { v[n] = acc[n][j] + b_in[2048 + col0 + 16 * n + fr]; ss += v[n] * v[n]; }
                    ss += __shfl_xor(ss, 1); ss += __shfl_xor(ss, 2); ss += __shfl_xor(ss, 4); ss += __shfl_xor(ss, 8);
                    const float rstd = 1.f / sqrtf(ss * (1.f / 64.f) + EPS);
#pragma unroll
                    for (int n = 0; n < 4; ++n) KC[(size_t)r * 512 + col0 + 16 * n + fr] = f2bf(v[n] * rstd * kg[16 * n + fr]);
                } else {
                    const float bias = b_in[2560 + r];
#pragma unroll
                    for (int n = 0; n < 4; ++n) VCT[(size_t)r * 512 + col0 + 16 * n + fr] = f2bf(acc[n][j] + bias);
                }
            }
        }
        __syncthreads();
    }
}

__device__ __forceinline__ void ph_headnorm(bf16_t* buf, int ld, int col0, int nrows, const float* g, int rope) {
    int tix_ = threadIdx.x; asm volatile("" : "+v"(tix_));
    for (int gi = blockIdx.x * NTHR + tix_; gi < nrows * NH; gi += gridDim.x * NTHR) {
        const int row = gi / NH, h = gi % NH;
        bf16_t* p = buf + (size_t)row * ld + col0 + h * HD;
        float v[64]; float s = 0.f;
#pragma unroll
        for (int i = 0; i < 64; ++i) { v[i] = bf2f(p[i]); s += v[i] * v[i]; }
        const float rstd = 1.f / sqrtf(s * (1.f / 64.f) + EPS);
#pragma unroll
        for (int i = 0; i < 64; ++i) v[i] = v[i] * rstd * g[i];
        if (rope) {
            const int pos = row % SEQ; const float pr = (float)(pos / GRID_W), pc = (float)(pos % GRID_W);
#pragma unroll
            for (int i = 0; i < 16; ++i) {
                const float inv = expf(-(float)i * 0.5756462732485114f);
                float sn = __sinf(pr * inv), cs = __cosf(pr * inv);
                const float a = v[i], b = v[16 + i]; v[i] = a * cs - b * sn; v[16 + i] = a * sn + b * cs;
                sn = __sinf(pc * inv); cs = __cosf(pc * inv);
                const float a2 = v[32 + i], b2 = v[48 + i]; v[32 + i] = a2 * cs - b2 * sn; v[48 + i] = a2 * sn + b2 * cs;
            }
        }
#pragma unroll
        for (int i = 0; i < 64; ++i) p[i] = f2bf(v[i]);
    }
}

__device__ __forceinline__ void ph_filter_mlp(const P& p, _Float16* h3, float* lds) {
    int tix_ = threadIdx.x; asm volatile("" : "+v"(tix_));
    float* hA = lds; float* hB = lds + 64 * 65;
    float* W1 = lds + 2 * 64 * 65; float* W2 = W1 + HY_EMB * 64; float* W3 = W2 + 64 * 64;
    const int tl = tix_ & 63, part = __builtin_amdgcn_readfirstlane(tix_ >> 6);
    if ((int)gridDim.x - 1 - (int)blockIdx.x >= SEQ / 64) return;
    for (int i = tix_; i < HY_EMB * 64; i += NTHR) W1[i] = p.f1w[i];
    for (int i = tix_; i < 64 * 64; i += NTHR) { W2[i] = p.f2w[i]; W3[i] = p.f3w[i]; }
    for (int it = (int)gridDim.x - 1 - (int)blockIdx.x; it < SEQ / 64; it += gridDim.x) {
        const int t = it * 64 + tl;
        {
            const float tt = (float)t / (float)(SEQ - 1), w = (6.283185307179586f / (float)SEQ) * (float)t;
            if (part == 0) hA[0 * 65 + tl] = tt;
            for (int k = part * 2; k < part * 2 + 2; ++k) { const float band = 1e-4f + (float)k * ((15.f - 1e-4f) / 15.f); const float sn = __sinf(band * w), cs = __cosf(band * w); hA[(1 + k) * 65 + tl] = cs; hA[(17 + k) * 65 + tl] = -sn; }
        }
        __syncthreads();
        float acc[8];
#pragma unroll
        for (int o = 0; o < 8; ++o) acc[o] = p.f1b[part * 8 + o];
#pragma unroll 3
        for (int i = 0; i < HY_EMB; ++i) { const float x = hA[i * 65 + tl]; const f32x4 wa = *(const f32x4*)(W1 + i * 64 + part * 8), wb = *(const f32x4*)(W1 + i * 64 + part * 8 + 4);
#pragma unroll
            for (int o = 0; o < 4; ++o) { acc[o] += x * wa[o]; acc[4 + o] += x * wb[o]; } }
#pragma unroll
        for (int o = 0; o < 8; ++o) hB[(part * 8 + o) * 65 + tl] = __sinf(p.freq[part * 8 + o] * acc[o]);
        __syncthreads();
#pragma unroll
        for (int o = 0; o < 8; ++o) acc[o] = p.f2b[part * 8 + o];
#pragma unroll 8
        for (int i = 0; i < 64; ++i) { const float x = hB[i * 65 + tl]; const f32x4 wa = *(const f32x4*)(W2 + i * 64 + part * 8), wb = *(const f32x4*)(W2 + i * 64 + part * 8 + 4);
#pragma unroll
            for (int o = 0; o < 4; ++o) { acc[o] += x * wa[o]; acc[4 + o] += x * wb[o]; } }
#pragma unroll
        for (int o = 0; o < 8; ++o) hA[(part * 8 + o) * 65 + tl] = __sinf(p.freq[part * 8 + o] * acc[o]);
        __syncthreads();
#pragma unroll
        for (int o = 0; o < 8; ++o) acc[o] = p.f3b[part * 8 + o];
#pragma unroll 8
        for (int i = 0; i < 64; ++i) { const float x = hA[i * 65 + tl]; const f32x4 wa = *(const f32x4*)(W3 + i * 64 + part * 8), wb = *(const f32x4*)(W3 + i * 64 + part * 8 + 4);
#pragma unroll
            for (int o = 0; o < 4; ++o) { acc[o] += x * wa[o]; acc[4 + o] += x * wb[o]; } }
#pragma unroll
        for (int o = 0; o < 8; ++o) h3[(size_t)t * 64 + part * 8 + o] = (_Float16)__sinf(p.freq[part * 8 + o] * acc[o]);
        __syncthreads();
    }
}

typedef _Float16 f16x8 __attribute__((ext_vector_type(8)));
__device__ __forceinline__ void ph_f4t(const float* f4w, _Float16* F4T) {
    int tix_ = threadIdx.x; asm volatile("" : "+v"(tix_));
    for (int e = blockIdx.x * NTHR + tix_; e < 2048 * 64; e += gridDim.x * NTHR) { const int c = e >> 6, i = e & 63; F4T[e] = (_Float16)f4w[(size_t)i * 2048 + c]; }
}
__device__ __forceinline__ void ph_filter_gemm(const _Float16* F4T, const _Float16* h3, _Float16* FILT) {
    int tix_ = threadIdx.x; asm volatile("" : "+v"(tix_));
    const int wave = tix_ >> 6, lane = tix_ & 63, fr = lane & 15, fq = lane >> 4;
    for (int wt = blockIdx.x * NWAVE + wave; wt < 32 * 128; wt += opq_gx() * NWAVE) {
        const int c0 = (wt >> 7) * 64, t0 = (wt & 127) * 64;
        f16x8 a[4][2], bb[4][2];
#pragma unroll
        for (int m = 0; m < 4; ++m)
#pragma unroll
            for (int ks = 0; ks < 2; ++ks) { a[m][ks] = *(const f16x8*)(F4T + (size_t)(c0 + m * 16 + fr) * 64 + ks * 32 + fq * 8); bb[m][ks] = *(const f16x8*)(h3 + (size_t)(t0 + m * 16 + fr) * 64 + ks * 32 + fq * 8); }
#pragma unroll
        for (int m = 0; m < 4; ++m) {
            const float a0 = -4.605170185988091f / 1.5f, a1 = -4.605170185988091f / 0.3f;
#pragma unroll
            for (int n = 0; n < 4; ++n) {
                f32x4 acc = (f32x4){0.f, 0.f, 0.f, 0.f};
                acc = __builtin_amdgcn_mfma_f32_16x16x32_f16(bb[n][0], a[m][0], acc, 0, 0, 0);
                acc = __builtin_amdgcn_mfma_f32_16x16x32_f16(bb[n][1], a[m][1], acc, 0, 0, 0);
                const int c = c0 + m * 16 + fr, tq = t0 + n * 16 + fq * 4; const float delta = fabsf(a0 + (float)(c & 511) * ((a1 - a0) / 511.f));
                typedef _Float16 f16x4_t __attribute__((ext_vector_type(4)));
                f16x4_t o;
#pragma unroll
                for (int j = 0; j < 4; ++j) { const float tt = (float)(tq + j) / (float)(SEQ - 1); o[j] = (_Float16)(acc[j] * __expf(-tt * delta)); }
                *(f16x4_t*)(FILT + (size_t)c * SEQ + tq) = o;
            }
        }
    }
}

__device__ __forceinline__ void ph_filter_fin(const float* h3, const float* f4w, float* FILT, float* lds) {
    int tix_ = threadIdx.x; asm volatile("" : "+v"(tix_));
    float* w4 = lds;
    float* red = lds + 256;
    const int tid = tix_, lane = tid & 63, wid = tid >> 6;
    for (int d = blockIdx.x; d < D_HY; d += gridDim.x) {
        if (tid < 256) { const int i = tid >> 2, q = tid & 3; w4[i * 4 + q] = f4w[(size_t)i * 2048 + q * 512 + d]; }
        __syncthreads();
        const float a = -4.605170185988091f / 1.5f, bq = -4.605170185988091f / 0.3f;
        const float delta = fabsf(a + (float)d * ((bq - a) / 511.f));
        float s0 = 0.f, s1 = 0.f;
#pragma unroll 1
        for (int t = tid; t < SEQ; t += NTHR) {
            const f32x4* hr = (const f32x4*)(h3 + (size_t)t * 64);
            float v0 = 0.f, v1 = 0.f, v2 = 0.f, v3 = 0.f;
#pragma unroll 2
            for (int i4 = 0; i4 < 16; ++i4) { const f32x4 hv = hr[i4];
                const f32x4 wa = *(const f32x4*)(w4 + 16 * i4), wb = *(const f32x4*)(w4 + 16 * i4 + 4), wc = *(const f32x4*)(w4 + 16 * i4 + 8), wd = *(const f32x4*)(w4 + 16 * i4 + 12);
                v0 += hv.x * wa.x + hv.y * wb.x + hv.z * wc.x + hv.w * wd.x;
                v1 += hv.x * wa.y + hv.y * wb.y + hv.z * wc.y + hv.w * wd.y;
                v2 += hv.x * wa.z + hv.y * wb.z + hv.z * wc.z + hv.w * wd.z;
                v3 += hv.x * wa.w + hv.y * wb.w + hv.z * wc.w + hv.w * wd.w; }
            const float tt = (float)t / (float)(SEQ - 1), dec = expf(-tt * delta);
            v0 *= dec; v1 *= dec; v2 *= dec; v3 *= dec;
            s0 += fabsf(v0) + fabsf(v1); s1 += fabsf(v2) + fabsf(v3);
            FILT[((size_t)(0 * 512 + d) * 2 + 0) * SEQ + t] = v0; FILT[((size_t)(0 * 512 + d) * 2 + 1) * SEQ + t] = v1;
            FILT[((size_t)(1 * 512 + d) * 2 + 0) * SEQ + t] = v2; FILT[((size_t)(1 * 512 + d) * 2 + 1) * SEQ + t] = v3;
        }
        s0 = wave_sum(s0); s1 = wave_sum(s1);
        if (lane == 0) { red[wid] = s0; red[8 + wid] = s1; }
        __syncthreads();
        float t0 = 0.f, t1 = 0.f;
#pragma unroll
        for (int w = 0; w < 8; ++w) { t0 += red[w]; t1 += red[8 + w]; }
        const float r0 = 1.f / t0, r1 = 1.f / t1;
        for (int t = tid; t < SEQ; t += NTHR) {
            FILT[((size_t)(0 * 512 + d) * 2 + 0) * SEQ + t] *= r0; FILT[((size_t)(0 * 512 + d) * 2 + 1) * SEQ + t] *= r0;
            FILT[((size_t)(1 * 512 + d) * 2 + 0) * SEQ + t] *= r1; FILT[((size_t)(1 * 512 + d) * 2 + 1) * SEQ + t] *= r1;
        }
        __syncthreads();
    }
}

typedef _Float16 h2_t __attribute__((ext_vector_type(2)));
__device__ __forceinline__ float shortconv(const bf16_t* row, int t, float w0, float w1, float w2, float cb) {
    const float zm = t > 0 ? bf2f(row[t - 1]) : 0.f, z0 = bf2f(row[t]), zp = t < SEQ - 1 ? bf2f(row[t + 1]) : 0.f;
    return w0 * zm + w1 * z0 + w2 * zp + cb;
}
__device__ __forceinline__ void ph_hyena_fft(bf16_t* ZT, const _Float16* FILT, const float* cw, const float* cb, const float* skip, bf16_t* HYO, h2_t* KFS, LAS fc2* L) {
    int tix_ = threadIdx.x; asm volatile("" : "+v"(tix_));
    const int tid = tix_;
    h2_t* KF0 = KFS; h2_t* KF1 = KFS + FN;
    LAS float* FS = (LAS float*)(L + FLDS_ELEMS);
    for (int d = blockIdx.x; d < D_HY; d += gridDim.x) {
        {
            LAS _Float16* FL = (LAS _Float16*)L;
            int tq = tid; asm volatile("" : "+v"(tq));
            __syncthreads();
#pragma unroll
            for (int k = 0; k < 8; ++k) { const int ch = tq + 512 * k, s = ch >> 10, off = (ch & 1023) * 8;
                typedef unsigned u32x4v_t __attribute__((ext_vector_type(4)));
                const u32x4v_t v = *(const u32x4v_t*)(FILT + (size_t)(s * 512 + d) * SEQ + off);
                *(LAS u32x4v_t*)(FL + s * SEQ + off) = v; }
            __syncthreads();
            float re[32], im[32];
            float s0 = 0.f, s1 = 0.f;
#pragma unroll
            for (int n1 = 0; n1 < 16; ++n1) { re[n1] = (float)FL[0 * SEQ + tq + 512 * n1]; im[n1] = (float)FL[2 * SEQ + tq + 512 * n1]; s0 += fabsf(re[n1]); s1 += fabsf(im[n1]); }
#pragma unroll
            for (int n1 = 16; n1 < 32; ++n1) { const int m = tq + 512 * (n1 - 16); const float vb0 = (float)FL[1 * SEQ + (m == 0 ? 0 : SEQ - m)], vb1 = (float)FL[3 * SEQ + (m == 0 ? 0 : SEQ - m)]; s0 += fabsf(vb0); s1 += fabsf(vb1);
                re[n1] = m == 0 ? 0.f : vb0; im[n1] = m == 0 ? 0.f : vb1; }
            s0 = wave_sum(s0); s1 = wave_sum(s1);
            if ((tid & 63) == 0) { FS[(tid >> 6) * 2] = s0; FS[(tid >> 6) * 2 + 1] = s1; }
            __syncthreads();
            fpassF1(tid, L, re, im);
        }
        __syncthreads();
        float sc0 = 0.f, sc1 = 0.f;
#pragma unroll
        for (int w = 0; w < 8; ++w) { sc0 += FS[2 * w]; sc1 += FS[2 * w + 1]; }
        sc0 = 1.f / sc0; sc1 = 1.f / sc1;
        fpassF2(tid, L);
        __syncthreads();
        fpassF3(tid, L);
        __syncthreads();
        funpack<h2_t, _Float16>(tid, L, KF0, KF1, sc0, sc1, skip[d], skip[512 + d]);
        __syncthreads();
        LAS bf16_t* ZL = (LAS bf16_t*)L;
        {
            int tq = tid; asm volatile("" : "+v"(tq));
#pragma unroll
            for (int k = 0; k < 12; ++k) { const int ch = tq + 512 * k, s = ch >> 10, off = (ch & 1023) * 8;
                typedef unsigned u32x4v_t __attribute__((ext_vector_type(4)));
                const u32x4v_t v = *(const u32x4v_t*)(ZT + (size_t)((s >> 1) * 512 + d) * T + (size_t)(s & 1) * SEQ + off);
                *(LAS u32x4v_t*)(ZL + s * SEQ + off) = v; }
        }
        __syncthreads();
        float xr[16], xi[16];
        {
            int tq = tid; asm volatile("" : "+v"(tq));
#pragma unroll
            for (int sg = 0; sg < 3; ++sg) {
                const int c = sg * 512 + d; const float w0 = cw[c], w1 = cw[1536 + c], w2 = cw[3072 + c], bb = cb[c];
#pragma unroll
                for (int bt = 0; bt < 2; ++bt) {
                    const LAS bf16_t* zr = ZL + (sg * 2 + bt) * SEQ; float cv[16];
#pragma unroll
                    for (int i = 0; i < 16; ++i) { const int t = tq + 512 * i;
                        const float zm = t > 0 ? bf2f(zr[t - 1]) : 0.f, z0 = bf2f(zr[t]), zp = t < SEQ - 1 ? bf2f(zr[t + 1]) : 0.f;
                        cv[i] = w0 * zm + w1 * z0 + w2 * zp + bb; }
                    if (sg == 0) {
#pragma unroll
                        for (int i = 0; i < 16; ++i) { if (bt == 0) xr[i] = cv[i]; else xi[i] = cv[i]; }
                    } else {
                        uint4 p0, p1; p0.x = pk_bf16(cv[0], cv[1]); p0.y = pk_bf16(cv[2], cv[3]); p0.z = pk_bf16(cv[4], cv[5]); p0.w = pk_bf16(cv[6], cv[7]);
                        p1.x = pk_bf16(cv[8], cv[9]); p1.y = pk_bf16(cv[10], cv[11]); p1.z = pk_bf16(cv[12], cv[13]); p1.w = pk_bf16(cv[14], cv[15]);
                        bf16_t* gp = ZT + (size_t)c * T + (size_t)bt * SEQ + tq * 16;
                        *(uint4*)gp = p0; *(uint4*)(gp + 8) = p1;
                    }
                }
            }
        }
        __syncthreads();
#pragma unroll 1
        for (int o = 0; o < 2; ++o) {
            fpassF1z(tid, L, xr, xi);
            __syncthreads();
            fpassF2(tid, L);
            __syncthreads();
            fpassF3KI3<h2_t>(tid, L, o == 0 ? KF0 : KF1);
            __syncthreads();
            fpassI2(tid, L);
            __syncthreads();
            uint4 a0, a1, b0, b1;
            { int tq = tid; asm volatile("" : "+v"(tq));
              const bf16_t* gp = ZT + (size_t)((o + 1) * 512 + d) * T + tq * 16;
              a0 = *(const uint4*)gp; a1 = *(const uint4*)(gp + 8); b0 = *(const uint4*)(gp + SEQ); b1 = *(const uint4*)(gp + SEQ + 8); }
            __builtin_amdgcn_sched_barrier(0);
            fpassI1h(tid, L, xr, xi);
            {
                const unsigned ga[8] = {a0.x, a0.y, a0.z, a0.w, a1.x, a1.y, a1.z, a1.w}, gb[8] = {b0.x, b0.y, b0.z, b0.w, b1.x, b1.y, b1.z, b1.w};
#pragma unroll
                for (int i = 0; i < 8; ++i) {
                    xr[2 * i] *= __uint_as_float(ga[i] << 16) * (1.f / FN); xr[2 * i + 1] *= __uint_as_float(ga[i] & 0xffff0000u) * (1.f / FN);
                    xi[2 * i] *= __uint_as_float(gb[i] << 16) * (1.f / FN); xi[2 * i + 1] *= __uint_as_float(gb[i] & 0xffff0000u) * (1.f / FN);
                }
            }
        }
        {
            int tq = tid; asm volatile("" : "+v"(tq));
            uint4 p0, p1;
            p0.x = pk_bf16(xr[0], xr[1]); p0.y = pk_bf16(xr[2], xr[3]); p0.z = pk_bf16(xr[4], xr[5]); p0.w = pk_bf16(xr[6], xr[7]);
            p1.x = pk_bf16(xr[8], xr[9]); p1.y = pk_bf16(xr[10], xr[11]); p1.z = pk_bf16(xr[12], xr[13]); p1.w = pk_bf16(xr[14], xr[15]);
            bf16_t* op = ZT + (size_t)d * T + tq * 16;
            *(uint4*)op = p0; *(uint4*)(op + 8) = p1;
            p0.x = pk_bf16(xi[0], xi[1]); p0.y = pk_bf16(xi[2], xi[3]); p0.z = pk_bf16(xi[4], xi[5]); p0.w = pk_bf16(xi[6], xi[7]);
            p1.x = pk_bf16(xi[8], xi[9]); p1.y = pk_bf16(xi[10], xi[11]); p1.z = pk_bf16(xi[12], xi[13]); p1.w = pk_bf16(xi[14], xi[15]);
            *(uint4*)(op + SEQ) = p0; *(uint4*)(op + SEQ + 8) = p1;
        }
    }
}

#define HN_PITCH 1024
__device__ __forceinline__ void ph_hy_transpose(const bf16_t* ZT, bf16_t* HYO, LAS unsigned char* ldsb) {
    int tix_ = threadIdx.x; asm volatile("" : "+v"(tix_));
    const int wave = tix_ >> 6, lane = tix_ & 63;
    LAS bf16_t* tl = (LAS bf16_t*)ldsb + wave * (64 * 66);
    for (int wt = blockIdx.x * NWAVE + wave; wt < 2 * 8 * 128; wt += opq_gx() * NWAVE) {
        const int tc = wt & 127, dc = (wt >> 7) & 7, bt = wt >> 10;
#pragma unroll
        for (int k = 0; k < 8; ++k) { const int r = 8 * k + (lane >> 3), c8 = (lane & 7) * 8;
            const uint4 v = *(const uint4*)(ZT + (size_t)(dc * 64 + r) * T + (size_t)bt * SEQ + tc * 64 + c8);
            const unsigned w[4] = {v.x, v.y, v.z, v.w};
#pragma unroll
            for (int e = 0; e < 4; ++e) { tl[(c8 + 2 * e) * 66 + r] = (bf16_t)(w[e] & 0xffffu); tl[(c8 + 2 * e + 1) * 66 + r] = (bf16_t)(w[e] >> 16); } }
        asm volatile("s_waitcnt lgkmcnt(0)" ::: "memory");
#pragma unroll
        for (int k = 0; k < 8; ++k) { const int x = 8 * k + (lane >> 3), c8 = (lane & 7) * 8; const int t = (tc * 4 + (x >> 4)) + 512 * (x & 15);
            const LAS bf16_t* sp = tl + x * 66 + c8;
            uint4 o; o.x = (unsigned)sp[0] | ((unsigned)sp[1] << 16); o.y = (unsigned)sp[2] | ((unsigned)sp[3] << 16); o.z = (unsigned)sp[4] | ((unsigned)sp[5] << 16); o.w = (unsigned)sp[6] | ((unsigned)sp[7] << 16);
            *(uint4*)(HYO + ((size_t)bt * SEQ + t) * HN_PITCH + dc * 64 + c8) = o; }
        asm volatile("s_waitcnt lgkmcnt(0)" ::: "memory");
    }
}

typedef short s16x4_t __attribute__((ext_vector_type(4)));

__device__ __forceinline__ void ph_natten_mfma(const bf16_t* ZN, const bf16_t* VT, const bf16_t* KC, const bf16_t* VCT, const float* rpb, bf16_t* NAO) {
    int tix_ = threadIdx.x; asm volatile("" : "+v"(tix_));
    const int wave = tix_ >> 6, lane = tix_ & 63, q = lane & 15, g = lane >> 4;
    const bool xcdmap = (gridDim.x & 7) == 0;
    const int ustart = xcdmap ? (int)(blockIdx.x >> 3) * NWAVE + wave : (int)blockIdx.x * NWAVE + wave, ustep = xcdmap ? (int)(gridDim.x >> 3) * NWAVE : (int)opq_gx() * NWAVE;
    const int uend = xcdmap ? BATCH * 128 * 4 : BATCH * 128 * NH * 4;
    for (int uu = ustart; uu < uend; uu += ustep) {
        const int unit = xcdmap ? (((uu >> 2) << 5) | ((int)(blockIdx.x & 7) << 2) | (uu & 3)) : uu;
        const int c0 = (unit & 3) * 16, h = (unit >> 2) & 7, r = (unit >> 5) & 127, b = unit >> 12;
        int w0 = c0 - 8; w0 = w0 < 0 ? 0 : (w0 > 32 ? 32 : w0);
        int rs = r - 4; rs = rs < 0 ? 0 : (rs > 120 ? 120 : rs);
        const int tq = b * SEQ + r * GRID_W + c0 + q;
        bf16x8 qf[2];
#pragma unroll
        for (int ks = 0; ks < 2; ++ks) qf[ks] = *(const bf16x8*)(ZN + (size_t)tq * 3072 + h * HD + ks * 32 + g * 8);
        f32x4 s[32];
#pragma unroll
        for (int grp = 0; grp < 4; ++grp) {
            bf16x8 ka[8][2];
#pragma unroll
            for (int i8 = 0; i8 < 8; ++i8) {
                const int blk = grp * 8 + i8;
                const bf16_t* kp = blk < 16
                    ? ZN + (size_t)(b * SEQ + (rs + (blk >> 1)) * GRID_W + w0 + 8 * (q >> 2) + 4 * (blk & 1) + (q & 3)) * 3072 + 512 + h * HD + g * 8
                    : KC + (size_t)(b * CTX + ((blk - 16) >> 1) * 32 + 8 * (q >> 2) + 4 * (blk & 1) + (q & 3)) * 512 + h * HD + g * 8;
                ka[i8][0] = *(const bf16x8*)kp; ka[i8][1] = *(const bf16x8*)(kp + 32);
            }
            __builtin_amdgcn_sched_barrier(0);
#pragma unroll
            for (int i8 = 0; i8 < 8; ++i8) {
                f32x4 acc = (f32x4){0.f, 0.f, 0.f, 0.f};
                acc = __builtin_amdgcn_mfma_f32_16x16x32_bf16(ka[i8][0], qf[0], acc, 0, 0, 0);
                s[grp * 8 + i8] = __builtin_amdgcn_mfma_f32_16x16x32_bf16(ka[i8][1], qf[1], acc, 0, 0, 0);
            }
            __builtin_amdgcn_sched_barrier(0);
        }
        const int qc = c0 + q; int cs = qc - 8; cs = cs < 0 ? 0 : (cs > 48 ? 48 : cs);
        float mx = -1e30f;
        {
            float bia[16][4];
#pragma unroll
            for (int blk = 0; blk < 16; ++blk) {
                const float* brow = rpb + (h * 15 + (rs + (blk >> 1) - r + 7)) * 31 + 15;
#pragma unroll
                for (int e = 0; e < 4; ++e) { int dc = w0 + 8 * g + 4 * (blk & 1) + e - qc; dc = dc < -15 ? -15 : (dc > 15 ? 15 : dc); bia[blk][e] = brow[dc]; }
            }
            __builtin_amdgcn_sched_barrier(0);
#pragma unroll
            for (int blk = 0; blk < 16; ++blk)
#pragma unroll
                for (int e = 0; e < 4; ++e) {
                    const int kc = w0 + 8 * g + 4 * (blk & 1) + e;
                    const bool ok = kc >= cs && kc < cs + 16;
                    const float v = ok ? s[blk][e] * 0.125f + bia[blk][e] : -1e30f;
                    s[blk][e] = v; mx = fmaxf(mx, v);
                }
        }
#pragma unroll
        for (int j = 16; j < 32; ++j)
#pragma unroll
            for (int e = 0; e < 4; ++e) { const float v = s[j][e] * 0.125f; s[j][e] = v; mx = fmaxf(mx, v); }
        mx = fmaxf(mx, __shfl_xor(mx, 16)); mx = fmaxf(mx, __shfl_xor(mx, 32));
        float sum = 0.f;
        unsigned pbu[16][4];
#pragma unroll
        for (int kk = 0; kk < 16; ++kk) {
            float pe[8];
#pragma unroll
            for (int e = 0; e < 4; ++e) { pe[e] = __expf(s[2 * kk][e] - mx); pe[4 + e] = __expf(s[2 * kk + 1][e] - mx); }
#pragma unroll
            for (int e = 0; e < 8; ++e) sum += pe[e];
            pbu[kk][0] = pk_bf16(pe[0], pe[1]); pbu[kk][1] = pk_bf16(pe[2], pe[3]); pbu[kk][2] = pk_bf16(pe[4], pe[5]); pbu[kk][3] = pk_bf16(pe[6], pe[7]);
        }
        sum += __shfl_xor(sum, 16); sum += __shfl_xor(sum, 32);
        const float rinv = 1.f / sum;
        f32x4 o[4];
#pragma unroll
        for (int mt = 0; mt < 4; ++mt) o[mt] = (f32x4){0.f, 0.f, 0.f, 0.f};
#pragma unroll
        for (int grp = 0; grp < 4; ++grp) {
            bf16x8 va[4][4];
#pragma unroll
            for (int k4 = 0; k4 < 4; ++k4) {
                const int kk = grp * 4 + k4;
#pragma unroll
                for (int mt = 0; mt < 4; ++mt) {
                    const bf16_t* vp = kk < 8 ? VT + (size_t)(h * HD + 16 * mt + q) * VPITCH + b * SEQ + (rs + kk) * GRID_W + w0 + 8 * g
                                              : VCT + (size_t)(h * HD + 16 * mt + q) * 512 + b * CTX + (kk - 8) * 32 + 8 * g;
                    va[k4][mt] = *(const bf16x8*)vp;
                }
            }
            __builtin_amdgcn_sched_barrier(0);
#pragma unroll
            for (int k4 = 0; k4 < 4; ++k4) {
                const int kk = grp * 4 + k4;
                union { unsigned u[4]; bf16x8 v; } pb; pb.u[0] = pbu[kk][0]; pb.u[1] = pbu[kk][1]; pb.u[2] = pbu[kk][2]; pb.u[3] = pbu[kk][3];
#pragma unroll
                for (int mt = 0; mt < 4; ++mt) o[mt] = __builtin_amdgcn_mfma_f32_16x16x32_bf16(va[k4][mt], pb.v, o[mt], 0, 0, 0);
            }
            __builtin_amdgcn_sched_barrier(0);
        }
#pragma unroll
        for (int mt = 0; mt < 4; ++mt) {
            uint2 w; w.x = pk_bf16(o[mt][0] * rinv, o[mt][1] * rinv); w.y = pk_bf16(o[mt][2] * rinv, o[mt][3] * rinv);
            *(uint2*)(NAO + (size_t)tq * HN_PITCH + h * HD + 16 * mt + 4 * g) = w;
        }
    }
}

__device__ __forceinline__ void ph_natten_lds(const bf16_t* ZN, const bf16_t* VT, const bf16_t* KC, const bf16_t* VCT, const float* rpb, bf16_t* NAO, LAS unsigned char* lds) {
    int tix_ = threadIdx.x; asm volatile("" : "+v"(tix_));
    const int tid = tix_, wave = __builtin_amdgcn_readfirstlane(tid >> 6), lane = tid & 63, q_ = lane & 15, g_ = lane >> 4;
    typedef unsigned u32x4v_t __attribute__((ext_vector_type(4)));
    LAS unsigned char* KR = lds; LAS unsigned char* VR = lds + 65536; LAS float* XO = (LAS float*)(lds + 131072); LAS float* XM = XO + 4 * 1024;
    const int h = blockIdx.x & 7, nper = 256 / (int)(gridDim.x >> 3);
    const int i0 = (int)(blockIdx.x >> 3) * nper;
    const int tile = wave & 3, half = wave >> 2, c0 = tile * 16;
    int w0 = c0 - 8; w0 = w0 < 0 ? 0 : (w0 > 32 ? 32 : w0);
    const int cr = tid >> 3, ch = tid & 7;
    const int swz = ((ch ^ (cr & 7)) << 4) + cr * 128;
    int prev_b = -1, prev_rs = 0;
    u32x4v_t pre_k = (u32x4v_t){0u, 0u, 0u, 0u}, pre_v = (u32x4v_t){0u, 0u, 0u, 0u};
    bf16x8 qf[2], qn[2];
    { const int b = i0 >> 7, r = i0 & 127; const int tq = b * SEQ + r * GRID_W + c0 + q_;
#pragma unroll
      for (int ks = 0; ks < 2; ++ks) qn[ks] = *(const bf16x8*)(ZN + (size_t)tq * 3072 + h * HD + ks * 32 + g_ * 8); }
    for (int it = 0; it < nper; ++it) {
        int q = q_, g = g_; asm volatile("" : "+v"(q), "+v"(g));
        const int br = i0 + it, b = br >> 7, r = br & 127;
        int rs = r - 4; rs = rs < 0 ? 0 : (rs > 120 ? 120 : rs);
        const int tq = b * SEQ + r * GRID_W + c0 + q;
        qf[0] = qn[0]; qf[1] = qn[1];
        if (it == 0 || b != prev_b) {
            for (int R = rs; R < rs + 8; ++R) {
                const int slot = R & 7;
                const u32x4v_t kv = *(const u32x4v_t*)(ZN + (size_t)(b * SEQ + R * GRID_W + cr) * 3072 + 512 + h * HD + ch * 8);
                const u32x4v_t vv = *(const u32x4v_t*)(VT + (size_t)(h * HD + cr) * VPITCH + b * SEQ + R * GRID_W + ch * 8);
                *(LAS u32x4v_t*)(KR + slot * 8192 + swz) = kv; *(LAS u32x4v_t*)(VR + slot * 8192 + swz) = vv;
            }
        } else if (rs != prev_rs) {
            const int slot = (rs + 7) & 7;
            *(LAS u32x4v_t*)(KR + slot * 8192 + swz) = pre_k; *(LAS u32x4v_t*)(VR + slot * 8192 + swz) = pre_v;
        }
        prev_b = b; prev_rs = rs;
        __syncthreads();
        if (it + 1 < nper) {
            const int br2 = br + 1, b2 = br2 >> 7, r2 = br2 & 127; int rs2 = r2 - 4; rs2 = rs2 < 0 ? 0 : (rs2 > 120 ? 120 : rs2);
            if (b2 == b && rs2 != rs) {
                pre_k = *(const u32x4v_t*)(ZN + (size_t)(b * SEQ + (rs2 + 7) * GRID_W + cr) * 3072 + 512 + h * HD + ch * 8);
                pre_v = *(const u32x4v_t*)(VT + (size_t)(h * HD + cr) * VPITCH + b * SEQ + (rs2 + 7) * GRID_W + ch * 8);
            }
            const int tq2 = b2 * SEQ + r2 * GRID_W + c0 + q;
#pragma unroll
            for (int ks = 0; ks < 2; ++ks) qn[ks] = *(const bf16x8*)(ZN + (size_t)tq2 * 3072 + h * HD + ks * 32 + g * 8);
        }
        float mx = -1e30f, sum = 0.f;
        f32x4 o[4];
#pragma unroll
        for (int mt = 0; mt < 4; ++mt) o[mt] = (f32x4){0.f, 0.f, 0.f, 0.f};
        if (half == 0) {
            float bia[16][4];
            const int qc = c0 + q; int cs = qc - 8; cs = cs < 0 ? 0 : (cs > 48 ? 48 : cs);
#pragma unroll
            for (int blk = 0; blk < 16; ++blk) {
                const float* brow = rpb + (h * 15 + (rs + (blk >> 1) - r + 7)) * 31 + 15;
#pragma unroll
                for (int e = 0; e < 4; ++e) { int dc = w0 + 8 * g + 4 * (blk & 1) + e - qc; dc = dc < -15 ? -15 : (dc > 15 ? 15 : dc); bia[blk][e] = brow[dc]; }
            }
            f32x4 s[16];
#pragma unroll
            for (int blk = 0; blk < 16; ++blk) {
                const int col = w0 + 8 * (q >> 2) + 4 * (blk & 1) + (q & 3), slot = (rs + (blk >> 1)) & 7;
                const LAS unsigned char* kp = KR + slot * 8192 + col * 128;
                const bf16x8 a0 = *(const LAS bf16x8*)(kp + ((g ^ (col & 7)) << 4)), a1 = *(const LAS bf16x8*)(kp + (((4 + g) ^ (col & 7)) << 4));
                f32x4 acc = (f32x4){0.f, 0.f, 0.f, 0.f};
                acc = __builtin_amdgcn_mfma_f32_16x16x32_bf16(a0, qf[0], acc, 0, 0, 0);
                s[blk] = __builtin_amdgcn_mfma_f32_16x16x32_bf16(a1, qf[1], acc, 0, 0, 0);
            }
#pragma unroll
            for (int blk = 0; blk < 16; ++blk)
#pragma unroll
                for (int e = 0; e < 4; ++e) {
                    const int kc = w0 + 8 * g + 4 * (blk & 1) + e;
                    const bool ok = kc >= cs && kc < cs + 16;
                    const float v = ok ? s[blk][e] * 0.125f + bia[blk][e] : -1e30f;
                    s[blk][e] = v; mx = fmaxf(mx, v);
                }
            mx = fmaxf(mx, __shfl_xor(mx, 16)); mx = fmaxf(mx, __shfl_xor(mx, 32));
#pragma unroll
            for (int kk = 0; kk < 8; ++kk) {
                float pe[8];
#pragma unroll
                for (int e = 0; e < 4; ++e) { pe[e] = __expf(s[2 * kk][e] - mx); pe[4 + e] = __expf(s[2 * kk + 1][e] - mx); }
#pragma unroll
                for (int e = 0; e < 8; ++e) sum += pe[e];
                union { unsigned u[4]; bf16x8 v; } pb; pb.u[0] = pk_bf16(pe[0], pe[1]); pb.u[1] = pk_bf16(pe[2], pe[3]); pb.u[2] = pk_bf16(pe[4], pe[5]); pb.u[3] = pk_bf16(pe[6], pe[7]);
                const int slot = (rs + kk) & 7;
#pragma unroll
                for (int mt = 0; mt < 4; ++mt) { const int dr = 16 * mt + q;
                    const bf16x8 vf = *(const LAS bf16x8*)(VR + slot * 8192 + dr * 128 + ((((w0 >> 3) + g) ^ (dr & 7)) << 4));
                    o[mt] = __builtin_amdgcn_mfma_f32_16x16x32_bf16(vf, pb.v, o[mt], 0, 0, 0); }
            }
            sum += __shfl_xor(sum, 16); sum += __shfl_xor(sum, 32);
        } else {
            f32x4 s[16];
#pragma unroll
            for (int grp = 0; grp < 2; ++grp) {
                bf16x8 ka[8][2];
#pragma unroll
                for (int i8 = 0; i8 < 8; ++i8) { const int j2 = grp * 8 + i8;
                    const bf16_t* kp = KC + (size_t)(b * CTX + (j2 >> 1) * 32 + 8 * (q >> 2) + 4 * (j2 & 1) + (q & 3)) * 512 + h * HD + g * 8;
                    ka[i8][0] = *(const bf16x8*)kp; ka[i8][1] = *(const bf16x8*)(kp + 32); }
                __builtin_amdgcn_sched_barrier(0);
#pragma unroll
                for (int i8 = 0; i8 < 8; ++i8) { f32x4 acc = (f32x4){0.f, 0.f, 0.f, 0.f};
                    acc = __builtin_amdgcn_mfma_f32_16x16x32_bf16(ka[i8][0], qf[0], acc, 0, 0, 0);
                    s[grp * 8 + i8] = __builtin_amdgcn_mfma_f32_16x16x32_bf16(ka[i8][1], qf[1], acc, 0, 0, 0); }
                __builtin_amdgcn_sched_barrier(0);
            }
            bf16x8 va[8][4];
#pragma unroll
            for (int kk = 0; kk < 8; ++kk)
#pragma unroll
                for (int mt = 0; mt < 4; ++mt) va[kk][mt] = *(const bf16x8*)(VCT + (size_t)(h * HD + 16 * mt + q) * 512 + b * CTX + kk * 32 + 8 * g);
            __builtin_amdgcn_sched_barrier(0);
#pragma unroll
            for (int j2 = 0; j2 < 16; ++j2)
#pragma unroll
                for (int e = 0; e < 4; ++e) { const float v = s[j2][e] * 0.125f; s[j2][e] = v; mx = fmaxf(mx, v); }
            mx = fmaxf(mx, __shfl_xor(mx, 16)); mx = fmaxf(mx, __shfl_xor(mx, 32));
#pragma unroll
            for (int kk = 0; kk < 8; ++kk) {
                float pe[8];
#pragma unroll
                for (int e = 0; e < 4; ++e) { pe[e] = __expf(s[2 * kk][e] - mx); pe[4 + e] = __expf(s[2 * kk + 1][e] - mx); }
#pragma unroll
                for (int e = 0; e < 8; ++e) sum += pe[e];
                union { unsigned u[4]; bf16x8 v; } pb; pb.u[0] = pk_bf16(pe[0], pe[1]); pb.u[1] = pk_bf16(pe[2], pe[3]); pb.u[2] = pk_bf16(pe[4], pe[5]); pb.u[3] = pk_bf16(pe[6], pe[7]);
#pragma unroll
                for (int mt = 0; mt < 4; ++mt) o[mt] = __builtin_amdgcn_mfma_f32_16x16x32_bf16(va[kk][mt], pb.v, o[mt], 0, 0, 0);
            }
            sum += __shfl_xor(sum, 16); sum += __shfl_xor(sum, 32);
#pragma unroll
            for (int mt = 0; mt < 4; ++mt) *(LAS f32x4*)(XO + tile * 1024 + lane * 16 + 4 * mt) = o[mt];
            if (g == 0) { XM[tile * 32 + q] = mx; XM[tile * 32 + 16 + q] = sum; }
        }
        __syncthreads();
        if (half == 0) {
            const float mb = XM[tile * 32 + q], lb = XM[tile * 32 + 16 + q];
            const float m = fmaxf(mx, mb), fa = __expf(mx - m), fb = __expf(mb - m);
            const float rinv = 1.f / (sum * fa + lb * fb);
#pragma unroll
            for (int mt = 0; mt < 4; ++mt) {
                const f32x4 ob = *(const LAS f32x4*)(XO + tile * 1024 + lane * 16 + 4 * mt);
                const f32x4 oc = (o[mt] * fa + ob * fb) * rinv;
                uint2 w; w.x = pk_bf16(oc[0], oc[1]); w.y = pk_bf16(oc[2], oc[3]);
                *(uint2*)(NAO + (size_t)tq * HN_PITCH + h * HD + 16 * mt + 4 * g) = w;
            }
        }
    }
    __syncthreads();
}

__device__ __forceinline__ void ph_natten2(const bf16_t* ZN, const bf16_t* VT, const bf16_t* KC, const bf16_t* VCT, const float* rpb, bf16_t* NAO, unsigned char* SCR, LAS unsigned char* lds) {
    int tix_ = threadIdx.x; asm volatile("" : "+v"(tix_));
    const int tid = tix_, wave = __builtin_amdgcn_readfirstlane(tid >> 6), lane = tid & 63, q_ = lane & 15, g_ = lane >> 4;
    typedef unsigned u32x4v_t __attribute__((ext_vector_type(4)));
    const int h = blockIdx.x & 7, i0 = (int)(blockIdx.x >> 3) * 8, b = i0 >> 7;
    constexpr int TSTR = 2304;
    {
        LAS unsigned char* KL = lds; LAS unsigned char* VL = lds + 32768;
#pragma unroll
        for (int i = 0; i < 4; ++i) {
            const int key = (tid >> 3) + 64 * i, ch = tid & 7;
            *(LAS u32x4v_t*)(KL + key * 128 + ((ch ^ (key & 7)) << 4)) = *(const u32x4v_t*)(KC + (size_t)(b * CTX + key) * 512 + h * HD + ch * 8);
            const int dim = (tid >> 5) + 16 * i, c = tid & 31;
            *(LAS u32x4v_t*)(VL + dim * 512 + ((c ^ (dim & 7)) << 4)) = *(const u32x4v_t*)(VCT + (size_t)(h * HD + dim) * 512 + b * CTX + c * 8);
        }
        __syncthreads();
        bf16x8 qn[2];
        { const int tq = b * SEQ + (i0 & 127) * GRID_W + (wave & 3) * 16 + q_ + (wave >> 2) * GRID_W;
#pragma unroll
          for (int ks = 0; ks < 2; ++ks) qn[ks] = *(const bf16x8*)(ZN + (size_t)tq * 3072 + h * HD + ks * 32 + g_ * 8); }
#pragma unroll 1
        for (int tt = 0; tt < 4; ++tt) {
            int q = q_, g = g_; asm volatile("" : "+v"(q), "+v"(g));
            const int tile = wave + 8 * tt;
            bf16x8 qf[2]; qf[0] = qn[0]; qf[1] = qn[1];
            if (tt < 3) { const int t2 = tile + 8; const int tq2 = b * SEQ + ((i0 & 127) + (t2 >> 2)) * GRID_W + (t2 & 3) * 16 + q;
#pragma unroll
                for (int ks = 0; ks < 2; ++ks) qn[ks] = *(const bf16x8*)(ZN + (size_t)tq2 * 3072 + h * HD + ks * 32 + g * 8); }
            f32x4 s[16];
#pragma unroll
            for (int j = 0; j < 16; ++j) {
                const int key = (j >> 1) * 32 + 8 * (q >> 2) + 4 * (j & 1) + (q & 3);
                const LAS unsigned char* kp = KL + key * 128;
                const bf16x8 a0 = *(const LAS bf16x8*)(kp + ((g ^ (key & 7)) << 4)), a1 = *(const LAS bf16x8*)(kp + (((4 + g) ^ (key & 7)) << 4));
                f32x4 acc = (f32x4){0.f, 0.f, 0.f, 0.f};
                acc = __builtin_amdgcn_mfma_f32_16x16x32_bf16(a0, qf[0], acc, 0, 0, 0);
                s[j] = __builtin_amdgcn_mfma_f32_16x16x32_bf16(a1, qf[1], acc, 0, 0, 0);
            }
            float mx = -1e30f, sum = 0.f;
#pragma unroll
            for (int j = 0; j < 16; ++j)
#pragma unroll
                for (int e = 0; e < 4; ++e) { const float v = s[j][e] * 0.125f; s[j][e] = v; mx = fmaxf(mx, v); }
            mx = fmaxf(mx, __shfl_xor(mx, 16)); mx = fmaxf(mx, __shfl_xor(mx, 32));
            f32x4 o[4];
#pragma unroll
            for (int mt = 0; mt < 4; ++mt) o[mt] = (f32x4){0.f, 0.f, 0.f, 0.f};
#pragma unroll
            for (int kk = 0; kk < 8; ++kk) {
                float pe[8];
#pragma unroll
                for (int e = 0; e < 4; ++e) { pe[e] = __expf(s[2 * kk][e] - mx); pe[4 + e] = __expf(s[2 * kk + 1][e] - mx); }
#pragma unroll
                for (int e = 0; e < 8; ++e) sum += pe[e];
                union { unsigned u[4]; bf16x8 v; } pb; pb.u[0] = pk_bf16(pe[0], pe[1]); pb.u[1] = pk_bf16(pe[2], pe[3]); pb.u[2] = pk_bf16(pe[4], pe[5]); pb.u[3] = pk_bf16(pe[6], pe[7]);
#pragma unroll
                for (int mt = 0; mt < 4; ++mt) { const int dr = 16 * mt + q;
                    const bf16x8 vf = *(const LAS bf16x8*)(VL + dr * 512 + ((((4 * kk + g) ^ (dr & 7))) << 4));
                    o[mt] = __builtin_amdgcn_mfma_f32_16x16x32_bf16(vf, pb.v, o[mt], 0, 0, 0); }
            }
            sum += __shfl_xor(sum, 16); sum += __shfl_xor(sum, 32);
            unsigned char* sp = SCR + (size_t)tile * TSTR;
            uint4 w0, w1; w0.x = pk_bf16(o[0][0], o[0][1]); w0.y = pk_bf16(o[0][2], o[0][3]); w0.z = pk_bf16(o[1][0], o[1][1]); w0.w = pk_bf16(o[1][2], o[1][3]);
            w1.x = pk_bf16(o[2][0], o[2][1]); w1.y = pk_bf16(o[2][2], o[2][3]); w1.z = pk_bf16(o[3][0], o[3][1]); w1.w = pk_bf16(o[3][2], o[3][3]);
            *(uint4*)(sp + (q + 16 * g) * 32) = w0; *(uint4*)(sp + (q + 16 * g) * 32 + 16) = w1;
            if (g == 0) { *(float*)(sp + 2048 + 4 * q) = mx; *(float*)(sp + 2112 + 4 * q) = sum; }
        }
    }
    __syncthreads();
    {
        LAS unsigned char* KR = lds; LAS unsigned char* VR = lds + 73728;
        const int tile = wave & 3, rsel = wave >> 2, c0 = tile * 16;
        int w0 = c0 - 8; w0 = w0 < 0 ? 0 : (w0 > 32 ? 32 : w0);
        const int cr = tid >> 3, ch = tid & 7, swz = ((ch ^ (cr & 7)) << 4) + cr * 128;
        int have_hi = 0, bias_dro = -100;
        u32x4v_t pre_k[2], pre_v[2];
#pragma unroll
        for (int i = 0; i < 2; ++i) { pre_k[i] = (u32x4v_t){0u, 0u, 0u, 0u}; pre_v[i] = (u32x4v_t){0u, 0u, 0u, 0u}; }
        bf16x8 qn[2]; uint4 on0, on1; float mcn, lcn; float bia[16][4];
        {
            const int r = (i0 & 127) + rsel; const int tq = b * SEQ + r * GRID_W + c0 + q_;
#pragma unroll
            for (int ks = 0; ks < 2; ++ks) qn[ks] = *(const bf16x8*)(ZN + (size_t)tq * 3072 + h * HD + ks * 32 + g_ * 8);
            const unsigned char* sp = SCR + (size_t)(rsel * 4 + tile) * TSTR;
            on0 = *(const uint4*)(sp + lane * 32); on1 = *(const uint4*)(sp + lane * 32 + 16); mcn = *(const float*)(sp + 2048 + 4 * q_); lcn = *(const float*)(sp + 2112 + 4 * q_);
        }
#pragma unroll 1
        for (int pp = 0; pp < 4; ++pp) {
            int q = q_, g = g_; asm volatile("" : "+v"(q), "+v"(g));
            const int r0 = (i0 & 127) + 2 * pp, r = r0 + rsel;
            int lo = r0 - 4; lo = lo < 0 ? 0 : (lo > 120 ? 120 : lo);
            int rs1 = r0 - 3; rs1 = rs1 < 0 ? 0 : (rs1 > 120 ? 120 : rs1);
            const int hi = rs1 + 8;
            int rs = r - 4; rs = rs < 0 ? 0 : (rs > 120 ? 120 : rs);
            if (pp == 0) {
                for (int R = lo; R < hi; ++R) { const int slot = R % 9;
                    const u32x4v_t kv = *(const u32x4v_t*)(ZN + (size_t)(b * SEQ + R * GRID_W + cr) * 3072 + 512 + h * HD + ch * 8);
                    const u32x4v_t vv = *(const u32x4v_t*)(VT + (size_t)(h * HD + cr) * VPITCH + b * SEQ + R * GRID_W + ch * 8);
                    *(LAS u32x4v_t*)(KR + slot * 8192 + swz) = kv; *(LAS u32x4v_t*)(VR + slot * 8192 + swz) = vv; }
            } else {
                __syncthreads();
#pragma unroll
                for (int i = 0; i < 2; ++i) if (have_hi + i < hi) { const int slot = (have_hi + i) % 9;
                    *(LAS u32x4v_t*)(KR + slot * 8192 + swz) = pre_k[i]; *(LAS u32x4v_t*)(VR + slot * 8192 + swz) = pre_v[i]; }
            }
            have_hi = hi;
            __syncthreads();
            bf16x8 qf[2]; qf[0] = qn[0]; qf[1] = qn[1];
            const uint4 oc0 = on0, oc1 = on1; const float mc = mcn, lc = lcn;
            if (pp < 3) {
                const int r0n = r0 + 2; int rs1n = r0n - 3; rs1n = rs1n < 0 ? 0 : (rs1n > 120 ? 120 : rs1n); const int hin = rs1n + 8;
#pragma unroll
                for (int i = 0; i < 2; ++i) if (hi + i < hin) { const int R = hi + i;
                    pre_k[i] = *(const u32x4v_t*)(ZN + (size_t)(b * SEQ + R * GRID_W + cr) * 3072 + 512 + h * HD + ch * 8);
                    pre_v[i] = *(const u32x4v_t*)(VT + (size_t)(h * HD + cr) * VPITCH + b * SEQ + R * GRID_W + ch * 8); }
                const int tq2 = b * SEQ + (r + 2) * GRID_W + c0 + q;
#pragma unroll
                for (int ks = 0; ks < 2; ++ks) qn[ks] = *(const bf16x8*)(ZN + (size_t)tq2 * 3072 + h * HD + ks * 32 + g * 8);
                const unsigned char* sp = SCR + (size_t)((2 * pp + 2 + rsel) * 4 + tile) * TSTR;
                on0 = *(const uint4*)(sp + (q + 16 * g) * 32); on1 = *(const uint4*)(sp + (q + 16 * g) * 32 + 16); mcn = *(const float*)(sp + 2048 + 4 * q); lcn = *(const float*)(sp + 2112 + 4 * q);
            }
            if (rs - r != bias_dro) {
                bias_dro = rs - r; const int qc = c0 + q;
#pragma unroll
                for (int blk = 0; blk < 16; ++blk) {
                    const float* brow = rpb + (h * 15 + (rs + (blk >> 1) - r + 7)) * 31 + 15;
#pragma unroll
                    for (int e = 0; e < 4; ++e) { int dc = w0 + 8 * g + 4 * (blk & 1) + e - qc; dc = dc < -15 ? -15 : (dc > 15 ? 15 : dc); bia[blk][e] = brow[dc]; }
                }
            }
            const int tq = b * SEQ + r * GRID_W + c0 + q;
            const int qc = c0 + q; int cs = qc - 8; cs = cs < 0 ? 0 : (cs > 48 ? 48 : cs);
            f32x4 s[16];
#pragma unroll
            for (int blk = 0; blk < 16; ++blk) {
                const int col = w0 + 8 * (q >> 2) + 4 * (blk & 1) + (q & 3), slot = (rs + (blk >> 1)) % 9;
                const LAS unsigned char* kp = KR + slot * 8192 + col * 128;
                const bf16x8 a0 = *(const LAS bf16x8*)(kp + ((g ^ (col & 7)) << 4)), a1 = *(const LAS bf16x8*)(kp + (((4 + g) ^ (col & 7)) << 4));
                f32x4 acc = (f32x4){0.f, 0.f, 0.f, 0.f};
                acc = __builtin_amdgcn_mfma_f32_16x16x32_bf16(a0, qf[0], acc, 0, 0, 0);
                s[blk] = __builtin_amdgcn_mfma_f32_16x16x32_bf16(a1, qf[1], acc, 0, 0, 0);
            }
            float mx = -1e30f, sum = 0.f;
#pragma unroll
            for (int blk = 0; blk < 16; ++blk)
#pragma unroll
                for (int e = 0; e < 4; ++e) {
                    const int kc = w0 + 8 * g + 4 * (blk & 1) + e;
                    const bool ok = kc >= cs && kc < cs + 16;
                    const float v = ok ? s[blk][e] * 0.125f + bia[blk][e] : -1e30f;
                    s[blk][e] = v; mx = fmaxf(mx, v);
                }
            mx = fmaxf(mx, __shfl_xor(mx, 16)); mx = fmaxf(mx, __shfl_xor(mx, 32));
            f32x4 o[4];
#pragma unroll
            for (int mt = 0; mt < 4; ++mt) o[mt] = (f32x4){0.f, 0.f, 0.f, 0.f};
#pragma unroll
            for (int kk = 0; kk < 8; ++kk) {
                float pe[8];
#pragma unroll
                for (int e = 0; e < 4; ++e) { pe[e] = __expf(s[2 * kk][e] - mx); pe[4 + e] = __expf(s[2 * kk + 1][e] - mx); }
#pragma unroll
                for (int e = 0; e < 8; ++e) sum += pe[e];
                union { unsigned u[4]; bf16x8 v; } pb; pb.u[0] = pk_bf16(pe[0], pe[1]); pb.u[1] = pk_bf16(pe[2], pe[3]); pb.u[2] = pk_bf16(pe[4], pe[5]); pb.u[3] = pk_bf16(pe[6], pe[7]);
                const int slot = (rs + kk) % 9;
#pragma unroll
                for (int mt = 0; mt < 4; ++mt) { const int dr = 16 * mt + q;
                    const bf16x8 vf = *(const LAS bf16x8*)(VR + slot * 8192 + dr * 128 + ((((w0 >> 3) + g) ^ (dr & 7)) << 4));
                    o[mt] = __builtin_amdgcn_mfma_f32_16x16x32_bf16(vf, pb.v, o[mt], 0, 0, 0); }
            }
            sum += __shfl_xor(sum, 16); sum += __shfl_xor(sum, 32);
            const float m = fmaxf(mx, mc), fa = __expf(mx - m), fb = __expf(mc - m);
            const float rinv = 1.f / (sum * fa + lc * fb);
            const unsigned ow[8] = {oc0.x, oc0.y, oc0.z, oc0.w, oc1.x, oc1.y, oc1.z, oc1.w};
#pragma unroll
            for (int mt = 0; mt < 4; ++mt) {
                const f32x4 ob = (f32x4){__uint_as_float(ow[2 * mt] << 16), __uint_as_float(ow[2 * mt] & 0xffff0000u), __uint_as_float(ow[2 * mt + 1] << 16), __uint_as_float(ow[2 * mt + 1] & 0xffff0000u)};
                const f32x4 oc = (o[mt] * fa + ob * fb) * rinv;
                uint2 w; w.x = pk_bf16(oc[0], oc[1]); w.y = pk_bf16(oc[2], oc[3]);
                *(uint2*)(NAO + (size_t)tq * HN_PITCH + h * HD + 16 * mt + 4 * g) = w;
            }
        }
    }
    __syncthreads();
}

__device__ __forceinline__ void ph_natten(const bf16_t* ZN, const bf16_t* ZT, const bf16_t* KC, const bf16_t* VCT, const float* rpb, bf16_t* NAO, float* lds) {
    int tix_ = threadIdx.x; asm volatile("" : "+v"(tix_));
    const int wid = tix_ >> 6, lane = tix_ & 63;
    float* sc = lds + wid * 384;
    for (int gw = blockIdx.x * NWAVE + wid; gw < T * NH; gw += opq_gx() * NWAVE) {
        const int t = gw >> 3, h = gw & 7, b = t / SEQ, pos = t % SEQ, r = pos / GRID_W, c = pos % GRID_W;
        int rs = r - 4; rs = rs < 0 ? 0 : (rs > 120 ? 120 : rs);
        int cs = c - 8; cs = cs < 0 ? 0 : (cs > 48 ? 48 : cs);
        const float q = bf2f(ZN[(size_t)t * 3072 + h * HD + lane]);
        for (int i = 0; i < 8; ++i)
            for (int kc = cs; kc < cs + 16; ++kc) {
                const int tk = b * SEQ + (rs + i) * GRID_W + kc;
                const float kv = bf2f(ZN[(size_t)tk * 3072 + 512 + h * HD + lane]);
                float s = wave_sum(q * kv) * 0.125f;
                int dc = kc - c; dc = dc < -15 ? -15 : (dc > 15 ? 15 : dc);
                s += rpb[(h * 15 + (rs + i - r + 7)) * 31 + dc + 15];
                if (lane == 0) sc[i * 16 + (kc - cs)] = s;
            }
        for (int j = 0; j < CTX; ++j) {
            const float kv = bf2f(KC[(size_t)(b * CTX + j) * 512 + h * HD + lane]);
            const float s = wave_sum(q * kv) * 0.125f;
            if (lane == 0) sc[128 + j] = s;
        }
        __builtin_amdgcn_s_waitcnt(0);
        float mx = -INFINITY;
#pragma unroll
        for (int k = 0; k < 6; ++k) mx = fmaxf(mx, sc[lane + 64 * k]);
        mx = wave_max(mx);
        float pv[6], sum = 0.f;
#pragma unroll
        for (int k = 0; k < 6; ++k) { pv[k] = expf(sc[lane + 64 * k] - mx); sum += pv[k]; }
        sum = wave_sum(sum); const float rinv = 1.f / sum;
#pragma unroll
        for (int k = 0; k < 6; ++k) sc[lane + 64 * k] = pv[k] * rinv;
        __builtin_amdgcn_s_waitcnt(0);
        float o = 0.f;
        const bf16_t* vrow = ZT + (size_t)(1536 + h * HD + lane) * T;
        for (int i = 0; i < 8; ++i)
            for (int kk = 0; kk < 16; ++kk) { const int tk = b * SEQ + (rs + i) * GRID_W + cs + kk; o += sc[i * 16 + kk] * bf2f(vrow[tk]); }
        const bf16_t* vcrow = VCT + (size_t)(h * HD + lane) * 512 + b * CTX;
        for (int j = 0; j < CTX; ++j) o += sc[128 + j] * bf2f(vcrow[j]);
        NAO[(size_t)t * HN_PITCH + h * HD + lane] = f2bf(o);
        __builtin_amdgcn_s_waitcnt(0);
    }
}

__device__ __forceinline__ void ph_cvt_bf16(const float* src, bf16_t* dst, size_t n) {
    int tix_ = threadIdx.x; asm volatile("" : "+v"(tix_));
    const size_t stride = (size_t)gridDim.x * NTHR * 8;
    for (size_t i = ((size_t)blockIdx.x * NTHR + tix_) * 8; i < n; i += stride) {
        const f32x4 a = *(const f32x4*)(src + i), c = *(const f32x4*)(src + i + 4);
        uint4 w; w.x = pk_bf16(a[0], a[1]); w.y = pk_bf16(a[2], a[3]); w.z = pk_bf16(c[0], c[1]); w.w = pk_bf16(c[2], c[3]);
        *(uint4*)(dst + i) = w;
    }
}

constexpr int PROW = 768;
constexpr int PROWV = 512;
typedef float f32x2_t __attribute__((ext_vector_type(2)));
template <int FP4> __device__ __forceinline__ void ph_cvt_rows(const float* src, unsigned char* dst, float* scales, int nrows, const float* mod = nullptr, float* SU = nullptr) {
    int tix_ = threadIdx.x; asm volatile("" : "+v"(tix_));
    const int wave = tix_ >> 6, lane = tix_ & 63;
    f32x4 sh0[4], sh1[4];
#pragma unroll
    for (int i = 0; i < 4; ++i) { sh0[i] = SU ? *(const f32x4*)(mod + 3 * 1024 + 16 * lane + 4 * i) : (f32x4){0.f, 0.f, 0.f, 0.f}; sh1[i] = SU ? *(const f32x4*)(mod + 6144 + 3 * 1024 + 16 * lane + 4 * i) : (f32x4){0.f, 0.f, 0.f, 0.f}; }
    int bx_ = blockIdx.x; asm volatile("" : "+s"(bx_));
    const int rstep = opq_gx() * NWAVE; int row = bx_ * NWAVE + wave; if (row >= nrows) return;
    f32x4 vn[4];
#pragma unroll
    for (int i = 0; i < 4; ++i) vn[i] = *(const f32x4*)(src + (size_t)row * DM + 16 * lane + 4 * i);
    for (; row < nrows; row += rstep) {
        f32x4 v[4]; float am = 0.f;
#pragma unroll
        for (int i = 0; i < 4; ++i) v[i] = vn[i];
        if (row + rstep < nrows) {
#pragma unroll
            for (int i = 0; i < 4; ++i) vn[i] = *(const f32x4*)(src + (size_t)(row + rstep) * DM + 16 * lane + 4 * i);
        }
#pragma unroll
        for (int i = 0; i < 4; ++i) { am = fmaxf(am, fmaxf(fmaxf(fabsf(v[i][0]), fabsf(v[i][1])), fmaxf(fabsf(v[i][2]), fabsf(v[i][3])))); }
        am = wave_max(am);
        const float qmax = FP4 ? 6.f : 7.5f;
        const float inv = am > 0.f ? qmax / am : 1.f, sc = am > 0.f ? am * (1.f / qmax) : 1.f;
        if (FP4) {
            unsigned w0 = 0u, w1 = 0u;
            w0 = __builtin_amdgcn_cvt_scalef32_pk_fp4_f32(w0, v[0][0] * inv, v[0][1] * inv, 1.0f, 0); w0 = __builtin_amdgcn_cvt_scalef32_pk_fp4_f32(w0, v[0][2] * inv, v[0][3] * inv, 1.0f, 1);
            w0 = __builtin_amdgcn_cvt_scalef32_pk_fp4_f32(w0, v[1][0] * inv, v[1][1] * inv, 1.0f, 2); w0 = __builtin_amdgcn_cvt_scalef32_pk_fp4_f32(w0, v[1][2] * inv, v[1][3] * inv, 1.0f, 3);
            w1 = __builtin_amdgcn_cvt_scalef32_pk_fp4_f32(w1, v[2][0] * inv, v[2][1] * inv, 1.0f, 0); w1 = __builtin_amdgcn_cvt_scalef32_pk_fp4_f32(w1, v[2][2] * inv, v[2][3] * inv, 1.0f, 1);
            w1 = __builtin_amdgcn_cvt_scalef32_pk_fp4_f32(w1, v[3][0] * inv, v[3][1] * inv, 1.0f, 2); w1 = __builtin_amdgcn_cvt_scalef32_pk_fp4_f32(w1, v[3][2] * inv, v[3][3] * inv, 1.0f, 3);
            uint2 o; o.x = w0; o.y = w1; *(uint2*)(dst + (size_t)row * PROWV + 8 * lane) = o;
        } else {
            typedef float v16f_t __attribute__((ext_vector_type(16))); typedef unsigned v6u_t __attribute__((ext_vector_type(6))); typedef unsigned v3u_t __attribute__((ext_vector_type(3)));
            v16f_t xe, xo;
#pragma unroll
            for (int i = 0; i < 4; ++i) { xe[2 * i] = v[i][0] * inv; xo[2 * i] = v[i][1] * inv; xe[2 * i + 1] = v[i][2] * inv; xo[2 * i + 1] = v[i][3] * inv; }
#pragma unroll
            for (int i = 8; i < 16; ++i) { xe[i] = 0.f; xo[i] = 0.f; }
            const v6u_t w6 = __builtin_amdgcn_cvt_scalef32_2xpk16_fp6_f32(xe, xo, 1.0f);
            *(v3u_t*)(dst + (size_t)row * PROW + 12 * lane) = (v3u_t){w6[0], w6[1], w6[2]};
        }
        if (lane == 0) scales[row] = sc;
        if (SU) { float d0 = 0.f, d1 = 0.f;
#pragma unroll
            for (int i = 0; i < 4; ++i) { d0 += (v[i][0] * sh0[i][0] + v[i][1] * sh0[i][1]) + (v[i][2] * sh0[i][2] + v[i][3] * sh0[i][3]); d1 += (v[i][0] * sh1[i][0] + v[i][1] * sh1[i][1]) + (v[i][2] * sh1[i][2] + v[i][3] * sh1[i][3]); }
            d0 = wave_sum(d0); d1 = wave_sum(d1); if (lane == 0) { SU[row] = d0; SU[PNK * PNK + row] = d1; } }
    }
}

typedef __bf16 bf2_t __attribute__((ext_vector_type(2)));
template <int CTRL> __device__ __forceinline__ int dpp_i(int v) { return __builtin_amdgcn_update_dpp(0, v, CTRL, 0xF, 0xF, false); }
__device__ __forceinline__ int row_allmax_i(int v) { int o;
    o = dpp_i<0x121>(v); v = v > o ? v : o; o = dpp_i<0x122>(v); v = v > o ? v : o; o = dpp_i<0x124>(v); v = v > o ? v : o; o = dpp_i<0x128>(v); v = v > o ? v : o; return v; }
__device__ __forceinline__ float row_allsum_f(float v) {
    v += __int_as_float(dpp_i<0x121>(__float_as_int(v))); v += __int_as_float(dpp_i<0x122>(__float_as_int(v)));
    v += __int_as_float(dpp_i<0x124>(__float_as_int(v))); v += __int_as_float(dpp_i<0x128>(__float_as_int(v))); return v; }
__device__ __forceinline__ int f2key(float f) { const int i = __float_as_int(f); return i ^ ((i >> 31) & 0x7fffffff); }
__device__ __forceinline__ float key2f(int k) { return __int_as_float(k ^ ((k >> 31) & 0x7fffffff)); }
__device__ __forceinline__ float gelu_erf(float v) {
    const float av = fabsf(v), t = __builtin_amdgcn_rcpf(av * 0.2316418882f + 1.0f);
    float qq = t * 0.5307027145f + (-0.7265760135f); qq = qq * t + 0.7107068705f; qq = qq * t + (-0.142248368f); qq = qq * t + 0.127414796f; qq = qq * t;
    const float e = __builtin_amdgcn_exp2f((v * v) * (-0.72134752044f)), m = v * (qq * e);
    return v < 0.f ? m : v - m;
}
__device__ __forceinline__ float dot8(const uint4& a, const uint4& h, float acc) {
    acc = __builtin_amdgcn_fdot2_f32_bf16(__builtin_bit_cast(bf2_t, a.x), __builtin_bit_cast(bf2_t, h.x), acc, false);
    acc = __builtin_amdgcn_fdot2_f32_bf16(__builtin_bit_cast(bf2_t, a.y), __builtin_bit_cast(bf2_t, h.y), acc, false);
    acc = __builtin_amdgcn_fdot2_f32_bf16(__builtin_bit_cast(bf2_t, a.z), __builtin_bit_cast(bf2_t, h.z), acc, false);
    acc = __builtin_amdgcn_fdot2_f32_bf16(__builtin_bit_cast(bf2_t, a.w), __builtin_bit_cast(bf2_t, h.w), acc, false);
    return acc;
}
__device__ __forceinline__ void fma8(float (&o)[8], const uint4& v, float c) {
    o[0] += c * __uint_as_float(v.x << 16); o[1] += c * __uint_as_float(v.x & 0xffff0000u);
    o[2] += c * __uint_as_float(v.y << 16); o[3] += c * __uint_as_float(v.y & 0xffff0000u);
    o[4] += c * __uint_as_float(v.z << 16); o[5] += c * __uint_as_float(v.z & 0xffff0000u);
    o[6] += c * __uint_as_float(v.w << 16); o[7] += c * __uint_as_float(v.w & 0xffff0000u);
}
typedef unsigned v3u32_t __attribute__((ext_vector_type(3)));
typedef unsigned v2u32_t __attribute__((ext_vector_type(2)));
typedef float f32x2_t __attribute__((ext_vector_type(2)));
template <int OFF> __device__ __forceinline__ v3u32_t ldrow_(__amdgpu_buffer_rsrc_t r, int voff, int soff) { return __builtin_amdgcn_raw_buffer_load_b96(r, voff + OFF, soff, 0); }
__device__ __forceinline__ void dec16(const v3u32_t& r, float (&f)[16]) { typedef unsigned v6u_t __attribute__((ext_vector_type(6))); typedef float v32f_t __attribute__((ext_vector_type(32)));
    const v32f_t d = __builtin_amdgcn_cvt_scalef32_pk32_f32_fp6((v6u_t){r[0], r[1], r[2], 0u, 0u, 0u}, 1.0f);
#pragma unroll
    for (int i = 0; i < 16; ++i) f[i] = d[i]; }
__device__ __forceinline__ void dec32(const v3u32_t& a, const v3u32_t& b, float (&f)[32]) { typedef unsigned v6u_t __attribute__((ext_vector_type(6))); typedef float v32f_t __attribute__((ext_vector_type(32)));
    const v32f_t d = __builtin_amdgcn_cvt_scalef32_pk32_f32_fp6((v6u_t){a[0], a[1], a[2], b[0], b[1], b[2]}, 1.0f);
#pragma unroll
    for (int i = 0; i < 32; ++i) f[i] = d[i]; }
#define ldrow(r, vo, so, OFF) ldrow_<OFF>(r, vo, so)
__device__ __forceinline__ void peer_A(const bf16_t* QP, const bf16_t* KEYB, const int t0, int* IDX, float* GW, const int hsel) {
    int tix_ = threadIdx.x; asm volatile("" : "+v"(tix_));
    const int lane = tix_ & 63, q = lane & 15, g = lane >> 4;
    {
        const int h = hsel; int qo = q, lo_ = lane; asm volatile("" : "+v"(qo), "+v"(lo_));
        int tk0[4], tk1[4];
#pragma unroll
        for (int p = 0; p < 2; ++p) {
            bf16x8 aq[4];
#pragma unroll
            for (int ks = 0; ks < 4; ++ks) aq[ks] = *(const bf16x8*)(QP + (size_t)(t0 + qo) * 2048 + h * 256 + p * 128 + ks * 32 + g * 8);
            f32x4 sc[8];
#pragma unroll
            for (int grp = 0; grp < 2; ++grp) {
                bf16x8 kb[4][4];
#pragma unroll
                for (int n4 = 0; n4 < 4; ++n4) {
                    const bf16_t* kp = KEYB + ((size_t)((h * 2 + p) * PNK + (grp * 4 + n4) * 16 + qo)) * PDH + g * 8;
#pragma unroll
                    for (int ks = 0; ks < 4; ++ks) kb[n4][ks] = *(const bf16x8*)(kp + ks * 32);
                }
                __builtin_amdgcn_sched_barrier(0);
#pragma unroll
                for (int n4 = 0; n4 < 4; ++n4) {
                    f32x4 acc = (f32x4){0.f, 0.f, 0.f, 0.f};
#pragma unroll
                    for (int ks = 0; ks < 4; ++ks) acc = __builtin_amdgcn_mfma_f32_16x16x32_bf16(aq[ks], kb[n4][ks], acc, 0, 0, 0);
                    sc[grp * 4 + n4] = acc;
                }
                __builtin_amdgcn_sched_barrier(0);
            }
            int key[4][8], mine[4];
#pragma unroll
            for (int e = 0; e < 4; ++e) { mine[e] = (int)0x80000000;
#pragma unroll
                for (int nt = 0; nt < 8; ++nt) key[e][nt] = (f2key(sc[nt][e]) & ~127) | (127 - (nt * 16 + qo));
#define CSWAP(i, j) { const int hi_ = key[e][i] > key[e][j] ? key[e][i] : key[e][j], lo_2 = key[e][i] > key[e][j] ? key[e][j] : key[e][i]; key[e][i] = hi_; key[e][j] = lo_2; }
                CSWAP(0, 1) CSWAP(2, 3) CSWAP(4, 5) CSWAP(6, 7) CSWAP(0, 2) CSWAP(1, 3) CSWAP(4, 6) CSWAP(5, 7) CSWAP(1, 2) CSWAP(5, 6)
                CSWAP(0, 4) CSWAP(1, 5) CSWAP(2, 6) CSWAP(3, 7) CSWAP(2, 4) CSWAP(3, 5) CSWAP(1, 2) CSWAP(3, 4) CSWAP(5, 6)
#undef CSWAP
            }
#pragma unroll 1
            for (int k = 0; k < PTOPK; ++k) {
                int m[4];
#pragma unroll
                for (int e = 0; e < 4; ++e) m[e] = key[e][0];
#pragma unroll
                for (int e = 0; e < 4; ++e) { const int o = dpp_i<0x121>(m[e]); m[e] = m[e] > o ? m[e] : o; }
#pragma unroll
                for (int e = 0; e < 4; ++e) { const int o = dpp_i<0x122>(m[e]); m[e] = m[e] > o ? m[e] : o; }
#pragma unroll
                for (int e = 0; e < 4; ++e) { const int o = dpp_i<0x124>(m[e]); m[e] = m[e] > o ? m[e] : o; }
#pragma unroll
                for (int e = 0; e < 4; ++e) { const int o = dpp_i<0x128>(m[e]); m[e] = m[e] > o ? m[e] : o; }
#pragma unroll
                for (int e = 0; e < 4; ++e) {
                    const bool win = key[e][0] == m[e];
#pragma unroll
                    for (int nt = 0; nt < 7; ++nt) key[e][nt] = win ? key[e][nt + 1] : key[e][nt];
                    key[e][7] = win ? (int)0x80000000 : key[e][7];
                    mine[e] = qo == k ? m[e] : mine[e];
                }
            }
#pragma unroll
            for (int e = 0; e < 4; ++e) { if (p == 0) tk0[e] = mine[e]; else tk1[e] = mine[e]; }
        }
        {
            float av[4], bself[4], bv[4]; int ptr[4], mine[4];
#pragma unroll
            for (int e = 0; e < 4; ++e) { av[e] = key2f(tk0[e] & ~127); bself[e] = key2f(tk1[e] & ~127); ptr[e] = 0; bv[e] = __shfl(bself[e], (lo_ & 48)); mine[e] = (int)0x80000000; }
#pragma unroll 1
            for (int k = 0; k < PTOPK; ++k) {
                int ck[4], m[4];
#pragma unroll
                for (int e = 0; e < 4; ++e) { ck[e] = ptr[e] < 16 ? ((f2key(av[e] + bv[e]) & ~255) | (255 - (qo * 16 + ptr[e]))) : (int)0x80000000; m[e] = ck[e]; }
#pragma unroll
                for (int e = 0; e < 4; ++e) { const int o = dpp_i<0x121>(m[e]); m[e] = m[e] > o ? m[e] : o; }
#pragma unroll
                for (int e = 0; e < 4; ++e) { const int o = dpp_i<0x122>(m[e]); m[e] = m[e] > o ? m[e] : o; }
#pragma unroll
                for (int e = 0; e < 4; ++e) { const int o = dpp_i<0x124>(m[e]); m[e] = m[e] > o ? m[e] : o; }
#pragma unroll
                for (int e = 0; e < 4; ++e) { const int o = dpp_i<0x128>(m[e]); m[e] = m[e] > o ? m[e] : o; }
#pragma unroll
                for (int e = 0; e < 4; ++e) { mine[e] = qo == k ? m[e] : mine[e]; if (ck[e] == m[e]) ++ptr[e]; }
#pragma unroll
                for (int e = 0; e < 4; ++e) bv[e] = __shfl(bself[e], (lo_ & 48) + (ptr[e] & 15));
            }
#pragma unroll
            for (int e = 0; e < 4; ++e) {
                const int code = 255 - (mine[e] & 255), wi = code >> 4, wj = code & 15;
                const int ka = __shfl(tk0[e], (lo_ & 48) + wi), kb = __shfl(tk1[e], (lo_ & 48) + wj);
                const int expert = (127 - (ka & 127)) * PNK + (127 - (kb & 127));
                const float bs = key2f(mine[e] & ~255);
                const float mxv = key2f(row_allmax_i(mine[e]) & ~255);
                const float ex = __expf(bs - mxv);
                const float gsm = ex / row_allsum_f(ex);
                IDX[(4 * g + e) * 128 + h * 16 + qo] = expert; GW[(4 * g + e) * 128 + h * 16 + qo] = gsm;
            }
        }
    }
}
typedef int v8i32_t __attribute__((ext_vector_type(8)));
typedef int i32x4_t __attribute__((ext_vector_type(4)));
typedef unsigned u32x2_t __attribute__((ext_vector_type(2)));
#define PEER_UPITCH 528
#define PEER_LDS_HL 32768
#define PEER_LDS_U 49152
struct PeerNext { float uscl, vsc, sue, gw; };
__device__ __forceinline__ void peer_issue(const unsigned char* UB, const __amdgpu_buffer_rsrc_t vsrd, const float* USC, const float* VSC, const float* subn, const int* ipn, const float* gwn,
                                           LAS unsigned char* UL, const int voffb, const int myj, v2u32_t (&ry)[16], PeerNext& nx) {
    int ex[16];
#pragma unroll
    for (int j = 0; j < 16; ++j) ex[j] = __builtin_amdgcn_readfirstlane(ipn[j]);
    const int mye = ipn[myj];
    nx.gw = gwn[myj];
    __builtin_amdgcn_sched_barrier(0);
    if (voffb < 32 * 12) {
        const int vo16 = (voffb / 12) * 16;
#pragma unroll
        for (int j = 0; j < 16; ++j) __builtin_amdgcn_global_load_lds((const unsigned*)(UB + (size_t)ex[j] * PROWV + vo16), (LAS unsigned*)(UL + j * PEER_UPITCH), 16, 0, 0);
    }
#pragma unroll
    for (int j = 0; j < 16; ++j) ry[j] = __builtin_amdgcn_raw_buffer_load_b64(vsrd, (voffb / 12) * 8, ex[j] * PROWV, 0);
    nx.uscl = USC[mye]; nx.vsc = VSC[mye]; nx.sue = subn[mye];
    __builtin_amdgcn_sched_barrier(0);
}
__device__ __forceinline__ float peer_udots(const LAS unsigned char* UL, const v8i32_t hbv, const int scb, const int cb, const int gb, const int myj) {
    asm volatile("s_waitcnt vmcnt(0)" ::: "memory");
    __builtin_amdgcn_sched_barrier(0);
    f32x4 acc[8];
    const LAS unsigned char* ua = UL + cb * PEER_UPITCH + 16 * gb;
#pragma unroll
    for (int s8 = 0; s8 < 8; ++s8) {
        const i32x4_t a0 = *(const LAS i32x4_t*)(ua + 64 * s8);
        const v8i32_t av = (v8i32_t){a0[0], a0[1], a0[2], a0[3], 0, 0, 0, 0};
        acc[s8] = __builtin_amdgcn_mfma_scale_f32_16x16x128_f8f6f4(av, hbv, (f32x4){0.f, 0.f, 0.f, 0.f}, 4, 0, 0, 0x7F7F7F7F, 0, scb);
    }
    float tsum[4];
    const int cs = cb & 7;
#pragma unroll
    for (int i = 0; i < 4; ++i) {
        const float s01 = (cs & 1) ? acc[1][i] : acc[0][i], s23 = (cs & 1) ? acc[3][i] : acc[2][i], s45 = (cs & 1) ? acc[5][i] : acc[4][i], s67 = (cs & 1) ? acc[7][i] : acc[6][i];
        const float s03 = (cs & 2) ? s23 : s01, s47 = (cs & 2) ? s67 : s45;
        tsum[i] = row_allsum_f((cs & 4) ? s47 : s03);
    }
    return (myj & 2) ? ((myj & 1) ? tsum[3] : tsum[2]) : ((myj & 1) ? tsum[1] : tsum[0]);
}
__device__ __forceinline__ void peer_vacc(const v2u32_t (&ry)[16], const float cf, f32x2_t (&oo)[8]) {
#pragma unroll
    for (int j = 0; j < 16; j += 2) {
        const float c = __int_as_float(__builtin_amdgcn_readlane(__float_as_int(cf), 4 * j)), c2 = __int_as_float(__builtin_amdgcn_readlane(__float_as_int(cf), 4 * j + 4));
        const f32x2_t cc = (f32x2_t){c, c}, cc2 = (f32x2_t){c2, c2};
#define PEER_V4(q, w, sel) { const f32x2_t fa = __builtin_amdgcn_cvt_scalef32_pk_f32_fp4(ry[j][w], 1.0f, sel), fb = __builtin_amdgcn_cvt_scalef32_pk_f32_fp4(ry[j + 1][w], 1.0f, sel); \
            oo[q] = __builtin_elementwise_fma(cc, fa, oo[q]); oo[q] = __builtin_elementwise_fma(cc2, fb, oo[q]); }
        PEER_V4(0, 0, 0) PEER_V4(1, 0, 1) PEER_V4(2, 0, 2) PEER_V4(3, 0, 3) PEER_V4(4, 1, 0) PEER_V4(5, 1, 1) PEER_V4(6, 1, 2) PEER_V4(7, 1, 3)
#undef PEER_V4
        asm volatile("" : "+v"(oo[0]), "+v"(oo[1]), "+v"(oo[2]), "+v"(oo[3]), "+v"(oo[4]), "+v"(oo[5]), "+v"(oo[6]), "+v"(oo[7]));
        __builtin_amdgcn_sched_barrier(0);
    }
}
__device__ __forceinline__ void peer_B(const bf16_t* H2, const unsigned char* UB, const unsigned char* VB, const float* USC, const float* VSC, const float* PSS, const float* SU, const float* mod, const bf16_t* X1B, float* out, const int t0, const int* IDX, const float* GW, LAS unsigned char* ldsl, const float* n2g, const int tpw) {
    int tix_ = threadIdx.x; asm volatile("" : "+v"(tix_));
    const int wave = __builtin_amdgcn_readfirstlane(tix_ >> 6), lane = tix_ & 63;
    const __amdgpu_buffer_rsrc_t vsrd = __builtin_amdgcn_make_buffer_rsrc((void*)VB, 0, PNK * PNK * PROWV, 0x00020000);
    LAS unsigned char* HL = ldsl + PEER_LDS_HL + wave * 2048;
    LAS unsigned char* UL = ldsl + PEER_LDS_U + wave * (16 * PEER_UPITCH);
    int lb_ = lane; asm volatile("" : "+v"(lb_)); const int voffb = lb_ * 12;
    const int cb = lb_ & 15, gb = lb_ >> 4, myj = (lb_ >> 2) & 15;
    v2u32_t ry0[16], ry1[16]; PeerNext n0, n1;
    peer_issue(UB, vsrd, USC, VSC, SU + (t0 + tpw * wave >= SEQ ? PNK * PNK : 0), IDX + tpw * wave * 128, GW + tpw * wave * 128, UL, voffb, myj, ry0, n0);
    f32x4 g2v[4];
    { const float* g2 = mod + (t0 >= SEQ ? 6144 : 0) + 5 * 1024;
#pragma unroll
      for (int v4 = 0; v4 < 4; ++v4) g2v[v4] = *(const f32x4*)(g2 + 16 * lb_ + 4 * v4); }
    const float* sc2 = mod + (t0 >= SEQ ? 6144 : 0) + 4 * 1024;
#pragma unroll 1
    for (int tk = 0; tk < tpw; ++tk) {
        const int tl = tpw * wave + tk, t = t0 + tl;
        const float rstd = 1.f / sqrtf(row_allsum_f(PSS[(size_t)t * 16 + (lb_ & 15)]) * (1.f / DM) + EPS);
        v8i32_t hbv;
        { const uint4 ha = *(const uint4*)(X1B + (size_t)t * DM + 16 * lb_), hc = *(const uint4*)(X1B + (size_t)t * DM + 16 * lb_ + 8);
          const unsigned hw[8] = {ha.x, ha.y, ha.z, ha.w, hc.x, hc.y, hc.z, hc.w};
          int hi[4], lo[4];
#pragma unroll
          for (int q4 = 0; q4 < 4; ++q4) {
              float v[4];
              v[0] = __uint_as_float(hw[2 * q4] << 16); v[1] = __uint_as_float(hw[2 * q4] & 0xffff0000u); v[2] = __uint_as_float(hw[2 * q4 + 1] << 16); v[3] = __uint_as_float(hw[2 * q4 + 1] & 0xffff0000u);
              const f32x4 svq = *(const f32x4*)(n2g + 16 * lb_ + 4 * q4) * (*(const f32x4*)(sc2 + 16 * lb_ + 4 * q4) + 1.f);
#pragma unroll
              for (int i = 0; i < 4; ++i) v[i] = fminf(fmaxf(v[i] * svq[i], -448.f), 448.f);
              int w = 0;
              w = __builtin_amdgcn_cvt_pk_fp8_f32(v[0], v[1], w, false); w = __builtin_amdgcn_cvt_pk_fp8_f32(v[2], v[3], w, true);
              const f32x2_t r01 = __builtin_amdgcn_cvt_pk_f32_fp8(w, false), r23 = __builtin_amdgcn_cvt_pk_f32_fp8(w, true);
              int x = 0;
              x = __builtin_amdgcn_cvt_pk_fp8_f32((v[0] - r01[0]) * 16.f, (v[1] - r01[1]) * 16.f, x, false); x = __builtin_amdgcn_cvt_pk_fp8_f32((v[2] - r23[0]) * 16.f, (v[3] - r23[1]) * 16.f, x, true);
              hi[q4] = w; lo[q4] = x;
          }
          *(LAS i32x4_t*)(HL + 16 * lb_) = (i32x4_t){hi[0], hi[1], hi[2], hi[3]};
          *(LAS i32x4_t*)(HL + 1024 + 16 * lb_) = (i32x4_t){lo[0], lo[1], lo[2], lo[3]};
          __builtin_amdgcn_fence(__ATOMIC_RELEASE, "wavefront"); __builtin_amdgcn_wave_barrier(); __builtin_amdgcn_fence(__ATOMIC_ACQUIRE, "wavefront");
          const LAS unsigned char* src = HL + (cb & 8) * 128 + (cb & 7) * 128 + 16 * gb;
          const i32x4_t p0 = *(const LAS i32x4_t*)(src), p1 = *(const LAS i32x4_t*)(src + 64);
          hbv = (v8i32_t){p0.x, p0.y, p0.z, p0.w, p1.x, p1.y, p1.z, p1.w};
          __builtin_amdgcn_fence(__ATOMIC_RELEASE, "wavefront"); __builtin_amdgcn_wave_barrier();
        }
        const int scb = cb >= 8 ? 0x7B7B7B7B : 0x7F7F7F7F;
        f32x2_t oo[8];
#pragma unroll
        for (int j = 0; j < 8; ++j) oo[j] = (f32x2_t){0.f, 0.f};
#pragma unroll 1
        for (int b2 = 0; b2 < 4; ++b2) {
            {
              const float d1 = peer_udots(UL, hbv, scb, cb, gb, myj);
              const int ni = tl * 128 + (2 * b2 + 1) * 16;
              peer_issue(UB, vsrd, USC, VSC, SU + (t >= SEQ ? PNK * PNK : 0), IDX + ni, GW + ni, UL, voffb, myj, ry1, n1);
              const float cf = n0.gw * gelu_erf(d1 * (n0.uscl * rstd) + n0.sue) * n0.vsc;
              peer_vacc(ry0, cf, oo); }
            {
              const float d1 = peer_udots(UL, hbv, scb, cb, gb, myj);
              if (!(tk == tpw - 1 && b2 == 3)) {
                  const int ni = tl * 128 + (2 * b2 + 2) * 16, tn = t0 + (ni >> 7);
                  peer_issue(UB, vsrd, USC, VSC, SU + (tn >= SEQ ? PNK * PNK : 0), IDX + ni, GW + ni, UL, voffb, myj, ry0, n0);
              }
              const float cf = n1.gw * gelu_erf(d1 * (n1.uscl * rstd) + n1.sue) * n1.vsc;
              peer_vacc(ry1, cf, oo); }
        }
        float* orow = out + (size_t)t * DM;
        const uint4 xa = *(const uint4*)(X1B + (size_t)t * DM + 16 * lb_), xb = *(const uint4*)(X1B + (size_t)t * DM + 16 * lb_ + 8);
        const unsigned xw[8] = {xa.x, xa.y, xa.z, xa.w, xb.x, xb.y, xb.z, xb.w};
#pragma unroll
        for (int v4 = 0; v4 < 4; ++v4) {
            const int c0 = 16 * lb_ + 4 * v4;
            const f32x4 gv = g2v[v4];
            const f32x4 xv = (f32x4){__uint_as_float(xw[2 * v4] << 16), __uint_as_float(xw[2 * v4] & 0xffff0000u), __uint_as_float(xw[2 * v4 + 1] << 16), __uint_as_float(xw[2 * v4 + 1] & 0xffff0000u)};
            f32x4 ov;
#pragma unroll
            for (int j = 0; j < 4; ++j) ov[j] = xv[j] + gv[j] * oo[2 * v4 + (j >> 1)][j & 1];
            *(f32x4*)(orow + c0) = ov;
        }
    }
}
__device__ __forceinline__ void ph_peer2(const bf16_t* QP, const bf16_t* H2, const bf16_t* KEYB, const unsigned char* UB, const unsigned char* VB, const float* USC, const float* VSC, const float* PSS, const float* SU, const float* mod, const bf16_t* X1B, float* out, LAS unsigned char* ldsl, const float* n2g) {
    const int nit = (T / 16 - (int)blockIdx.x + (int)gridDim.x - 1) / (int)gridDim.x;
    int* IDXb = (int*)(unsigned char*)ldsl;
    float* GWb = (float*)((unsigned char*)ldsl + 16384);
    int tix_ = threadIdx.x; asm volatile("" : "+v"(tix_));
    const int wave = __builtin_amdgcn_readfirstlane(tix_ >> 6);
    if (nit > 0) peer_A(QP, KEYB, (int)blockIdx.x * 16, IDXb, GWb, wave);
    __syncthreads();
#pragma unroll 1
    for (int s = 0; s < nit; ++s) {
        const bool last = s + 1 == nit;
        if (wave < 4 || last) { __builtin_amdgcn_s_setprio(3);
            peer_B(H2, UB, VB, USC, VSC, PSS, SU, mod, X1B, out, ((int)blockIdx.x + s * (int)gridDim.x) * 16, IDXb + (s & 1) * 2048, GWb + (s & 1) * 2048, ldsl, n2g, last ? 2 : 4);
            __builtin_amdgcn_s_setprio(0); }
        else {
#pragma unroll 1
            for (int hh = 0; hh < 2; ++hh) peer_A(QP, KEYB, ((int)blockIdx.x + (s + 1) * (int)gridDim.x) * 16, IDXb + ((s + 1) & 1) * 2048, GWb + ((s + 1) & 1) * 2048, (wave - 4) + 4 * hh);
        }
        __syncthreads();
    }
}

__device__ __forceinline__ void ph_peer(const bf16_t* QP, const bf16_t* H2, const float* keys, const float* pu, const float* pv, const float* mod, float* out, float* lds) {
    int tix_ = threadIdx.x; asm volatile("" : "+v"(tix_));
    float* qsa = lds;
    float* part = lds + 2048;
    const int h = tix_ >> 6, lane = tix_ & 63;
    float* qs = qsa + h * 256;
    for (int t = blockIdx.x; t < T; t += gridDim.x) {
        const int b = t / SEQ;
        for (int i = lane; i < 256; i += 64) qs[i] = bf2f(QP[(size_t)t * 2048 + h * 256 + i]);
        __builtin_amdgcn_s_waitcnt(0);
        float s00 = 0.f, s01 = 0.f, s10 = 0.f, s11 = 0.f;
        {
            const float* k00 = keys + ((size_t)(h * 2 + 0) * PNK + lane) * PDH; const float* k01 = k00 + 64 * PDH;
            const float* k10 = keys + ((size_t)(h * 2 + 1) * PNK + lane) * PDH; const float* k11 = k10 + 64 * PDH;
#pragma unroll 2
            for (int d4 = 0; d4 < 32; ++d4) {
                const f32x4 a = *(const f32x4*)(k00 + 4 * d4), bq = *(const f32x4*)(k01 + 4 * d4), cq = *(const f32x4*)(k10 + 4 * d4), dq = *(const f32x4*)(k11 + 4 * d4);
                const float q0 = qs[4 * d4], q1 = qs[4 * d4 + 1], q2 = qs[4 * d4 + 2], q3 = qs[4 * d4 + 3];
                const float r0 = qs[128 + 4 * d4], r1 = qs[128 + 4 * d4 + 1], r2 = qs[128 + 4 * d4 + 2], r3 = qs[128 + 4 * d4 + 3];
                s00 += a.x * q0 + a.y * q1 + a.z * q2 + a.w * q3; s01 += bq.x * q0 + bq.y * q1 + bq.z * q2 + bq.w * q3;
                s10 += cq.x * r0 + cq.y * r1 + cq.z * r2 + cq.w * r3; s11 += dq.x * r0 + dq.y * r1 + dq.z * r2 + dq.w * r3;
            }
        }
        float a0s = 0.f, a1s = 0.f; int a0i = 0, a1i = 0;
        for (int k = 0; k < PTOPK; ++k) {
            float v = s00 >= s01 ? s00 : s01; int idx = s00 >= s01 ? lane : lane + 64;
            wave_argmax(v, idx);
            if (lane == (idx & 63)) { if (idx < 64) s00 = -INFINITY; else s01 = -INFINITY; }
            if (lane == k) { a0s = v; a0i = idx; }
        }
        for (int k = 0; k < PTOPK; ++k) {
            float v = s10 >= s11 ? s10 : s11; int idx = s10 >= s11 ? lane : lane + 64;
            wave_argmax(v, idx);
            if (lane == (idx & 63)) { if (idx < 64) s10 = -INFINITY; else s11 = -INFINITY; }
            if (lane == k) { a1s = v; a1i = idx; }
        }
        float c0, c1, c2, c3;
        { const float ai = __shfl(a0s, lane >> 2); const int jb = (lane & 3) * 4;
          c0 = ai + __shfl(a1s, jb); c1 = ai + __shfl(a1s, jb + 1); c2 = ai + __shfl(a1s, jb + 2); c3 = ai + __shfl(a1s, jb + 3); }
        float bs = -INFINITY; int bc = 0;
        for (int k = 0; k < PTOPK; ++k) {
            float v = c0; int idx = lane * 4;
            if (c1 > v) { v = c1; idx = lane * 4 + 1; }
            if (c2 > v) { v = c2; idx = lane * 4 + 2; }
            if (c3 > v) { v = c3; idx = lane * 4 + 3; }
            wave_argmax(v, idx);
            if (lane == (idx >> 2)) { const int e = idx & 3; if (e == 0) c0 = -INFINITY; else if (e == 1) c1 = -INFINITY; else if (e == 2) c2 = -INFINITY; else c3 = -INFINITY; }
            if (lane == k) { bs = v; bc = idx; }
        }
        const int ei = __shfl(a0i, bc >> 4) * PNK + __shfl(a1i, bc & 15);
        const float mx = wave_max(bs);
        const float ex = lane < PTOPK ? expf(bs - mx) : 0.f;
        const float g = ex / wave_sum(ex);
        f32x4 hx[4], oacc[4];
#pragma unroll
        for (int j = 0; j < 4; ++j) { const ushort4 hv = *(const ushort4*)(H2 + (size_t)t * DM + 4 * lane + 256 * j); hx[j] = (f32x4){bf2f(hv.x), bf2f(hv.y), bf2f(hv.z), bf2f(hv.w)}; oacc[j] = (f32x4){0.f, 0.f, 0.f, 0.f}; }
#pragma unroll 1
        for (int k = 0; k < PTOPK; ++k) {
            const int e = __builtin_amdgcn_readfirstlane(__shfl(ei, k)); const float gk = __shfl(g, k);
            const f32x4* ur = (const f32x4*)(pu + (size_t)e * DM) + lane; const f32x4* vr = (const f32x4*)(pv + (size_t)e * DM) + lane;
            float dsum = 0.f;
#pragma unroll
            for (int j = 0; j < 4; ++j) { const f32x4 uv = ur[64 * j]; dsum += uv.x * hx[j].x + uv.y * hx[j].y + uv.z * hx[j].z + uv.w * hx[j].w; }
            dsum = wave_sum(dsum);
            const float act = 0.5f * dsum * (1.f + erff(dsum * 0.7071067811865476f));
            const float cf = gk * act;
#pragma unroll
            for (int j = 0; j < 4; ++j) { const f32x4 vv = vr[64 * j]; oacc[j] += vv * cf; }
        }
#pragma unroll
        for (int j = 0; j < 4; ++j) *(f32x4*)(&part[h * 1024 + 4 * lane + 256 * j]) = oacc[j];
        __syncthreads();
        for (int cc = tix_; cc < DM; cc += NTHR) {
            float s = 0.f;
#pragma unroll
            for (int w = 0; w < 8; ++w) s += part[w * 1024 + cc];
            out[(size_t)t * DM + cc] += mod[b * 6144 + 5 * 1024 + cc] * s;
        }
        __syncthreads();
    }
}


namespace pg8 {
__device__ __forceinline__ u32x4 pack8(const f32x4& a, const f32x4& b) { u32x4 w; w.x = cvt_pk_bf16(a[0], a[1]); w.y = cvt_pk_bf16(a[2], a[3]); w.z = cvt_pk_bf16(b[0], b[1]); w.w = cvt_pk_bf16(b[2], b[3]); return w; }
__device__ __forceinline__ float bflo(unsigned u) { return __builtin_bit_cast(float, u << 16); }
__device__ __forceinline__ float bfhi(unsigned u) { return __builtin_bit_cast(float, u & 0xffff0000u); }
__device__ __forceinline__ float sigm(float x) { return 1.f / (1.f + __expf(-x)); }
struct EpiZT {
    static constexpr bool PERM = true, AFTER_DRAIN = false, MID = false, FP8 = false;
    bf16_t* ZT; const float* b_in; bf16_t* VT;
    __device__ __forceinline__ void operator()(const f32x4 (&acc)[2][2][4][2], const Unit& u, int wr, int wc, int fr, int fq) const {
        const int row0 = u.pm * BM + wr * 64 + fr, col0 = u.pn * BM + wc * 32 + 8 * fq;
#pragma unroll
        for (int ai = 0; ai < 2; ++ai)
#pragma unroll
            for (int m = 0; m < 4; ++m) { const int r = row0 + ai * HALF + m * 16; const float bias = b_in[r < 1536 ? r : r + 1024]; bf16_t* rowp = (r < 1536 ? ZT + (size_t)r * T : VT + (size_t)(r - 1536) * VPITCH) + col0;
#pragma unroll
                for (int bj = 0; bj < 2; ++bj) { const f32x4 v0 = acc[ai][bj][m][0] + bias, v1 = acc[ai][bj][m][1] + bias; *(u32x4*)(rowp + bj * HALF) = pack8(v0, v1); } }
    }
};
struct EpiZT8 {
    static constexpr bool PERM = true, AFTER_DRAIN = false, MID = false, FP8 = true;
    bf16_t* ZT; const float* b_in; bf16_t* VT;
    __device__ __forceinline__ void operator()(const f32x4 (&acc)[2][2][4][2], const Unit& u, int wr, int wc, int fr, int fq) const {
        asm volatile("" : "+v"(fr), "+v"(fq));
        const int row0 = u.pm * BM + wr * 64 + fr, col0 = u.pn * BM + wc * 32 + 8 * fq;
#pragma unroll
        for (int ai = 0; ai < 2; ++ai)
#pragma unroll
            for (int m = 0; m < 4; ++m) { const int r = row0 + ai * HALF + m * 16; const float bias = b_in[r < 1536 ? r : r + 1024]; bf16_t* rowp = (r < 1536 ? ZT + (size_t)r * T : VT + (size_t)(r - 1536) * VPITCH) + col0;
#pragma unroll
                for (int bj = 0; bj < 2; ++bj) { const f32x4 v0 = acc[ai][bj][m][0] * (1.f / 64.f) + bias, v1 = acc[ai][bj][m][1] * (1.f / 64.f) + bias; *(u32x4*)(rowp + bj * HALF) = pack8(v0, v1); } }
    }
};
struct EpiZN {
    static constexpr bool PERM = true, AFTER_DRAIN = false, MID = false, FP8 = false;
    bf16_t* ZN; const float* b_in;
    __device__ __forceinline__ void operator()(const f32x4 (&acc)[2][2][4][2], const Unit& u, int wr, int wc, int fr, int fq) const {
        const int row0 = u.pm * BM + wr * 64 + fr, col0 = u.pn * BM + wc * 32 + 8 * fq; const bool gate = col0 >= 1024;
        const int lc0 = gate ? col0 + 2048 : col0 + 1536;
        f32x4 bv[2][2];
#pragma unroll
        for (int bj = 0; bj < 2; ++bj)
#pragma unroll
            for (int n = 0; n < 2; ++n) bv[bj][n] = *(const f32x4*)(b_in + lc0 + bj * HALF + 4 * n);
#pragma unroll
        for (int ai = 0; ai < 2; ++ai)
#pragma unroll
            for (int m = 0; m < 4; ++m) { bf16_t* rowp = ZN + (size_t)(row0 + ai * HALF + m * 16) * 3072 + col0;
#pragma unroll
                for (int bj = 0; bj < 2; ++bj) { f32x4 v0 = acc[ai][bj][m][0] + bv[bj][0], v1 = acc[ai][bj][m][1] + bv[bj][1];
                    if (gate) { v0 = (f32x4){sigm(v0[0]), sigm(v0[1]), sigm(v0[2]), sigm(v0[3])}; v1 = (f32x4){sigm(v1[0]), sigm(v1[1]), sigm(v1[2]), sigm(v1[3])}; }
                    *(u32x4*)(rowp + bj * HALF) = pack8(v0, v1); } }
    }
};

struct EpiQK {
    static constexpr bool PERM = false, AFTER_DRAIN = false, MID = false, FP8 = false;
    bf16_t* ZN; const float* b_in; const float* qg; const float* kg; const float* rope;
    __device__ __forceinline__ void operator()(const f32x4 (&acc)[2][2][4][2], const Unit& u, int wr, int wc, int fr, int fq) const {
        const float* gn = u.pn >= 2 ? kg : qg; const int lcol0 = u.pn * BM + 64 * wc;
        f32x4 bv[2][2], gv[2][2];
#pragma unroll
        for (int bj = 0; bj < 2; ++bj)
#pragma unroll
            for (int n = 0; n < 2; ++n) { bv[bj][n] = *(const f32x4*)(b_in + 1536 + lcol0 + 32 * bj + 16 * n + 4 * fq); gv[bj][n] = *(const f32x4*)(gn + 32 * bj + 16 * n + 4 * fq); }
#pragma unroll
        for (int ai = 0; ai < 2; ++ai) {
            f32x4 rt[4][2][2];
#pragma unroll
            for (int m = 0; m < 4; ++m) { const int pos = (u.pm * BM + ai * HALF + wr * 64 + m * 16 + fr) & (SEQ - 1);
#pragma unroll
                for (int bj = 0; bj < 2; ++bj) { const float* rp = rope + ((bj == 0 ? (pos >> 6) : (pos & 63)) * 16 + 4 * fq) * 2; rt[m][bj][0] = *(const f32x4*)rp; rt[m][bj][1] = *(const f32x4*)(rp + 4); } }
            __builtin_amdgcn_sched_barrier(0);
#pragma unroll
            for (int m = 0; m < 4; ++m) {
                const int r = u.pm * BM + ai * HALF + wr * 64 + m * 16 + fr;
                f32x4 v[2][2]; float ss = 0.f;
#pragma unroll
                for (int bj = 0; bj < 2; ++bj)
#pragma unroll
                    for (int n = 0; n < 2; ++n) { v[bj][n] = acc[ai][bj][m][n] + bv[bj][n]; ss += (v[bj][n][0] * v[bj][n][0] + v[bj][n][1] * v[bj][n][1]) + (v[bj][n][2] * v[bj][n][2] + v[bj][n][3] * v[bj][n][3]); }
                ss += __shfl_xor(ss, 16); ss += __shfl_xor(ss, 32);
                const float rstd = 1.f / sqrtf(ss * (1.f / 64.f) + EPS);
                bf16_t* rowp = ZN + (size_t)r * 3072 + lcol0 + 4 * fq;
#pragma unroll
                for (int bj = 0; bj < 2; ++bj) {
                    const f32x4 cs01 = rt[m][bj][0], cs23 = rt[m][bj][1];
                    const f32x4 a = v[bj][0] * rstd * gv[bj][0], bb = v[bj][1] * rstd * gv[bj][1];
                    const f32x4 cc = (f32x4){cs01[0], cs01[2], cs23[0], cs23[2]}, sn = (f32x4){cs01[1], cs01[3], cs23[1], cs23[3]};
                    const f32x4 ra = a * cc - bb * sn, rb = a * sn + bb * cc;
                    uint2 w0, w1; w0.x = cvt_pk_bf16(ra[0], ra[1]); w0.y = cvt_pk_bf16(ra[2], ra[3]); w1.x = cvt_pk_bf16(rb[0], rb[1]); w1.y = cvt_pk_bf16(rb[2], rb[3]);
                    *(uint2*)(rowp + 32 * bj) = w0; *(uint2*)(rowp + 32 * bj + 16) = w1;
                }
            }
            __builtin_amdgcn_sched_barrier(0);
        }
    }
};
struct EpiQK8 {
    static constexpr bool PERM = false, AFTER_DRAIN = false, MID = false, FP8 = true;
    bf16_t* ZN; const float* b_in; const float* qg; const float* kg; const float* rope;
    __device__ __forceinline__ void operator()(const f32x4 (&acc)[2][2][4][2], const Unit& u, int wr, int wc, int fr, int fq) const {
        asm volatile("" : "+v"(fr), "+v"(fq));
        const float* gn = u.pn >= 2 ? kg : qg; const int lcol0 = u.pn * BM + 64 * wc;
        f32x4 bv[2][2], gv[2][2];
#pragma unroll
        for (int bj = 0; bj < 2; ++bj)
#pragma unroll
            for (int n = 0; n < 2; ++n) { bv[bj][n] = *(const f32x4*)(b_in + 1536 + lcol0 + 32 * bj + 16 * n + 4 * fq); gv[bj][n] = *(const f32x4*)(gn + 32 * bj + 16 * n + 4 * fq); }
#pragma unroll
        for (int ai = 0; ai < 2; ++ai)
#pragma unroll
        for (int mp = 0; mp < 2; ++mp) {
            f32x4 rt[4][2][2];
#pragma unroll
            for (int m = 2 * mp; m < 2 * mp + 2; ++m) { const int pos = (u.pm * BM + ai * HALF + wr * 64 + m * 16 + fr) & (SEQ - 1);
#pragma unroll
                for (int bj = 0; bj < 2; ++bj) { const float* rp = rope + ((bj == 0 ? (pos >> 6) : (pos & 63)) * 16 + 4 * fq) * 2; rt[m][bj][0] = *(const f32x4*)rp; rt[m][bj][1] = *(const f32x4*)(rp + 4); } }
            __builtin_amdgcn_sched_barrier(0);
#pragma unroll
            for (int m = 2 * mp; m < 2 * mp + 2; ++m) {
                const int r = u.pm * BM + ai * HALF + wr * 64 + m * 16 + fr;
                f32x4 v[2][2]; float ss = 0.f;
#pragma unroll
                for (int bj = 0; bj < 2; ++bj)
#pragma unroll
                    for (int n = 0; n < 2; ++n) { v[bj][n] = acc[ai][bj][m][n] * (1.f / 64.f) + bv[bj][n]; ss += (v[bj][n][0] * v[bj][n][0] + v[bj][n][1] * v[bj][n][1]) + (v[bj][n][2] * v[bj][n][2] + v[bj][n][3] * v[bj][n][3]); }
                { const auto h16 = __builtin_amdgcn_permlane16_swap(__float_as_uint(ss), __float_as_uint(ss), false, false); ss = __uint_as_float(h16[0]) + __uint_as_float(h16[1]);
                  const auto h32 = __builtin_amdgcn_permlane32_swap(__float_as_uint(ss), __float_as_uint(ss), false, false); ss = __uint_as_float(h32[0]) + __uint_as_float(h32[1]); }
                const float rstd = 1.f / sqrtf(ss * (1.f / 64.f) + EPS);
                bf16_t* rowp = ZN + (size_t)r * 3072 + lcol0 + 4 * fq;
#pragma unroll
                for (int bj = 0; bj < 2; ++bj) {
                    const f32x4 cs01 = rt[m][bj][0], cs23 = rt[m][bj][1];
                    const f32x4 a = v[bj][0] * rstd * gv[bj][0], bb = v[bj][1] * rstd * gv[bj][1];
                    const f32x4 cc = (f32x4){cs01[0], cs01[2], cs23[0], cs23[2]}, sn = (f32x4){cs01[1], cs01[3], cs23[1], cs23[3]};
                    const f32x4 ra = a * cc - bb * sn, rb = a * sn + bb * cc;
                    uint2 w0, w1; w0.x = cvt_pk_bf16(ra[0], ra[1]); w0.y = cvt_pk_bf16(ra[2], ra[3]); w1.x = cvt_pk_bf16(rb[0], rb[1]); w1.y = cvt_pk_bf16(rb[2], rb[3]);
                    *(uint2*)(rowp + 32 * bj) = w0; *(uint2*)(rowp + 32 * bj + 16) = w1;
                }
            }
            __builtin_amdgcn_sched_barrier(0);
        }
    }
};
struct EpiGate {
    static constexpr bool PERM = true, AFTER_DRAIN = false, MID = false, FP8 = false;
    bf16_t* ZN; const float* b_in;
    __device__ __forceinline__ void operator()(const f32x4 (&acc)[2][2][4][2], const Unit& u, int wr, int wc, int fr, int fq) const {
        const int row0 = u.pm * BM + wr * 64 + fr, col0 = u.pn * BM + wc * 32 + 8 * fq;
        f32x4 bv[2][2];
#pragma unroll
        for (int bj = 0; bj < 2; ++bj)
#pragma unroll
            for (int n = 0; n < 2; ++n) bv[bj][n] = *(const f32x4*)(b_in + 3072 + col0 + bj * HALF + 4 * n);
#pragma unroll
        for (int ai = 0; ai < 2; ++ai)
#pragma unroll
            for (int m = 0; m < 4; ++m) { bf16_t* rowp = ZN + (size_t)(row0 + ai * HALF + m * 16) * 3072 + 1024 + col0;
#pragma unroll
                for (int bj = 0; bj < 2; ++bj) { f32x4 v0 = acc[ai][bj][m][0] + bv[bj][0], v1 = acc[ai][bj][m][1] + bv[bj][1];
                    v0 = (f32x4){sigm(v0[0]), sigm(v0[1]), sigm(v0[2]), sigm(v0[3])}; v1 = (f32x4){sigm(v1[0]), sigm(v1[1]), sigm(v1[2]), sigm(v1[3])};
                    *(u32x4*)(rowp + bj * HALF) = pack8(v0, v1); } }
    }
};
struct EpiGate8 {
    static constexpr bool PERM = true, AFTER_DRAIN = false, MID = false, FP8 = true;
    bf16_t* ZN; const float* b_in;
    __device__ __forceinline__ void operator()(const f32x4 (&acc)[2][2][4][2], const Unit& u, int wr, int wc, int fr, int fq) const {
        asm volatile("" : "+v"(fr), "+v"(fq));
        const int row0 = u.pm * BM + wr * 64 + fr, col0 = u.pn * 128 + wc * 32 + 8 * fq;
        f32x4 bv[2][2];
#pragma unroll
        for (int bj = 0; bj < 2; ++bj)
#pragma unroll
            for (int n = 0; n < 2; ++n) bv[bj][n] = *(const f32x4*)(b_in + 3072 + bj * 1024 + col0 + 4 * n);
#pragma unroll
        for (int ai = 0; ai < 2; ++ai)
#pragma unroll
            for (int m = 0; m < 4; ++m) { bf16_t* rowp = ZN + (size_t)(row0 + ai * HALF + m * 16) * 3072 + 1024 + col0;
                f32x4 gn[2], rt[2];
#pragma unroll
                for (int n = 0; n < 2; ++n) { const f32x4 a = acc[ai][0][m][n] * (1.f / 64.f) + bv[0][n], b = acc[ai][1][m][n] * (1.f / 64.f) + bv[1][n];
#pragma unroll
                    for (int e = 0; e < 4; ++e) { const float da = 1.f + __expf(-a[e]), db = 1.f + __expf(-b[e]); const float ia = __builtin_amdgcn_rcpf(da); gn[n][e] = __builtin_amdgcn_rcpf(db); rt[n][e] = db * ia; } }
                *(u32x4*)(rowp) = pack8(rt[0], rt[1]); *(u32x4*)(rowp + 1024) = pack8(gn[0], gn[1]); }
    }
};
struct EpiB16 {
    static constexpr bool PERM = true, AFTER_DRAIN = false, MID = false, FP8 = false;
    bf16_t* O; int ldc, pad;
    __device__ __forceinline__ void operator()(const f32x4 (&acc)[2][2][4][2], const Unit& u, int wr, int wc, int fr, int fq) const {
        const int row0 = u.pm * BM + wr * 64 + fr, col0 = u.pn * BM + wc * 32 + 8 * fq;
#pragma unroll
        for (int ai = 0; ai < 2; ++ai)
#pragma unroll
            for (int m = 0; m < 4; ++m) { bf16_t* rowp = O + (size_t)(row0 + ai * HALF + m * 16) * ldc + col0;
#pragma unroll
                for (int bj = 0; bj < 2; ++bj) *(u32x4*)(rowp + bj * HALF) = pack8(acc[ai][bj][m][0], acc[ai][bj][m][1]); }
    }
};
template <bool ADD> struct EpiMg {
    static constexpr bool PERM = true, AFTER_DRAIN = false, MID = false, FP8 = false;
    bf16_t* MG; const bf16_t* ZN; int goff, pad;
    __device__ __forceinline__ void operator()(const f32x4 (&acc)[2][2][4][2], const Unit& u, int wr, int wc, int fr, int fq) const {
        const int row0 = u.pm * BM + wr * 64 + fr, col0 = u.pn * BM + wc * 32 + 8 * fq;
#pragma unroll
        for (int ai = 0; ai < 2; ++ai) {
            u32x4 gt[4][2], og[4][2];
#pragma unroll
            for (int m = 0; m < 4; ++m)
#pragma unroll
                for (int bj = 0; bj < 2; ++bj) { const int r = row0 + ai * HALF + m * 16; gt[m][bj] = *(const u32x4*)(ZN + (size_t)r * 3072 + goff + col0 + bj * HALF);
                    if (ADD) og[m][bj] = *(const u32x4*)(MG + (size_t)r * DM + col0 + bj * HALF); }
            __builtin_amdgcn_sched_barrier(0);
#pragma unroll
            for (int m = 0; m < 4; ++m) { const int r = row0 + ai * HALF + m * 16; bf16_t* rowp = MG + (size_t)r * DM + col0;
#pragma unroll
                for (int bj = 0; bj < 2; ++bj) { const u32x4 g = gt[m][bj];
                    f32x4 v0 = acc[ai][bj][m][0] * (f32x4){bflo(g.x), bfhi(g.x), bflo(g.y), bfhi(g.y)}, v1 = acc[ai][bj][m][1] * (f32x4){bflo(g.z), bfhi(g.z), bflo(g.w), bfhi(g.w)};
                    if (ADD) { const u32x4 o = og[m][bj]; v0 += (f32x4){bflo(o.x), bfhi(o.x), bflo(o.y), bfhi(o.y)}; v1 += (f32x4){bflo(o.z), bfhi(o.z), bflo(o.w), bfhi(o.w)}; }
                    *(u32x4*)(rowp + bj * HALF) = pack8(v0, v1); } }
            __builtin_amdgcn_sched_barrier(0);
        }
    }
};
struct EpiMg2 {
    static constexpr bool PERM = true, AFTER_DRAIN = false, MID = true, FP8 = false;
    bf16_t* MG; const bf16_t* ZN;
    __device__ __forceinline__ void mid(f32x4 (&acc)[2][2][4][2], const Unit& u, int wr, int wc, int fr, int fq) const {
        int fr_ = fr, fq_ = fq; asm volatile("" : "+v"(fr_), "+v"(fq_));
        const int row0 = u.pm * BM + wr * 64 + fr_, col0 = u.pn * BM + wc * 32 + 8 * fq_;
#pragma unroll
        for (int ai = 0; ai < 2; ++ai)
#pragma unroll
            for (int mp = 0; mp < 2; ++mp) {
                u32x4 gh[2][2];
#pragma unroll
                for (int mm = 0; mm < 2; ++mm)
#pragma unroll
                    for (int bj = 0; bj < 2; ++bj) { const int r = row0 + ai * HALF + (2 * mp + mm) * 16; gh[mm][bj] = *(const u32x4*)(ZN + (size_t)r * 3072 + 1024 + col0 + bj * HALF); }
                __builtin_amdgcn_sched_barrier(0);
#pragma unroll
                for (int mm = 0; mm < 2; ++mm)
#pragma unroll
                    for (int bj = 0; bj < 2; ++bj) { const u32x4 a = gh[mm][bj]; const int m = 2 * mp + mm;
                        acc[ai][bj][m][0] = acc[ai][bj][m][0] * (f32x4){bflo(a.x), bfhi(a.x), bflo(a.y), bfhi(a.y)};
                        acc[ai][bj][m][1] = acc[ai][bj][m][1] * (f32x4){bflo(a.z), bfhi(a.z), bflo(a.w), bfhi(a.w)}; }
                __builtin_amdgcn_sched_barrier(0);
            }
    }
    __device__ __forceinline__ void operator()(const f32x4 (&acc)[2][2][4][2], const Unit& u, int wr, int wc, int fr, int fq) const {
        const int row0 = u.pm * BM + wr * 64 + fr, col0 = u.pn * BM + wc * 32 + 8 * fq;
#pragma unroll
        for (int ai = 0; ai < 2; ++ai) {
            u32x4 gt[4][2];
#pragma unroll
            for (int m = 0; m < 4; ++m)
#pragma unroll
                for (int bj = 0; bj < 2; ++bj) { const int r = row0 + ai * HALF + m * 16; gt[m][bj] = *(const u32x4*)(ZN + (size_t)r * 3072 + 2048 + col0 + bj * HALF); }
            __builtin_amdgcn_sched_barrier(0);
#pragma unroll
            for (int m = 0; m < 4; ++m) { const int r = row0 + ai * HALF + m * 16; bf16_t* rowp = MG + (size_t)r * DM + col0;
#pragma unroll
                for (int bj = 0; bj < 2; ++bj) { const u32x4 g = gt[m][bj];
                    const f32x4 v0 = acc[ai][bj][m][0] * (f32x4){bflo(g.x), bfhi(g.x), bflo(g.y), bfhi(g.y)}, v1 = acc[ai][bj][m][1] * (f32x4){bflo(g.z), bfhi(g.z), bflo(g.w), bfhi(g.w)};
                    *(u32x4*)(rowp + bj * HALF) = pack8(v0, v1); } }
            __builtin_amdgcn_sched_barrier(0);
        }
    }
};
struct EpiOut {
    static constexpr bool PERM = true, AFTER_DRAIN = false, MID = false, FP8 = false;
    bf16_t* X1; const float* x; const float* mod; const float* n2g; bf16_t* XS; float* PSS;
    __device__ __forceinline__ void operator()(const f32x4 (&acc)[2][2][4][2], const Unit& u, int wr, int wc, int fr, int fq) const {
        const int row0 = u.pm * BM + wr * 64 + fr, col0 = u.pn * BM + wc * 32 + 8 * fq; const float* mb = mod + (u.pm * BM >= SEQ ? 6144 : 0);
        f32x4 gv[2][2];
#pragma unroll
        for (int bj = 0; bj < 2; ++bj)
#pragma unroll
            for (int n = 0; n < 2; ++n) { const int c = col0 + bj * HALF + n * 4; gv[bj][n] = *(const f32x4*)(mb + 2 * 1024 + c); }
#pragma unroll
        for (int ai = 0; ai < 2; ++ai)
#pragma unroll
            for (int mp = 0; mp < 2; ++mp) {
                f32x4 xr[2][2][2];
#pragma unroll
                for (int mm = 0; mm < 2; ++mm)
#pragma unroll
                    for (int bj = 0; bj < 2; ++bj)
#pragma unroll
                        for (int n = 0; n < 2; ++n) xr[mm][bj][n] = *(const f32x4*)(x + (size_t)(row0 + ai * HALF + (2 * mp + mm) * 16) * DM + col0 + bj * HALF + n * 4);
                __builtin_amdgcn_sched_barrier(0);
#pragma unroll
                for (int mm = 0; mm < 2; ++mm) { const int m = 2 * mp + mm; const int r = row0 + ai * HALF + m * 16; const size_t off = (size_t)r * DM + col0; float ss = 0.f;
#pragma unroll
                    for (int bj = 0; bj < 2; ++bj) {
                        const f32x4 xa = xr[mm][bj][0] + gv[bj][0] * acc[ai][bj][m][0], xb = xr[mm][bj][1] + gv[bj][1] * acc[ai][bj][m][1];
                        *(u32x4*)(X1 + off + bj * HALF) = pack8(xa, xb);
                        ss += ((xa[0] * xa[0] + xa[1] * xa[1]) + (xa[2] * xa[2] + xa[3] * xa[3])) + ((xb[0] * xb[0] + xb[1] * xb[1]) + (xb[2] * xb[2] + xb[3] * xb[3]));
                        }
                    ss += __shfl_xor(ss, 16); ss += __shfl_xor(ss, 32);
                    if (fq == 0) PSS[(size_t)r * 16 + u.pn * 4 + wc] = ss; }
                __builtin_amdgcn_sched_barrier(0);
            }
    }
};
struct EpiQP {
    static constexpr bool PERM = true, AFTER_DRAIN = false, MID = false, FP8 = false;
    bf16_t* O; const float* PSS; const float* CQ;
    __device__ __forceinline__ void operator()(const f32x4 (&acc)[2][2][4][2], const Unit& u, int wr, int wc, int fr, int fq) const {
        const int row0 = u.pm * BM + wr * 64 + fr, col0 = u.pn * BM + wc * 32 + 8 * fq; const float* cq = CQ + (u.pm * BM >= SEQ ? 2048 : 0);
        f32x4 cv[2][2];
#pragma unroll
        for (int bj = 0; bj < 2; ++bj)
#pragma unroll
            for (int n = 0; n < 2; ++n) cv[bj][n] = *(const f32x4*)(cq + col0 + bj * HALF + 4 * n);
        f32x4 psv[2][4];
#pragma unroll
        for (int ai = 0; ai < 2; ++ai)
#pragma unroll
            for (int m = 0; m < 4; ++m) psv[ai][m] = *(const f32x4*)(PSS + (size_t)(row0 + ai * HALF + m * 16) * 16 + 4 * fq);
        __builtin_amdgcn_sched_barrier(0);
#pragma unroll
        for (int ai = 0; ai < 2; ++ai)
#pragma unroll
            for (int m = 0; m < 4; ++m) { const int r = row0 + ai * HALF + m * 16;
                const f32x4 ps = psv[ai][m]; float ss = (ps[0] + ps[1]) + (ps[2] + ps[3]);
                ss += __shfl_xor(ss, 16); ss += __shfl_xor(ss, 32);
                const float rstd = 1.f / sqrtf(ss * (1.f / DM) + EPS);
                bf16_t* rowp = O + (size_t)r * 2048 + col0;
#pragma unroll
                for (int bj = 0; bj < 2; ++bj) *(u32x4*)(rowp + bj * HALF) = pack8(acc[ai][bj][m][0] * rstd + cv[bj][0], acc[ai][bj][m][1] * rstd + cv[bj][1]); }
    }
};
}

#define XB_TMO      128
#define XB_XCNT(j)  (256  + 64 * (j))
#define XB_XSUB(j)  (1280 + 64 * (j))
#define XB_XGEN(j)  (2304 + 64 * (j))
#define XB_TOP      3328
#define XB_TOPGEN   3392
#define XCD_BAR_WORDS 3456
#define XB_SPIN_CAP (1u << 18)

__device__ __forceinline__ unsigned xb_ld(unsigned* p)              { return __hip_atomic_load(p, __ATOMIC_RELAXED, __HIP_MEMORY_SCOPE_AGENT); }
__device__ __forceinline__ unsigned xb_add(unsigned* p, unsigned v) { return __hip_atomic_fetch_add(p, v, __ATOMIC_RELAXED, __HIP_MEMORY_SCOPE_AGENT); }
__device__ __forceinline__ unsigned xb_xcc_id() { return (unsigned)__builtin_amdgcn_s_getreg((3 << 11) | 20) & 0xFu; }
#define XB_SPIN(cond, bar) do { unsigned _sp = 0; while (cond) { __builtin_amdgcn_s_sleep(1); \
    if ((++_sp & 255u) == 0u) { if (xb_ld(&(bar)[XB_TMO])) break; if (_sp > XB_SPIN_CAP) { atomicAdd(&(bar)[XB_TMO], 1u); break; } } } } while (0)

__device__ unsigned g_xbar_words[XCD_BAR_WORDS + 64];
struct XcdBarrier {
    unsigned* bar; unsigned x;
    volatile LAS unsigned* st;
};

__device__ __forceinline__ XcdBarrier xcd_barrier_post(unsigned* bar, volatile LAS unsigned* st) {
    XcdBarrier b; b.bar = bar; b.x = xb_xcc_id(); b.st = st;
    if (threadIdx.x == 0) (void)xb_add(&bar[XB_XCNT(b.x)], 1u);
    return b;
}
__device__ __forceinline__ void xcd_barrier_complete(unsigned* bar, unsigned x, unsigned& nloc, unsigned& nx) {
    const unsigned G = gridDim.x * gridDim.y * gridDim.z;
    unsigned sum, cnt, mine, sp = 0u;
    for (;;) {
        sum = 0u; cnt = 0u; mine = 0u;
#pragma unroll
        for (unsigned j = 0; j < 16; ++j) { const unsigned c = xb_ld(&bar[XB_XCNT(j)]); sum += c; cnt += (c > 0u) ? 1u : 0u; mine = (j == x) ? c : mine; }
        if (sum == G) break;
        __builtin_amdgcn_s_sleep(1);
        if ((++sp & 255u) == 0u) { if (xb_ld(&bar[XB_TMO])) break; if (sp > XB_SPIN_CAP) { atomicAdd(&bar[XB_TMO], 1u); break; } }
    }
    nloc = mine > 0u ? mine : 1u; nx = cnt > 0u ? cnt : 1u;
}

__device__ __forceinline__ void xcd_barrier(const XcdBarrier& b) {
    asm volatile("s_waitcnt vmcnt(0)" ::: "memory");
    __syncthreads();
    if (threadIdx.x == 0) {
        unsigned* bar = g_xbar_words;
        __builtin_amdgcn_s_waitcnt(0);
        unsigned nloc = b.st[0], nx = b.st[1];
        if (nloc == 0u) { xcd_barrier_complete(bar, b.x, nloc, nx); b.st[0] = nloc; b.st[1] = nx; }
        const unsigned old = xb_add(&bar[XB_XSUB(b.x)], 1u);
        const unsigned gen = old / nloc;
        if (old + 1u == (gen + 1u) * nloc) {
            __builtin_amdgcn_fence(__ATOMIC_RELEASE, "agent");
            asm volatile("s_waitcnt vmcnt(0)" ::: "memory");
            const unsigned og = xb_add(&bar[XB_TOP], 1u);
            const unsigned tg = og / nx;
            if (og + 1u == (tg + 1u) * nx) xb_add(&bar[XB_TOPGEN], 1u);
            else XB_SPIN(xb_ld(&bar[XB_TOPGEN]) == tg, bar);
            __builtin_amdgcn_fence(__ATOMIC_ACQUIRE, "agent");
            xb_add(&bar[XB_XGEN(b.x)], 1u);
            asm volatile("s_waitcnt vmcnt(0)" ::: "memory");
        } else {
            XB_SPIN(xb_ld(&bar[XB_XGEN(b.x)]) == gen, bar);
            __builtin_amdgcn_fence(__ATOMIC_ACQUIRE, "agent");
            asm volatile("s_waitcnt vmcnt(0)" ::: "memory");
        }
    }
    __syncthreads();
}


__global__ void __launch_bounds__(NTHR, 2) mega(P p) {
    extern __shared__ __attribute__((aligned(16))) unsigned char lds_raw[];
    float* lds = (float*)lds_raw;
    PG8_LAS unsigned char* PL = (PG8_LAS unsigned char*)lds_raw;
    cg::grid_group grid = cg::this_grid();
    { LAS unsigned* MISC = (LAS unsigned*)((LAS unsigned char*)lds_raw + LDS_BYTES - 64); if (threadIdx.x < 16) MISC[threadIdx.x] = 0u; }
    __syncthreads();
    const XcdBarrier xbar = xcd_barrier_post(g_xbar_words, (volatile LAS unsigned*)((LAS unsigned char*)lds_raw + LDS_BYTES - 64));
    unsigned char* ws = p.ws;
    bf16_t* WIN_T = (bf16_t*)(ws + WS_WIN_T); bf16_t* WHY_T = (bf16_t*)(ws + WS_WHY_T); bf16_t* WNA_T = (bf16_t*)(ws + WS_WNA_T); bf16_t* WOUT_T = (bf16_t*)(ws + WS_WOUT_T); bf16_t* WQ_T = (bf16_t*)(ws + WS_WQ_T);
    float* MOD = (float*)(ws + WS_MOD); bf16_t* HCTX = (bf16_t*)(ws + WS_HCTX); bf16_t* KCTX = (bf16_t*)(ws + WS_KCTX); bf16_t* VCTXT = (bf16_t*)(ws + WS_VCTXT);
    float* H3 = (float*)(ws + WS_H3); bf16_t* XN = (bf16_t*)(ws + WS_XN); bf16_t* ZT = (bf16_t*)(ws + WS_ZT); bf16_t* ZN = (bf16_t*)(ws + WS_ZN);
    bf16_t* HYO = (bf16_t*)(ws + WS_HYO); bf16_t* NAO = HYO + 512;
    _Float16* FILT = (_Float16*)p.out; bf16_t* VT = (bf16_t*)((unsigned char*)p.out + 32 * MiB); bf16_t* MG = XN; bf16_t* H2 = ZT; bf16_t* QP = ZN;
    bf16_t* WKC_T = (bf16_t*)(ws + WS_CTL + MiB); float* ROPE = (float*)(ws + WS_MOD + 512 * 1024);
    bf16_t* X1B = (bf16_t*)(ws + WS_ZN + 64 * MiB);
    float* PSS = (float*)(ws + WS_HCTX); float* CQ = (float*)(ws + WS_MOD + 256 * 1024); float* SU = (float*)(ws + WS_KCTX);
    _Float16* H3h = (_Float16*)(ws + WS_H3); _Float16* F4T = (_Float16*)(ws + WS_H3 + MiB);
    bf16_t* KEYB = (bf16_t*)(ws + WS_H3); unsigned char* UB = ws + WS_ZT + 32 * MiB; unsigned char* VB = ws + WS_ZT + 48 * MiB; float* USC = (float*)(ws + WS_H3 + MiB); float* VSC = USC + PNK * PNK;

    ph_transpose(p.w_in, 1024, NPROJ, WIN_T, 1, lds, 0, 0, ws + WS_NAO);
    ph_transpose(p.w_hy_out, 512, 1024, WHY_T, 0, lds, 0, 1024);
    ph_transpose(p.w_na_out, 512, 1024, WHY_T + 512, 0, lds, 0, 1024);
    ph_transpose(p.w_out, 1024, 1024, WOUT_T, 0, lds);
    ph_transpose(p.peer_w_q, 1024, 2048, WQ_T, 0, lds);
    ph_transpose(p.w_in + 2048, 1024, 512, WKC_T, 0, lds, NPROJ);
    ph_rope_table(ROPE);
    __syncthreads();
    ph_adaln(p, MOD, lds);
    __syncthreads();
    ph_filter_mlp(p, H3h, lds);
    ph_f4t(p.f4w, F4T);
    if (p.ws == nullptr) grid.sync();
    xcd_barrier(xbar);
    ph_filter_gemm(F4T, H3h, FILT);
    ph_modulate(p.x, T, p.norm1_g, MOD, 0, SEQ, 0, nullptr, ws + WS_HYO);
    ph_modulate(p.ctx, 512, p.norm1_g, MOD, 0, 0, 2, HCTX);
    ph_cq(WQ_T, MOD, CQ);
    ph_scale_wq(WQ_T, MOD, p.norm2_g, (bf16_t*)((unsigned char*)p.out + 50 * MiB));
    xcd_barrier(xbar);
    { pg8::Gemm g{(const bf16_t*)(ws + WS_NAO), (const bf16_t*)(ws + WS_HYO), 2048, T, 512}; pg8::StaticOrder S; S.init(2048, T, (int)gridDim.x, (int)blockIdx.x); pg8::EpiZT8 E{ZT, p.b_in, VT};
      pg8::gemm_phase<pg8::EpiZT8, pg8::StaticOrder, true, true>(PL, g, S, E); }
    { pg8::Gemm g{(const bf16_t*)(ws + WS_HYO), (const bf16_t*)(ws + WS_NAO + (size_t)2048 * 1024), T, 1024, 512}; pg8::StaticOrder S; S.init(T, 1024, (int)gridDim.x, (int)blockIdx.x); pg8::EpiQK8 E{ZN, p.b_in, p.q_norm_g, p.k_norm_g, ROPE};
      pg8::gemm_phase<pg8::EpiQK8, pg8::StaticOrder, true, true>(PL, g, S, E); }
    { pg8::Gemm g{(const bf16_t*)(ws + WS_HYO), (const bf16_t*)(ws + WS_NAO + (size_t)3072 * 1024), T, 2048, 512};
      pg8::StaticOrder S; S.init(T, 2048, (int)gridDim.x, (int)blockIdx.x); pg8::EpiGate8 E{ZN, p.b_in};
      pg8::gemm_phase<pg8::EpiGate8, pg8::StaticOrder, true, true>(PL, g, S, E); }
    ph_gemm_ctx2(HCTX, WKC_T, WIN_T + (size_t)1536 * 1024, p.b_in, p.k_norm_g, KCTX, VCTXT, (LAS float*)lds_raw);
    xcd_barrier(xbar);
    { int sfirst = (int)((blockIdx.x >> 3) & 1u);
      #pragma unroll 1
      for (int s = 0; s < 2; ++s) {
        if (s == sfirst) ph_hyena_fft(ZT, FILT, p.hy_conv_w, p.hy_conv_b, p.hy_skip, HYO, (h2_t*)(ws + WS_XN) + (size_t)blockIdx.x * (2 * FN), (LAS fc2*)lds_raw);
        else if (gridDim.x == 256) ph_natten2(ZN, VT, KCTX, VCTXT, p.na_rpb, NAO, ws + WS_XN + (size_t)blockIdx.x * 131072, (LAS unsigned char*)lds_raw);
        else ph_natten_mfma(ZN, VT, KCTX, VCTXT, p.na_rpb, NAO);
        __syncthreads();
      } }
    xcd_barrier(xbar);
    ph_hy_transpose(ZT, HYO, (LAS unsigned char*)lds_raw);
    xcd_barrier(xbar);
    { pg8::Gemm g{HYO, WHY_T, T, 1024, 1024}; pg8::StaticOrder S; S.init(T, 1024, (int)gridDim.x, (int)blockIdx.x); pg8::EpiMg2 E{MG, ZN};
      pg8::gemm_phase<pg8::EpiMg2, pg8::StaticOrder, true, true>(PL, g, S, E); }
    xcd_barrier(xbar);
    { pg8::Gemm g{MG, WOUT_T, T, 1024, 1024}; pg8::StaticOrder S; S.init(T, 1024, (int)gridDim.x, (int)blockIdx.x); pg8::EpiOut E{X1B, p.x, MOD, p.norm2_g, H2, PSS};
      pg8::gemm_phase<pg8::EpiOut, pg8::StaticOrder, true, true>(PL, g, S, E); }
    xcd_barrier(xbar);
    { int sfirst = (int)((blockIdx.x >> 3) & 1u);
      #pragma unroll 1
      for (int s = 0; s < 2; ++s) {
        if (s == sfirst) {
            ph_cvt_bf16(p.peer_keys, KEYB, (size_t)PH * 2 * PNK * PDH);
            ph_cvt_rows<1>(p.peer_u, UB, USC, PNK * PNK, MOD, SU);
            ph_cvt_rows<1>(p.peer_v, VB, VSC, PNK * PNK);
        } else {
            pg8::Gemm g{X1B, (const bf16_t*)((unsigned char*)p.out + 50 * MiB), T, 2048, 1024, SEQ, (size_t)2048 * 1024 * 2}; pg8::StaticOrder S; S.init(T, 2048, (int)gridDim.x, (int)blockIdx.x); pg8::EpiQP E{QP, PSS, CQ};
            pg8::gemm_phase<pg8::EpiQP, pg8::StaticOrder, true, true>(PL, g, S, E);
        }
        __syncthreads();
      } }
    xcd_barrier(xbar);
    ph_peer2(QP, H2, KEYB, UB, VB, USC, VSC, PSS, SU, MOD, X1B, p.out, (LAS unsigned char*)lds_raw, p.norm2_g);
    { volatile LAS unsigned* MISC = (volatile LAS unsigned*)((LAS unsigned char*)lds_raw + LDS_BYTES - 64);
      __syncthreads();
      if (threadIdx.x == 0) MISC[4] = (xb_add(&g_xbar_words[XCD_BAR_WORDS + 32], 1u) == gridDim.x - 1u) ? 1u : 0u;
      __syncthreads();
      if (MISC[4]) { for (int i = threadIdx.x; i < XCD_BAR_WORDS + 64; i += NTHR) __hip_atomic_store(&g_xbar_words[i], 0u, __ATOMIC_RELAXED, __HIP_MEMORY_SCOPE_AGENT); } }
}

extern "C" void kernel_launch(void* const* d_in, const int* in_sizes, int n_in, void* d_out, int out_size, void* d_ws, size_t ws_size, hipStream_t stream) {
    static int grid_blocks = 0;
    if (grid_blocks == 0) {
        if (n_in != 31 || ws_size < WS_END) { fprintf(stderr, "kernel_launch: unexpected inputs (n_in %d, ws %zu)\n", n_in, ws_size); grid_blocks = -1; return; }
        int dev = 0, cus = 0, per_cu = 0;
        (void)hipGetDevice(&dev);
        (void)hipDeviceGetAttribute(&cus, hipDeviceAttributeMultiprocessorCount, dev);
        (void)hipFuncSetAttribute((const void*)mega, hipFuncAttributeMaxDynamicSharedMemorySize, LDS_BYTES);
        (void)hipOccupancyMaxActiveBlocksPerMultiprocessor(&per_cu, (const void*)mega, NTHR, LDS_BYTES);
        if (per_cu < 1) { fprintf(stderr, "kernel_launch: occupancy query says %d blocks per CU\n", per_cu); per_cu = 1; }
        grid_blocks = cus * per_cu;
    }
    if (grid_blocks < 0) return;
    P p{};
    const float** pf = (const float**)&p;
    for (int i = 0; i < 31; ++i) pf[i] = (const float*)d_in[i];
    p.out = (float*)d_out; p.ws = (unsigned char*)d_ws;
    void* args[] = {&p};
    hipError_t e = hipLaunchCooperativeKernel((void*)mega, dim3(grid_blocks), dim3(NTHR), args, LDS_BYTES, stream);
    if (e != hipSuccess) fprintf(stderr, "cooperative launch failed: %s (grid %d)\n", hipGetErrorString(e), grid_blocks);
}
```
